# Optimizing an MI355X kernel written in HIP

```python
import math
import jax, jax.numpy as jnp
from jax import lax
import numpy as np

D_MODEL = 1024
BATCH = 1
SEQ = 16384
DEPTH = 4

N_META = 16
N_HEADS = 16
N_KV_HEADS = 4
HEAD_DIM = 64
Q_GROUP = N_HEADS // N_KV_HEADS
WINDOW = 128
BLOCK = 128
SSM_WIDTH = D_MODEL // 2
SSM_GROUP_CH = 16
SSM_GROUPS = SSM_WIDTH // SSM_GROUP_CH
SSM_STATE = 64
N_DIR = 2
DT_MIN = 1e-3
DT_MAX = 1e-1
D_FF = 2816
EPS = 1e-6
NEG = -1e30

ATTN_Q = N_HEADS * HEAD_DIM
ATTN_KV = N_KV_HEADS * HEAD_DIM
SPLITS = [ATTN_Q, ATTN_Q + ATTN_KV, ATTN_Q + 2 * ATTN_KV,
          ATTN_Q + 2 * ATTN_KV + SSM_WIDTH,
          ATTN_Q + 2 * ATTN_KV + SSM_WIDTH + D_MODEL]
IN_COLS = ATTN_Q + 2 * ATTN_KV + SSM_WIDTH + 2 * D_MODEL

kernel_name = "hybrid_s5_swa_macaron_encoder"


def alibi_slopes():
    s = 2.0 ** (-8.0 * np.arange(1, N_HEADS + 1) / N_HEADS)
    return jnp.asarray(s.reshape(N_KV_HEADS, Q_GROUP), dtype=jnp.float32)


def rmsnorm(x, g):
    xf = x.astype(jnp.float32)
    y = xf * lax.rsqrt(jnp.mean(xf * xf, axis=-1, keepdims=True) + EPS)
    return (y * g.astype(jnp.float32)).astype(x.dtype)


def swiglu(h, w_gate, w_up, w_down):
    return (jax.nn.silu(h @ w_gate) * (h @ w_up)) @ w_down


def s5_direction(ug, lam_re, lam_im, log_dt, b_re, b_im, c_re, c_im, reverse):
    f32 = jnp.float32
    lam = lax.complex(lam_re.astype(f32), lam_im.astype(f32))
    dt = jnp.exp(log_dt.astype(f32))[:, None]
    lam_bar = jnp.exp(lam * dt)
    b_bar = ((lam_bar - 1.0) / lam)[:, :, None] * lax.complex(b_re.astype(f32), b_im.astype(f32))
    c_mat = lax.complex(c_re.astype(f32), c_im.astype(f32))
    bu = jnp.einsum('blgc,gpc->blgp', ug, b_bar)
    a = jnp.broadcast_to(lam_bar, bu.shape)

    def combine(e1, e2):
        a1, b1 = e1
        a2, b2 = e2
        return a1 * a2, a2 * b1 + b2

    _, states = lax.associative_scan(combine, (a, bu), reverse=reverse, axis=1)
    return jnp.einsum('blgp,gcp->blgc', states, c_mat).real


def ssm_branch(u, lam_re, lam_im, log_dt, b_re, b_im, c_re, c_im, d, w_glu):
    B, L, _ = u.shape
    uf = u.astype(jnp.float32)
    ug = uf.reshape(B, L, SSM_GROUPS, SSM_GROUP_CH)
    y = jnp.zeros_like(ug)
    for dr in range(N_DIR):
        y = y + s5_direction(ug, lam_re[dr], lam_im[dr], log_dt[dr], b_re[dr], b_im[dr],
                             c_re[dr], c_im[dr], reverse=(dr == 1))
    y = y.reshape(B, L, SSM_WIDTH) + d.astype(jnp.float32) * uf
    z = jax.nn.gelu(y).astype(u.dtype)
    return z * jax.nn.sigmoid(z @ w_glu)


def windowed_gqa(q, k, v, sink):
    B, L = q.shape[:2]
    pad = BLOCK - N_META
    Lp = L + pad
    nb = Lp // BLOCK
    k_meta, v_meta = k[:, :N_META], v[:, :N_META]

    def to_blocks(t):
        tp = jnp.pad(t, ((0, 0), (pad, 0), (0, 0), (0, 0)))
        return tp.reshape(B, nb, BLOCK, *t.shape[2:])

    def band(t):
        tb = jnp.pad(to_blocks(t), ((0, 0), (1, 1), (0, 0), (0, 0), (0, 0)))
        return jnp.concatenate([tb[:, :-2], tb[:, 1:-1], tb[:, 2:]], axis=2)

    qb = to_blocks(q).reshape(B, nb, BLOCK, N_KV_HEADS, Q_GROUP, HEAD_DIM)
    kband, vband = band(k), band(v)
    scale = HEAD_DIM ** -0.5

    qi = jnp.arange(BLOCK)
    sj = jnp.arange(3 * BLOCK)
    dist = jnp.abs(qi[:, None] + BLOCK - sj[None, :])
    kpos = (jnp.arange(nb)[:, None] - 1) * BLOCK + sj[None, :]
    kvalid = (kpos >= BLOCK) & (kpos < Lp)
    valid = (dist <= WINDOW)[None] & kvalid[:, None, :]
    slopes = alibi_slopes()

    s_band = jnp.einsum('bnqkgd,bnskd->bnkgqs', qb, kband,
                        preferred_element_type=jnp.float32) * scale
    s_band = s_band - slopes[:, :, None, None] * dist.astype(jnp.float32)
    s_band = jnp.where(valid[None, :, None, None], s_band, NEG)
    s_meta = jnp.einsum('bnqkgd,bmkd->bnkgqm', qb, k_meta,
                        preferred_element_type=jnp.float32) * scale
    s_sink = jnp.broadcast_to(sink.astype(jnp.float32).reshape(N_KV_HEADS, Q_GROUP)[None, None, :, :, None, None],
                              (B, nb, N_KV_HEADS, Q_GROUP, BLOCK, 1))
    p = jax.nn.softmax(jnp.concatenate([s_band, s_meta, s_sink], axis=-1), axis=-1)
    p_band = p[..., :3 * BLOCK].astype(v.dtype)
    p_meta = p[..., 3 * BLOCK:3 * BLOCK + N_META].astype(v.dtype)
    out = (jnp.einsum('bnkgqs,bnskd->bnqkgd', p_band, vband)
           + jnp.einsum('bnkgqm,bmkd->bnqkgd', p_meta, v_meta))
    return out.reshape(B, Lp, N_HEADS * HEAD_DIM)[:, pad:]


def mixer(h, w_in, lam_re, lam_im, log_dt, b_re, b_im, c_re, c_im, d, w_glu, sink,
          w_branch_ssm, w_branch_attn, w_out):
    B, L, _ = h.shape
    proj = h @ w_in
    q, k, v, u, g_s, g_a = jnp.split(proj, SPLITS, axis=-1)
    y_attn = windowed_gqa(q.reshape(B, L, N_HEADS, HEAD_DIM),
                          k.reshape(B, L, N_KV_HEADS, HEAD_DIM),
                          v.reshape(B, L, N_KV_HEADS, HEAD_DIM), sink)
    y_ssm = ssm_branch(u, lam_re, lam_im, log_dt, b_re, b_im, c_re, c_im, d, w_glu)
    merged = (jax.nn.sigmoid(g_s) * (y_ssm @ w_branch_ssm)
              + jax.nn.sigmoid(g_a) * (y_attn @ w_branch_attn))
    return merged @ w_out


def setup_inputs(seed: int = 0) -> dict:
    key = jax.random.key(seed)
    ks = jax.random.split(key, 32)
    f32 = jnp.float32

    def nrm(k, shape, fan_in):
        return jax.random.normal(k, shape, f32) * fan_in ** -0.5

    def gain(k, shape):
        return 1.0 + 0.05 * jax.random.normal(k, shape, f32)

    G, P, CH = SSM_GROUPS, SSM_STATE, SSM_GROUP_CH
    n = jnp.arange(P, dtype=f32)
    return {
        "x": jax.random.normal(ks[0], (BATCH, SEQ, D_MODEL), f32),
        "meta_tokens": jax.random.normal(ks[1], (N_META, D_MODEL), f32),
        "ffn1_norm": gain(ks[2], (DEPTH, D_MODEL)),
        "ffn1_w_gate": nrm(ks[3], (DEPTH, D_MODEL, D_FF), D_MODEL),
        "ffn1_w_up": nrm(ks[4], (DEPTH, D_MODEL, D_FF), D_MODEL),
        "ffn1_w_down": nrm(ks[5], (DEPTH, D_FF, D_MODEL), D_FF),
        "mix_norm": gain(ks[6], (DEPTH, D_MODEL)),
        "w_in": nrm(ks[7], (DEPTH, D_MODEL, IN_COLS), D_MODEL),
        "ssm_lam_re": -0.5 + 0.01 * jax.random.normal(ks[8], (DEPTH, N_DIR, G, P), f32),
        "ssm_lam_im": math.pi * n + 0.01 * jax.random.normal(ks[9], (DEPTH, N_DIR, G, P), f32),
        "ssm_log_dt": jax.random.uniform(ks[10], (DEPTH, N_DIR, G), f32,
                                         minval=math.log(DT_MIN), maxval=math.log(DT_MAX)),
        "ssm_b_re": nrm(ks[11], (DEPTH, N_DIR, G, P, CH), 2 * CH),
        "ssm_b_im": nrm(ks[12], (DEPTH, N_DIR, G, P, CH), 2 * CH),
        "ssm_c_re": nrm(ks[13], (DEPTH, N_DIR, G, CH, P), 2 * P),
        "ssm_c_im": nrm(ks[14], (DEPTH, N_DIR, G, CH, P), 2 * P),
        "ssm_d": jax.random.normal(ks[15], (DEPTH, SSM_WIDTH), f32),
        "ssm_w_glu": nrm(ks[16], (DEPTH, SSM_WIDTH, SSM_WIDTH), SSM_WIDTH),
        "attn_sink": 0.5 * jax.random.normal(ks[17], (DEPTH, N_HEADS), f32),
        "w_branch_ssm": nrm(ks[18], (DEPTH, SSM_WIDTH, D_MODEL), SSM_WIDTH),
        "w_branch_attn": nrm(ks[19], (DEPTH, ATTN_Q, D_MODEL), ATTN_Q),
        "w_out": nrm(ks[20], (DEPTH, D_MODEL, D_MODEL), D_MODEL),
        "ffn2_norm": gain(ks[21], (DEPTH, D_MODEL)),
        "ffn2_w_gate": nrm(ks[22], (DEPTH, D_MODEL, D_FF), D_MODEL),
        "ffn2_w_up": nrm(ks[23], (DEPTH, D_MODEL, D_FF), D_MODEL),
        "ffn2_w_down": nrm(ks[24], (DEPTH, D_FF, D_MODEL), D_FF),
        "final_norm": gain(ks[25], (D_MODEL,)),
    }


def reference(x, meta_tokens, ffn1_norm, ffn1_w_gate, ffn1_w_up, ffn1_w_down,
              mix_norm, w_in, ssm_lam_re, ssm_lam_im, ssm_log_dt, ssm_b_re, ssm_b_im,
              ssm_c_re, ssm_c_im, ssm_d, ssm_w_glu, attn_sink, w_branch_ssm,
              w_branch_attn, w_out, ffn2_norm, ffn2_w_gate, ffn2_w_up, ffn2_w_down,
              final_norm):
    B = x.shape[0]
    meta = jnp.broadcast_to(meta_tokens.astype(x.dtype)[None], (B, N_META, D_MODEL))
    h = jnp.concatenate([meta, x], axis=1)
    for l in range(DEPTH):
        h = h + 0.5 * swiglu(rmsnorm(h, ffn1_norm[l]), ffn1_w_gate[l], ffn1_w_up[l], ffn1_w_down[l])
        h = h + mixer(rmsnorm(h, mix_norm[l]), w_in[l], ssm_lam_re[l], ssm_lam_im[l],
                      ssm_log_dt[l], ssm_b_re[l], ssm_b_im[l], ssm_c_re[l], ssm_c_im[l],
                      ssm_d[l], ssm_w_glu[l], attn_sink[l], w_branch_ssm[l],
                      w_branch_attn[l], w_out[l])
        h = h + 0.5 * swiglu(rmsnorm(h, ffn2_norm[l]), ffn2_w_gate[l], ffn2_w_up[l], ffn2_w_down[l])
    h = rmsnorm(h, final_norm)
    return h[:, N_META:]
```

```cpp
#ifndef PROBE_EXTRA
#define PROBE_EXTRA 0
#define PROBE_STEP 0
#endif
#include <hip/hip_runtime.h>
#include <hip/hip_cooperative_groups.h>
#include <cstdio>
#include <cstdint>
namespace cg = cooperative_groups;

typedef unsigned short bf16_t;
typedef short bf16x8 __attribute__((ext_vector_type(8)));
typedef float f32x16 __attribute__((ext_vector_type(16)));
typedef float f32x4 __attribute__((ext_vector_type(4)));

constexpr int L = 16400, NX = 16384, D = 1024, DFF = 2816;
constexpr int NG = 32, NP = 64;
constexpr int NCH = 257, LU = NCH * 64;
constexpr int LV = 16640;
constexpr int PADK = 64;
constexpr int LDH = D + PADK;
constexpr int LS = 16512;
constexpr int LZ = 16400;

constexpr size_t AL(size_t x) { return (x + 255) & ~(size_t)255; }
constexpr size_t OFF_H = 0;
constexpr size_t OFF_HB = OFF_H + AL((size_t)L * D * 4);
constexpr size_t OFF_SSQ = OFF_HB + AL((size_t)L * LDH * 2);
constexpr size_t OFF_SSK = OFF_SSQ + AL((size_t)13 * 16 * LS * 4);
constexpr size_t OFF_ACT = OFF_SSK + AL((size_t)13 * 64 * 16 * 4);
constexpr size_t OFF_Q = OFF_ACT;
constexpr size_t OFF_GS = OFF_Q + AL((size_t)129 * 128 * D * 2);
constexpr size_t OFF_K = OFF_GS + AL((size_t)L * D * 2);
constexpr size_t OFF_VT = OFF_K + AL((size_t)L * 256 * 2);
constexpr size_t OFF_VT_END = OFF_VT + AL((size_t)256 * LV * 2);
constexpr size_t OFF_GA = OFF_ACT + AL((size_t)129 * 128 * DFF * 2);
static_assert(OFF_VT_END <= OFF_GA, "alias overflow");
constexpr size_t OFF_YA = OFF_GA + AL((size_t)L * D * 2);
constexpr size_t OFF_UG = OFF_YA + AL((size_t)129 * 128 * D * 2) + 65536;
constexpr size_t OFF_Z = OFF_UG + AL((size_t)NG * LU * 16 * 2);
constexpr size_t OFF_YS = OFF_Z + AL((size_t)L * 512 * 2);
constexpr size_t OFF_XEND = OFF_YS + AL((size_t)129 * 128 * 512 * 2);
constexpr size_t OFF_XIN = OFF_XEND + AL((size_t)NG * NCH * 256 * 4);
constexpr size_t OFF_W = OFF_XIN + AL((size_t)NG * NCH * 256 * 2);
constexpr size_t W_GU1 = 0;
constexpr size_t W_D1 = W_GU1 + (size_t)2 * DFF * (D + PADK) * 2;
constexpr size_t W_IN = W_D1 + (size_t)D * (DFF + PADK) * 2;
constexpr size_t W_GLU = W_IN + (size_t)4096 * (D + PADK) * 2;
constexpr size_t W_BS = W_GLU + (size_t)512 * (512 + PADK) * 2;
constexpr size_t W_BA = W_BS + (size_t)D * (512 + PADK) * 2;
constexpr size_t W_O = W_BA + (size_t)D * (D + PADK) * 2;
constexpr size_t W_GU2 = W_O + (size_t)D * (D + PADK) * 2;
constexpr size_t W_D2 = W_GU2 + (size_t)2 * DFF * (D + PADK) * 2;
constexpr size_t W_TOTAL = W_D2 + (size_t)D * (DFF + PADK) * 2;
constexpr size_t OFF_KTAB = OFF_W + AL(W_TOTAL);
constexpr size_t OFF_WEND = OFF_KTAB + AL((size_t)NG * 127 * 256 * 2);
constexpr size_t OFF_MCAR = OFF_WEND + AL((size_t)NG * 256 * 1024 * 2);
constexpr size_t OFF_LP = OFF_MCAR + AL((size_t)NG * 1024 * 256 * 2);
constexpr size_t OFF_BB = OFF_LP + AL((size_t)4 * 2 * NG * NP * 65 * 8);
constexpr size_t OFF_BAR = OFF_BB + AL((size_t)4 * 2 * NG * NP * 16 * 8);
constexpr size_t WS_TOTAL = OFF_BAR + 16384;

struct Params {
  const float* x; const float* meta; const float* ffn1_norm; const float* ffn1_wg; const float* ffn1_wu; const float* ffn1_wd;
  const float* mix_norm; const float* w_in; const float* lam_re; const float* lam_im; const float* log_dt;
  const float* b_re; const float* b_im; const float* c_re; const float* c_im; const float* ssm_d; const float* w_glu;
  const float* sink; const float* w_bs; const float* w_ba; const float* w_out; const float* ffn2_norm;
  const float* ffn2_wg; const float* ffn2_wu; const float* ffn2_wd; const float* final_norm;
  float* out; char* ws;
};

#define LAUNDER_LANE() do { le = lane; asm volatile("" : "+v"(le)); } while (0)
__device__ __forceinline__ const bf16_t* wblk(const bf16_t* W, int nkt, int R, int kc) { return W + (((size_t)(R >> 8) * nkt + (kc >> 2)) * 256 + (R & 255)) * 32 + (kc & 3) * 8; }
__device__ __forceinline__ size_t hbidx(int row, int col) {
  const int rr = row - 16; const int tmx = row < 16 ? 128 : (rr >> 7), r = row < 16 ? row : (rr & 127);
  return (((size_t)tmx * 32 + (col >> 5)) * 128 + r) * 32 + (col & 31);
}
__device__ __forceinline__ size_t blkidx(int row, int col, int nkt) {
  const int rr = row - 16; const int tmx = row < 16 ? 128 : (rr >> 7), r = row < 16 ? row : (rr & 127);
  return (((size_t)tmx * nkt + (col >> 5)) * 128 + r) * 32 + (col & 31);
}
__device__ __forceinline__ size_t blkfast(int tm, int nkt, int cb, int rl) { return ((size_t)tm * nkt + cb) * 4096 + rl; }
__device__ __forceinline__ unsigned cvt_pk_bf16(float lo, float hi) { unsigned r; asm volatile("v_cvt_pk_bf16_f32 %0, %1, %2" : "=v"(r) : "v"(lo), "v"(hi)); return r; }
__device__ __forceinline__ float bf2f(bf16_t v) { return __uint_as_float(((unsigned)v) << 16); }
__device__ __forceinline__ float sigmoidf_(float v) { return __builtin_amdgcn_rcpf(1.0f + __expf(-v)); }
__device__ __forceinline__ float gelu_tanh(float x) { const float u = 1.5957691216f * (x + 0.044715f * x * x * x); return x * sigmoidf_(u); }
__device__ __forceinline__ int lds_off(int row, int ch) { return row * 128 + ((ch ^ ((row >> 1) & 7)) << 4); }
__device__ __forceinline__ uint2 pack4(f32x4 v) { uint2 r; r.x = cvt_pk_bf16(v[0], v[1]); r.y = cvt_pk_bf16(v[2], v[3]); return r; }

__device__ __forceinline__ float row_rstd(const Params& p, int si, int row) {
  float s = 0.f;
  if (row >= 16) {
    const float* q = (const float*)(p.ws + OFF_SSQ) + (size_t)si * 16 * LS + row + 16;
#pragma unroll
    for (int i = 0; i < 16; ++i) s += q[(size_t)i * LS];
  } else {
    const float* q = (const float*)(p.ws + OFF_SSK) + (size_t)si * 64 * 16 + row;
    for (int i = 0; i < 64; ++i) s += q[i * 16];
  }
  return rsqrtf(s * (1.f / 1024.f) + 1e-6f);
}
__device__ __forceinline__ float* ssq_slot(const Params& p, int si, int slot, int row) { return (float*)(p.ws + OFF_SSQ) + ((size_t)si * 16 + slot) * LS + row + 16; }
__device__ __forceinline__ float* ssk_slot(const Params& p, int si, int slot, int row) { return (float*)(p.ws + OFF_SSK) + ((size_t)si * 64 + slot) * 16 + row; }

#define GSTAGE 24576
#define GLDS(S) do { rx##S##0 = *(const uint4*)(xp); rx##S##1 = *(const uint4*)(xp + (size_t)64 * xld); \
                      rw##S##0 = *(const uint4*)(wp); rw##S##1 = *(const uint4*)(wp + (size_t)64 * wld); rw##S##2 = *(const uint4*)(wp + (size_t)128 * wld); rw##S##3 = *(const uint4*)(wp + (size_t)192 * wld); } while (0)
#define LSTS(S, base) do { char* _b = (base) + so; *(uint4*)(_b) = rx##S##0; *(uint4*)(_b + 4096) = rx##S##1; \
                        *(uint4*)(_b + 8192) = rw##S##0; *(uint4*)(_b + 12288) = rw##S##1; *(uint4*)(_b + 16384) = rw##S##2; *(uint4*)(_b + 20480) = rw##S##3; } while (0)
__device__ __forceinline__ void gemm_acc(f32x16 (&acc)[2][4], const bf16_t* xp, int xld, int xks, const bf16_t* wp, int wld, int wks,
                                         int nkt, char* lds, int tid) {
  const int lane = tid & 63, wave = tid >> 6, wm = wave >> 1, wn = wave & 1;
  const int lrow = tid >> 2, lch = tid & 3;
  uint4 rxA0, rxA1, rwA0, rwA1, rwA2, rwA3;
  GLDS(A);
  __syncthreads();
  const int so = lrow * 64 + ((lch ^ ((lrow >> 2) & 3)) << 4);
  LSTS(A, lds);
  __syncthreads();
  const int r31 = lane & 31, hh = lane >> 5, swz = (r31 >> 2) & 3;
  const int ro0 = r31 * 64 + (((0 + hh) ^ swz) << 4), ro1 = r31 * 64 + (((2 + hh) ^ swz) << 4);
  const int xb = wm * 4096, wb = 8192 + wn * 8192;
#define KSTEP(ro) do { const bf16x8 xf0 = *(const bf16x8*)(cur + xb + (ro)), xf1 = *(const bf16x8*)(cur + xb + 2048 + (ro)); \
    const bf16x8 wf0 = *(const bf16x8*)(cur + wb + (ro)), wf1 = *(const bf16x8*)(cur + wb + 2048 + (ro)); \
    const bf16x8 wf2 = *(const bf16x8*)(cur + wb + 4096 + (ro)), wf3 = *(const bf16x8*)(cur + wb + 6144 + (ro)); \
    __builtin_amdgcn_s_setprio(1); \
    acc[0][0] = __builtin_amdgcn_mfma_f32_32x32x16_bf16(wf0, xf0, acc[0][0], 0, 0, 0); \
    acc[0][1] = __builtin_amdgcn_mfma_f32_32x32x16_bf16(wf1, xf0, acc[0][1], 0, 0, 0); \
    acc[0][2] = __builtin_amdgcn_mfma_f32_32x32x16_bf16(wf2, xf0, acc[0][2], 0, 0, 0); \
    acc[0][3] = __builtin_amdgcn_mfma_f32_32x32x16_bf16(wf3, xf0, acc[0][3], 0, 0, 0); \
    acc[1][0] = __builtin_amdgcn_mfma_f32_32x32x16_bf16(wf0, xf1, acc[1][0], 0, 0, 0); \
    acc[1][1] = __builtin_amdgcn_mfma_f32_32x32x16_bf16(wf1, xf1, acc[1][1], 0, 0, 0); \
    acc[1][2] = __builtin_amdgcn_mfma_f32_32x32x16_bf16(wf2, xf1, acc[1][2], 0, 0, 0); \
    acc[1][3] = __builtin_amdgcn_mfma_f32_32x32x16_bf16(wf3, xf1, acc[1][3], 0, 0, 0); \
    __builtin_amdgcn_s_setprio(0); } while (0)
#pragma unroll 1
  for (int kt = 0; kt < nkt; ++kt) {
    const char* cur = lds + (kt & 1) * GSTAGE;
    const bool more = kt + 1 < nkt;
    if (more) { xp += xks; wp += wks; GLDS(A); }
    KSTEP(ro0); KSTEP(ro1);
    if (more) LSTS(A, lds + ((kt + 1) & 1) * GSTAGE);
    __syncthreads();
  }
#undef KSTEP
}
__device__ __forceinline__ void gemm_acc_h(f32x16 (&acc)[2][2], const bf16_t* xp, int xld, int xks, const bf16_t* wp, int wld, int wks,
                                           int nkt, char* lds, int tid) {
  const int lane = tid & 63, wave = tid >> 6, wm = wave >> 1, wn = wave & 1;
  const int lrow = tid >> 2, lch = tid & 3;
  uint4 rx0, rx1, rw0, rw1;
#define GLDH() do { rx0 = *(const uint4*)(xp); rx1 = *(const uint4*)(xp + (size_t)64 * xld); rw0 = *(const uint4*)(wp); rw1 = *(const uint4*)(wp + (size_t)64 * wld); } while (0)
#define LSTH(base) do { char* _b = (base) + so; *(uint4*)(_b) = rx0; *(uint4*)(_b + 4096) = rx1; *(uint4*)(_b + 8192) = rw0; *(uint4*)(_b + 12288) = rw1; } while (0)
  GLDH();
  __syncthreads();
  const int so = lrow * 64 + ((lch ^ ((lrow >> 2) & 3)) << 4);
  LSTH(lds);
  __syncthreads();
  const int r31 = lane & 31, hh = lane >> 5, swz = (r31 >> 2) & 3;
  const int ro0 = r31 * 64 + (((0 + hh) ^ swz) << 4), ro1 = r31 * 64 + (((2 + hh) ^ swz) << 4);
  const int xb = wm * 4096, wb = 8192 + wn * 4096;
#define KSTEPH(ro) do { const bf16x8 xf0 = *(const bf16x8*)(cur + xb + (ro)), xf1 = *(const bf16x8*)(cur + xb + 2048 + (ro)); \
    const bf16x8 wf0 = *(const bf16x8*)(cur + wb + (ro)), wf1 = *(const bf16x8*)(cur + wb + 2048 + (ro)); \
    acc[0][0] = __builtin_amdgcn_mfma_f32_32x32x16_bf16(wf0, xf0, acc[0][0], 0, 0, 0); \
    acc[0][1] = __builtin_amdgcn_mfma_f32_32x32x16_bf16(wf1, xf0, acc[0][1], 0, 0, 0); \
    acc[1][0] = __builtin_amdgcn_mfma_f32_32x32x16_bf16(wf0, xf1, acc[1][0], 0, 0, 0); \
    acc[1][1] = __builtin_amdgcn_mfma_f32_32x32x16_bf16(wf1, xf1, acc[1][1], 0, 0, 0); } while (0)
#pragma unroll 1
  for (int kt = 0; kt < nkt; ++kt) {
    const char* cur = lds + (kt & 1) * GSTAGE;
    const bool more = kt + 1 < nkt;
    if (more) { xp += xks; wp += wks; GLDH(); }
    KSTEPH(ro0); KSTEPH(ro1);
    if (more) LSTH(lds + ((kt + 1) & 1) * GSTAGE);
    __syncthreads();
  }
#undef KSTEPH
#undef GLDH
#undef LSTH
}
__device__ __forceinline__ void zero_acc(f32x16 (&acc)[2][4]) {
#pragma unroll
  for (int a = 0; a < 2; ++a)
#pragma unroll
    for (int b = 0; b < 4; ++b)
#pragma unroll
      for (int r = 0; r < 16; ++r) acc[a][b][r] = 0.f;
}

template <class XA, class WA>
__device__ __forceinline__ f32x4 skinny_acc(XA xaddr, WA waddr, int nk32, char* lds, int tid) {
  int lane = tid & 63; const int wave = tid >> 6;
  asm volatile("" : "+v"(lane));
  const int per = nk32 >> 2;
  f32x4 acc = {0.f, 0.f, 0.f, 0.f};
  const int e = (wave + 1) * per;
  for (int s = wave * per; s < e; s += 8) {
    bf16x8 a0, a1, a2, a3, a4, a5, a6, a7, b0, b1, b2, b3, b4, b5, b6, b7;
#define SKL(j) { const int ss = (s + j < e) ? s + j : e - 1; const int kc = ss * 4 + (lane >> 4); a##j = *(const bf16x8*)waddr(lane & 15, kc); b##j = *(const bf16x8*)xaddr(lane & 15, kc); }
    SKL(0) SKL(1) SKL(2) SKL(3) SKL(4) SKL(5) SKL(6) SKL(7)
#undef SKL
#define SKM(j) if (s + j < e) acc = __builtin_amdgcn_mfma_f32_16x16x32_bf16(a##j, b##j, acc, 0, 0, 0);
    SKM(0) SKM(1) SKM(2) SKM(3) SKM(4) SKM(5) SKM(6) SKM(7)
#undef SKM
  }
  __syncthreads();
  f32x4* red = (f32x4*)lds;
  red[wave * 64 + lane] = acc;
  __syncthreads();
  if (wave == 0) acc = red[lane] + red[64 + lane] + red[128 + lane] + red[192 + lane];
  return acc;
}

__shared__ int s_unit;
__shared__ unsigned s_nx, s_nloc;
__shared__ int s_vb_even;
__shared__ int s_vb;
__device__ __forceinline__ bool tile_of(int it, int nN, int& tm, int& tn, int xsel = -1) {
  const int G = gridDim.x, b = s_vb;
  const int x = xsel < 0 ? (b & 7) : xsel, j = b >> 3, tmPer = G >> 4;
  const int ptm = j % tmPer, ptn = j / tmPer;
  const int npn = nN >> 1, pi = it * 8 + x;
  tm = (pi / npn) * tmPer + ptm; tn = (pi % npn) * 2 + ptn;
  return tm < 128;
}
__device__ __forceinline__ int sk_first() { const int b = s_vb; return (7 - (b & 7)) * ((int)gridDim.x >> 3) + (b >> 3); }
__device__ __forceinline__ int tile_iters(int nN) { const int npatch = (128 / (gridDim.x >> 4)) * (nN >> 1); return (npatch + 7) >> 3; }

__device__ __forceinline__ void phase_init(const Params& p, int tid) {
  float* h = (float*)(p.ws + OFF_H); bf16_t* hb = (bf16_t*)(p.ws + OFF_HB);
  const int lane = tid & 63, wave = tid >> 6;
  const int gthreads = gridDim.x * 256, gtid = blockIdx.x * 256 + tid;
  for (int r0 = (int)blockIdx.x * 32 - 16; r0 < L; r0 += gridDim.x * 32)
  for (int r = r0 + wave; r < r0 + 32 && r < L; r += 4) {
    if (r < 0) continue;
    const float* src = r < 16 ? p.meta + (size_t)r * D : p.x + (size_t)(r - 16) * D;
    float ss = 0.f;
#pragma unroll
    for (int i = 0; i < 4; ++i) {
      const int c = i * 256 + lane * 4;
      const f32x4 v = *(const f32x4*)(src + c);
      *(f32x4*)(h + (size_t)r * D + c) = v;
      *(uint2*)(hb + hbidx(r, c)) = pack4(v);
      ss += v[0] * v[0] + v[1] * v[1] + v[2] * v[2] + v[3] * v[3];
    }
#pragma unroll
    for (int o = 32; o >= 1; o >>= 1) ss += __shfl_xor(ss, o);
    if (r >= 16) { if (lane < 16) *ssq_slot(p, 0, lane, r) = lane == 0 ? ss : 0.f; }
    else *ssk_slot(p, 0, lane, r) = lane == 0 ? ss : 0.f;
  }
  { bf16_t* ug = (bf16_t*)(p.ws + OFF_UG);
    for (int i = gtid; i < NG * 48 * 16 / 2; i += gthreads) { const int g = i / 384, w = i - g * 384; *(unsigned*)(ug + (size_t)g * LU * 16 + w * 2) = 0u; } }
  float2* LP = (float2*)(p.ws + OFF_LP); float2* BB = (float2*)(p.ws + OFF_BB);
  for (int i = gtid; i < 4 * 2 * NG * NP * 65; i += gthreads) {
    const int j = i % 65, q = i / 65;
    const float lre = p.lam_re[q], lim = p.lam_im[q];
    const float dt = expf(p.log_dt[q >> 6]);
    const float a = lre * dt;
    double ang = (double)j * ((double)lim * (double)dt);
    ang -= 6.283185307179586477 * rint(ang * 0.15915494309189533577);
    const float ra = (float)ang;
    const float mag = expf((float)j * a);
    LP[i] = make_float2(mag * cosf(ra), mag * sinf(ra));
  }
  for (int i = gtid; i < 4 * 2 * NG * NP * 16; i += gthreads) {
    const int q = i >> 4;
    const float lre = p.lam_re[q], lim = p.lam_im[q];
    const float dt = expf(p.log_dt[q >> 6]);
    const float a = lre * dt, b = lim * dt;
    const float sh = sinf(0.5f * b);
    const float nr = expm1f(a) * cosf(b) - 2.f * sh * sh, ni = expf(a) * sinf(b);
    const float den = 1.f / (lre * lre + lim * lim);
    const float cr = (nr * lre + ni * lim) * den, ci = (ni * lre - nr * lim) * den;
    const float br = p.b_re[i], bi = p.b_im[i];
    BB[i] = make_float2(cr * br - ci * bi, cr * bi + ci * br);
  }
}

__device__ __forceinline__ void phase_prep(const Params& p, int l, int ubeg, int uend, int bskip, char* lds, int tid) {
  char* W = p.ws + OFF_W;
  float* ldsf = (float*)lds;
  const float2* LP = (const float2*)(p.ws + OFF_LP) + (size_t)l * 2 * NG * NP * 65;
  const float2* BB = (const float2*)(p.ws + OFF_BB) + (size_t)l * 2 * NG * NP * 16;
  const float* Cre = p.c_re + (size_t)l * 2 * NG * 16 * NP; const float* Cim = p.c_im + (size_t)l * 2 * NG * 16 * NP;
  bf16_t* Ktab = (bf16_t*)(p.ws + OFF_KTAB); bf16_t* Wend = (bf16_t*)(p.ws + OFF_WEND); bf16_t* Mcar = (bf16_t*)(p.ws + OFF_MCAR);
  if ((int)blockIdx.x < bskip) return;
  for (int u = ubeg + (int)blockIdx.x - bskip; u < uend; u += (int)gridDim.x - bskip) {
    if (u < 5952) {
      const float* src; bf16_t* dst; int K, N; const float* rs = nullptr; float sc = 1.f; int perm = 0; int t;
      if (u < 704) { t = u; src = p.ffn1_wg + (size_t)l * D * DFF; dst = (bf16_t*)(W + W_GU1); K = D; N = DFF; rs = p.ffn1_norm + l * D; perm = 1; }
      else if (u < 1408) { t = u - 704; src = p.ffn1_wu + (size_t)l * D * DFF; dst = (bf16_t*)(W + W_GU1); K = D; N = DFF; rs = p.ffn1_norm + l * D; perm = 2; }
      else if (u < 2112) { t = u - 1408; src = p.ffn1_wd + (size_t)l * D * DFF; dst = (bf16_t*)(W + W_D1); K = DFF; N = D; sc = 0.5f; }
      else if (u < 3136) { t = u - 2112; src = p.w_in + (size_t)l * D * 4096; dst = (bf16_t*)(W + W_IN); K = D; N = 4096; rs = p.mix_norm + l * D; }
      else if (u < 3200) { t = u - 3136; src = p.w_glu + (size_t)l * 512 * 512; dst = (bf16_t*)(W + W_GLU); K = 512; N = 512; }
      else if (u < 3328) { t = u - 3200; src = p.w_bs + (size_t)l * 512 * D; dst = (bf16_t*)(W + W_BS); K = 512; N = D; }
      else if (u < 3584) { t = u - 3328; src = p.w_ba + (size_t)l * D * D; dst = (bf16_t*)(W + W_BA); K = D; N = D; }
      else if (u < 3840) { t = u - 3584; src = p.w_out + (size_t)l * D * D; dst = (bf16_t*)(W + W_O); K = D; N = D; }
      else if (u < 4544) { t = u - 3840; src = p.ffn2_wg + (size_t)l * D * DFF; dst = (bf16_t*)(W + W_GU2); K = D; N = DFF; rs = p.ffn2_norm + l * D; perm = 1; }
      else if (u < 5248) { t = u - 4544; src = p.ffn2_wu + (size_t)l * D * DFF; dst = (bf16_t*)(W + W_GU2); K = D; N = DFF; rs = p.ffn2_norm + l * D; perm = 2; }
      else { t = u - 5248; src = p.ffn2_wd + (size_t)l * D * DFF; dst = (bf16_t*)(W + W_D2); K = DFF; N = D; sc = 0.5f; }
      const int nkt = K >> 6; const int kt = t % nkt, nt = t / nkt;
      __syncthreads();
      f32x4 tv[4]; float tsc[4];
#pragma unroll
      for (int i = 0; i < 4; ++i) {
        const int idx = tid + 256 * i, kk = idx >> 4, n4 = idx & 15;
        tv[i] = *(const f32x4*)(src + (size_t)(kt * 64 + kk) * N + nt * 64 + n4 * 4);
        tsc[i] = rs ? rs[kt * 64 + kk] * sc : sc;
      }
#pragma unroll
      for (int i = 0; i < 4; ++i) {
        const int idx = tid + 256 * i, kk = idx >> 4, n4 = idx & 15;
        float* d4 = ldsf + kk * 65 + n4 * 4;
        d4[0] = tv[i][0] * tsc[i]; d4[1] = tv[i][1] * tsc[i]; d4[2] = tv[i][2] * tsc[i]; d4[3] = tv[i][3] * tsc[i];
      }
      __syncthreads();
      const int n = tid >> 2, kq = tid & 3;
      unsigned w[8];
#pragma unroll
      for (int j = 0; j < 8; ++j) w[j] = cvt_pk_bf16(ldsf[(kq * 16 + 2 * j) * 65 + n], ldsf[(kq * 16 + 2 * j + 1) * 65 + n]);
      int R = nt * 64 + n;
      if (perm) { const int tn = R >> 7, wn = (R >> 6) & 1, pr = (R >> 5) & 1, xx = R & 31; R = tn * 256 + wn * 128 + pr * 64 + xx + (perm == 2 ? 32 : 0); }
      const int k0 = kt * 64 + kq * 16;
      uint4* d = (uint4*)(dst + (((size_t)(R >> 8) * (K >> 5) + (k0 >> 5)) * 256 + (R & 255)) * 32 + (k0 & 31));
      d[0] = make_uint4(w[0], w[1], w[2], w[3]); d[1] = make_uint4(w[4], w[5], w[6], w[7]);
    } else if (u < 6464) {
      const int v = u - 5952, g = v >> 4, dd0 = (v & 15) * 8;
      float2* Cs = (float2*)lds;
      float2* Ws = (float2*)(lds + 16384);
      __syncthreads();
      for (int i = tid; i < 2048; i += 256) { const int dr = i >> 10, c = (i >> 6) & 15, pp = i & 63; const size_t ci = (size_t)((dr * NG + g) * 16 + c) * NP + pp; Cs[i] = make_float2(Cre[ci], Cim[ci]); }
      for (int j = 0; j < 8; ++j) {
        const int dd = dd0 + j; if (dd >= 127) break;
        const int d = dd - 63;
        __syncthreads();
#pragma unroll
        for (int ii = 0; ii < 8; ++ii) {
          const int i = tid + 256 * ii, dr = i >> 10, pp = (i >> 4) & 63, c2 = i & 15;
          const bool need = dr == 0 ? d >= 0 : d <= 0;
          float2 w = make_float2(0.f, 0.f);
          if (need) { const float2 a = LP[((size_t)(dr * NG + g) * NP + pp) * 65 + (d < 0 ? -d : d)], bb = BB[((size_t)(dr * NG + g) * NP + pp) * 16 + c2]; w = make_float2(a.x * bb.x - a.y * bb.y, a.x * bb.y + a.y * bb.x); }
          Ws[i] = w;
        }
        __syncthreads();
        const int c = tid >> 4, c2 = tid & 15;
        float sum = 0.f;
#pragma unroll 8
        for (int i = 0; i < 128; ++i) { const float2 cc = Cs[(i >> 6) * 1024 + c * 64 + (i & 63)], w = Ws[i * 16 + c2]; sum += cc.x * w.x - cc.y * w.y; }
        Ktab[((size_t)g * 127 + dd) * 256 + tid] = (bf16_t)(cvt_pk_bf16(sum, 0.f) & 0xffffu);
      }
    } else if (u < 8512) {
      const int v = u - 6464;
      const size_t e0 = ((size_t)v * 256 + tid) * 16;
      const int kk = (int)(e0 & 1023), pr = (int)((e0 >> 10) & 255), g = (int)(e0 >> 18);
      const int dr = pr >> 7, ri = (pr >> 6) & 1, pp = pr & 63, s = kk >> 4, c0 = kk & 15;
      const float2 a = LP[((size_t)(dr * NG + g) * NP + pp) * 65 + (dr ? s : 63 - s)];
      const float2* bb = BB + ((size_t)(dr * NG + g) * NP + pp) * 16 + c0;
      float o[16];
#pragma unroll
      for (int j = 0; j < 16; ++j) { const float2 b = bb[j]; o[j] = ri ? (a.x * b.y + a.y * b.x) : (a.x * b.x - a.y * b.y); }
      *(uint4*)(Wend + e0) = make_uint4(cvt_pk_bf16(o[0], o[1]), cvt_pk_bf16(o[2], o[3]), cvt_pk_bf16(o[4], o[5]), cvt_pk_bf16(o[6], o[7]));
      *(uint4*)(Wend + e0 + 8) = make_uint4(cvt_pk_bf16(o[8], o[9]), cvt_pk_bf16(o[10], o[11]), cvt_pk_bf16(o[12], o[13]), cvt_pk_bf16(o[14], o[15]));
    } else {
      const int v = u - 8512;
      const size_t e0 = ((size_t)v * 256 + tid) * 16;
      const int pr = (int)(e0 & 255), n = (int)((e0 >> 8) & 1023), g = (int)(e0 >> 18);
      const int dr = pr >> 7, ri = (pr >> 6) & 1, p0 = pr & 63, t = n >> 4, c = n & 15;
      const int e = dr ? 64 - t : t + 1;
      const float* cr = Cre + (size_t)((dr * NG + g) * 16 + c) * NP + p0; const float* ci = Cim + (size_t)((dr * NG + g) * 16 + c) * NP + p0;
      float o[16];
#pragma unroll
      for (int j = 0; j < 16; ++j) { const float2 a = LP[((size_t)(dr * NG + g) * NP + p0 + j) * 65 + e]; o[j] = ri ? -(cr[j] * a.y + ci[j] * a.x) : (cr[j] * a.x - ci[j] * a.y); }
      *(uint4*)(Mcar + e0) = make_uint4(cvt_pk_bf16(o[0], o[1]), cvt_pk_bf16(o[2], o[3]), cvt_pk_bf16(o[4], o[5]), cvt_pk_bf16(o[6], o[7]));
      *(uint4*)(Mcar + e0 + 8) = make_uint4(cvt_pk_bf16(o[8], o[9]), cvt_pk_bf16(o[10], o[11]), cvt_pk_bf16(o[12], o[13]), cvt_pk_bf16(o[14], o[15]));
    }
  }
}

__device__ __forceinline__ void phase_ffn_up(const Params& p, const bf16_t* Wgu, int si, char* lds, int tid) {
  const bf16_t* hb = (const bf16_t*)(p.ws + OFF_HB); bf16_t* act = (bf16_t*)(p.ws + OFF_ACT);
  const int lane = tid & 63, wave = tid >> 6, wm = wave >> 1, wn = wave & 1, lrow = tid >> 2, lch = tid & 3; int le = lane;
  constexpr int nN = 22;
  const int nit = tile_iters(nN);
  const bool split_last = (((128 / ((int)gridDim.x >> 4)) * (nN >> 1)) & 7) == 4 && s_vb_even;
  for (int it = 0; it < nit + 1; ++it) {
    if (it == nit - 1 && split_last) {
      const int xr = s_vb & 7, hsel = xr >> 2;
      int tm, tn; if (!tile_of(it, nN, tm, tn, xr & 3)) continue;
      const int m0 = 16 + tm * 128;
      f32x16 acc[2][2];
#pragma unroll
      for (int a_ = 0; a_ < 2; ++a_)
#pragma unroll
        for (int b_ = 0; b_ < 2; ++b_)
#pragma unroll
          for (int r_ = 0; r_ < 16; ++r_) acc[a_][b_][r_] = 0.f;
      int tl = tid; asm volatile("" : "+v"(tl));
      const int lrow = tl >> 2, lch = tl & 3;
      float* rsl = (float*)(lds + 2 * GSTAGE) + (it & 1) * 128;
      if (tid < 128) rsl[tid] = row_rstd(p, si, m0 + tid);
      gemm_acc_h(acc, hb + ((size_t)tm * 32 * 128 + lrow) * 32 + lch * 8, 32, 4096, Wgu + ((size_t)tn * 32 * 256 + hsel * 128 + lrow) * 32 + lch * 8, 32, 8192, 32, lds, tid);
      LAUNDER_LANE();
#pragma unroll
      for (int mi = 0; mi < 2; ++mi) {
        const float rs = rsl[wm * 64 + mi * 32 + (le & 31)];
#pragma unroll
        for (int q = 0; q < 4; ++q) {
          f32x4 o;
#pragma unroll
          for (int j = 0; j < 4; ++j) { const float g = acc[mi][0][4 * q + j] * rs, uu = acc[mi][1][4 * q + j] * rs; o[j] = g * sigmoidf_(g) * uu; }
          *(uint2*)(act + blkfast(tm, 88, tn * 4 + hsel * 2 + wn, (wm * 64 + mi * 32 + (le & 31)) * 32 + 8 * q + 4 * (le >> 5))) = pack4(o);
        }
      }
    } else if (it < nit) {
      int tm, tn; if (!tile_of(it, nN, tm, tn)) continue;
      const int m0 = 16 + tm * 128;
      f32x16 acc[2][4]; zero_acc(acc);
      int tl = tid; asm volatile("" : "+v"(tl));
      const int lrow = tl >> 2, lch = tl & 3;
      float* rsl = (float*)(lds + 2 * GSTAGE) + (it & 1) * 128;
      if (tid < 128) rsl[tid] = row_rstd(p, si, m0 + tid);
      gemm_acc(acc, hb + ((size_t)tm * 32 * 128 + lrow) * 32 + lch * 8, 32, 4096, Wgu + ((size_t)tn * 32 * 256 + lrow) * 32 + lch * 8, 32, 8192, 32, lds, tid);
      LAUNDER_LANE();
#pragma unroll
      for (int mi = 0; mi < 2; ++mi) {
        const int row = m0 + wm * 64 + mi * 32 + (le & 31);
        const float rs = rsl[wm * 64 + mi * 32 + (le & 31)];
#pragma unroll
        for (int pr = 0; pr < 2; ++pr)
#pragma unroll
        for (int q = 0; q < 4; ++q) {
          f32x4 o;
#pragma unroll
          for (int j = 0; j < 4; ++j) { const float g = acc[mi][2 * pr][4 * q + j] * rs, uu = acc[mi][2 * pr + 1][4 * q + j] * rs; o[j] = g * sigmoidf_(g) * uu; }
          *(uint2*)(act + blkfast(tm, 88, tn * 4 + wn * 2 + pr, (wm * 64 + mi * 32 + (le & 31)) * 32 + 8 * q + 4 * (le >> 5))) = pack4(o);
        }
      }
    } else for (int v = sk_first(); v < 176; v += gridDim.x) {
      {
      const int c0 = v * 16, tn = c0 >> 7, wnn = (c0 >> 6) & 1, pr = (c0 >> 5) & 1, x0 = c0 & 31;
      const int Rg = tn * 256 + wnn * 128 + pr * 64 + x0;
      auto xa = [&](int m, int kc) { return hb + (((size_t)128 * 32 + (kc >> 2)) * 128 + m) * 32 + (kc & 3) * 8; };
      auto wg = [&](int n, int kc) { return wblk(Wgu, 32, Rg + n, kc); };
      auto wu = [&](int n, int kc) { return wblk(Wgu, 32, Rg + 32 + n, kc); };
      const f32x4 ag = skinny_acc(xa, wg, 32, lds, tid);
      const f32x4 au = skinny_acc(xa, wu, 32, lds, tid);
      if (wave == 0) {
        const int row = lane & 15;
        const float rs = row_rstd(p, si, row);
        f32x4 o;
#pragma unroll
        for (int j = 0; j < 4; ++j) { const float g = ag[j] * rs, uu = au[j] * rs; o[j] = g * sigmoidf_(g) * uu; }
        *(uint2*)(act + blkidx(row, c0 + 4 * (lane >> 4), 88)) = pack4(o);
      }
      }
    }
  }
}

__device__ __forceinline__ void resid_store(float* h, bf16_t* hb, int row, int col, f32x4 a, float& ss) {
  float* hp = h + (size_t)row * D + col;
  f32x4 hv = *(const f32x4*)hp;
  hv += a;
  *(f32x4*)hp = hv;
  *(uint2*)(hb + hbidx(row, col)) = pack4(hv);
  ss += hv[0] * hv[0] + hv[1] * hv[1] + hv[2] * hv[2] + hv[3] * hv[3];
}
__device__ __forceinline__ void phase_resid(const Params& p, const bf16_t* A, int K, const bf16_t* Wt, int si_next, char* lds, int tid) {
  float* h = (float*)(p.ws + OFF_H); bf16_t* hb = (bf16_t*)(p.ws + OFF_HB);
  const int lane = tid & 63, wave = tid >> 6, wm = wave >> 1, wn = wave & 1, lrow = tid >> 2, lch = tid & 3; int le = lane;
  constexpr int nN = 4;
  const int nit = tile_iters(nN);
  for (int it = 0; it < nit + 1; ++it) {
    if (it < nit) {
      int tm, tn; if (!tile_of(it, nN, tm, tn)) continue;
      const int m0 = 16 + tm * 128;
      f32x16 acc[2][4]; zero_acc(acc);
      int tl = tid; asm volatile("" : "+v"(tl));
      const int lrow = tl >> 2, lch = tl & 3;
      gemm_acc(acc, A + ((size_t)tm * (K >> 5) * 128 + lrow) * 32 + lch * 8, 32, 4096, Wt + ((size_t)tn * (K >> 5) * 256 + lrow) * 32 + lch * 8, 32, 8192, K >> 5, lds, tid);
      LAUNDER_LANE();
#pragma unroll
      for (int mi = 0; mi < 2; ++mi) {
        const int row = m0 + wm * 64 + mi * 32 + (le & 31);
#pragma unroll
        for (int hf = 0; hf < 2; ++hf) {
        float ss = 0.f;
        f32x4 hv[2][4];
#pragma unroll
        for (int ni = 0; ni < 2; ++ni)
#pragma unroll
          for (int q = 0; q < 4; ++q) {
            hv[ni][q] = *(const f32x4*)(h + (size_t)row * D + tn * 256 + wn * 128 + (2 * hf + ni) * 32 + 8 * q + 4 * (le >> 5));
          }
#pragma unroll
        for (int ni = 0; ni < 2; ++ni)
#pragma unroll
          for (int q = 0; q < 4; ++q) {
            f32x4 a; a[0] = acc[mi][2 * hf + ni][4 * q]; a[1] = acc[mi][2 * hf + ni][4 * q + 1]; a[2] = acc[mi][2 * hf + ni][4 * q + 2]; a[3] = acc[mi][2 * hf + ni][4 * q + 3];
            const int col = tn * 256 + wn * 128 + (2 * hf + ni) * 32 + 8 * q + 4 * (le >> 5);
            const f32x4 hn = hv[ni][q] + a;
            *(f32x4*)(h + (size_t)row * D + col) = hn;
            *(uint2*)(hb + blkfast(tm, 32, tn * 8 + wn * 4 + 2 * hf + ni, (wm * 64 + mi * 32 + (le & 31)) * 32 + 8 * q + 4 * (le >> 5))) = pack4(hn);
            ss += hn[0] * hn[0] + hn[1] * hn[1] + hn[2] * hn[2] + hn[3] * hn[3];
          }
        ss += __shfl_xor(ss, 32);
        if (lane < 32) *ssq_slot(p, si_next, tn * 4 + wn * 2 + hf, row) = ss;
        asm volatile("" ::: "memory");
        }
      }
    } else for (int v = sk_first(); v < 64; v += gridDim.x) {
      {
      const int c0 = v * 16;
      auto xa = [&](int m, int kc) { return A + (((size_t)128 * (K >> 5) + (kc >> 2)) * 128 + m) * 32 + (kc & 3) * 8; };
      auto wa = [&](int n, int kc) { return wblk(Wt, K >> 5, c0 + n, kc); };
      const f32x4 a = skinny_acc(xa, wa, K >> 5, lds, tid);
      if (wave == 0) {
        const int row = lane & 15;
        float ss = 0.f;
        resid_store(h, hb, row, c0 + 4 * (lane >> 4), a, ss);
        ss += __shfl_xor(ss, 16); ss += __shfl_xor(ss, 32);
        if (lane < 16) *ssk_slot(p, si_next, c0 >> 4, row) = ss;
      }
      }
    }
  }
}

template <int SEL>
__device__ __forceinline__ void win_store(const Params& p, int row, int col, f32x4 a, float rs) {
  a *= rs;
  if (SEL == 0) { a *= 0.125f; *(uint2*)((bf16_t*)(p.ws + OFF_Q) + (size_t)row * D + col) = pack4(a); }
  else if (SEL == 1) { *(uint2*)((bf16_t*)(p.ws + OFF_K) + (size_t)row * 256 + (col - 1024)) = pack4(a); }
  else if (SEL == 2) {
    bf16_t* vt = (bf16_t*)(p.ws + OFF_VT) + (size_t)(col - 1280) * LV + row + 48;
    const uint2 w = pack4(a);
    vt[0] = (bf16_t)(w.x & 0xffffu); vt[LV] = (bf16_t)(w.x >> 16); vt[2 * LV] = (bf16_t)(w.y & 0xffffu); vt[3 * LV] = (bf16_t)(w.y >> 16);
  } else if (SEL == 3) {
    const int cc = col - 1536, g = cc >> 4, c = cc & 15;
    *(uint2*)((bf16_t*)(p.ws + OFF_UG) + ((size_t)g * LU + row + 48) * 16 + c) = pack4(a);
  } else {
    const f32x4 s = a;
    bf16_t* dst = (bf16_t*)(p.ws + (SEL == 4 ? OFF_GS : OFF_GA)) + (size_t)row * D + (col - (SEL == 4 ? 2048 : 3072));
    *(uint2*)dst = pack4(s);
  }
}
template <int SEL>
__device__ __forceinline__ void win_epi(const Params& p, const f32x16 (&acc)[2][4], const float* rsl, int m0, int tn, int tid) {
  const int lane = tid & 63, wave = tid >> 6, wm = wave >> 1, wn = wave & 1; int le = lane; LAUNDER_LANE();
#pragma unroll
  for (int mi = 0; mi < 2; ++mi) {
    const int row = m0 + wm * 64 + mi * 32 + (le & 31);
    const float rs = rsl[wm * 64 + mi * 32 + (le & 31)];
#pragma unroll
    for (int ni = 0; ni < 4; ++ni)
#pragma unroll
      for (int q = 0; q < 4; ++q) {
        f32x4 a; a[0] = acc[mi][ni][4 * q]; a[1] = acc[mi][ni][4 * q + 1]; a[2] = acc[mi][ni][4 * q + 2]; a[3] = acc[mi][ni][4 * q + 3];
        win_store<SEL>(p, row, tn * 256 + wn * 128 + ni * 32 + 8 * q + 4 * (le >> 5), a, rs);
      }
  }
}
__device__ __forceinline__ int win_sel(int col) { return col < 1024 ? 0 : col < 1280 ? 1 : col < 1536 ? 2 : col < 2048 ? 3 : col < 3072 ? 4 : 5; }
__device__ __forceinline__ void phase_win(const Params& p, int si, char* lds, int tid) {
  const bf16_t* hb = (const bf16_t*)(p.ws + OFF_HB); const bf16_t* Wt = (const bf16_t*)(p.ws + OFF_W + W_IN);
  const int lane = tid & 63, wave = tid >> 6, wm = wave >> 1, wn = wave & 1, lrow = tid >> 2, lch = tid & 3; int le = lane;
  constexpr int nN = 16;
  const int nit = tile_iters(nN);
  for (int it = 0; it < nit + 1; ++it) {
    if (it < nit) {
      int tm, tn; if (!tile_of(it, nN, tm, tn)) continue;
      const int m0 = 16 + tm * 128;
      f32x16 acc[2][4]; zero_acc(acc);
      int tl = tid; asm volatile("" : "+v"(tl));
      const int lrow = tl >> 2, lch = tl & 3;
      float* rsl = (float*)(lds + 2 * GSTAGE) + (it & 1) * 128;
      if (tid < 128) rsl[tid] = row_rstd(p, si, m0 + tid);
      gemm_acc(acc, hb + ((size_t)tm * 32 * 128 + lrow) * 32 + lch * 8, 32, 4096, Wt + ((size_t)tn * 32 * 256 + lrow) * 32 + lch * 8, 32, 8192, 32, lds, tid);
      LAUNDER_LANE();
      switch (win_sel(tn * 256)) {
        case 0: win_epi<0>(p, acc, rsl, m0, tn, tid); break;
        case 1: win_epi<1>(p, acc, rsl, m0, tn, tid); break;
        case 2: win_epi<2>(p, acc, rsl, m0, tn, tid); break;
        case 3: win_epi<3>(p, acc, rsl, m0, tn, tid); break;
        case 4: win_epi<4>(p, acc, rsl, m0, tn, tid); break;
        default: win_epi<5>(p, acc, rsl, m0, tn, tid); break;
      }
    } else for (int v = sk_first(); v < 256; v += gridDim.x) {
      {
      const int c0 = v * 16;
      auto xa = [&](int m, int kc) { return hb + (((size_t)128 * 32 + (kc >> 2)) * 128 + m) * 32 + (kc & 3) * 8; };
      auto wa = [&](int n, int kc) { return wblk(Wt, 32, c0 + n, kc); };
      const f32x4 a = skinny_acc(xa, wa, 32, lds, tid);
      if (wave == 0) {
        const int row = lane & 15;
        const float rs = row_rstd(p, si, row);
        const int cc = c0 + 4 * (lane >> 4);
        switch (win_sel(c0)) {
          case 0: win_store<0>(p, row, cc, a, rs); break;
          case 1: win_store<1>(p, row, cc, a, rs); break;
          case 2: win_store<2>(p, row, cc, a, rs); break;
          case 3: win_store<3>(p, row, cc, a, rs); break;
          case 4: win_store<4>(p, row, cc, a, rs); break;
          default: win_store<5>(p, row, cc, a, rs); break;
        }
      }
      }
    }
  }
}

__device__ __forceinline__ void attn_unit(const Params& p, int l, int b, int h, char* lds, int tid) {
  const bf16_t* Q = (const bf16_t*)(p.ws + OFF_Q); const bf16_t* Kb = (const bf16_t*)(p.ws + OFF_K); const bf16_t* VT = (const bf16_t*)(p.ws + OFF_VT);
  bf16_t* YA = (bf16_t*)(p.ws + OFF_YA);
  const int lane = tid & 63, wave = tid >> 6, r31 = lane & 31, hh = lane >> 5;
  const int kv = h >> 2;
  const float slope = exp2f(-0.5f * (float)(h + 1));
  const float sinkv = p.sink[l * 16 + h];
  const int q0 = b * 128 + wave * 32;
  const int qx = q0 + r31;
  const bool wactive = (b >= 0) || (wave == 3);
  int qseq = qx + 16; const bool qvalid = qseq >= 0; if (qseq < 0) qseq = 0;
  bf16x8 qf[4];
#pragma unroll
  for (int kk = 0; kk < 4; ++kk) qf[kk] = *(const bf16x8*)(Q + (size_t)qseq * D + h * 64 + kk * 16 + 8 * hh);
  f32x16 o[2];
#pragma unroll
  for (int r = 0; r < 16; ++r) { o[0][r] = 0.f; o[1][r] = 0.f; }
  float m = sinkv, lsum = hh == 0 ? 1.f : 0.f;
  const int swz = (r31 >> 1) & 7;
  for (int st = 0; st < 4; ++st) {
    const int kb = b - 2 + st;
    if (st != 0 && (kb < 0 || kb >= 128)) continue;
    const int kseq0 = st == 0 ? 0 : kb * 128 + 16;
    __syncthreads();
    {
      const int nrow = st == 0 ? 32 : 128;
#pragma unroll
      for (int i = 0; i < 4; ++i) {
        const int row = (tid >> 3) + 32 * i;
        if (row < nrow) *(uint4*)(lds + lds_off(row, tid & 7)) = *(const uint4*)(Kb + (size_t)(kseq0 + row) * 256 + kv * 64 + (tid & 7) * 8);
      }
      const int nkc = st == 0 ? 4 : 16;
#pragma unroll
      for (int i = 0; i < 4; ++i) {
        const int d = (tid >> 4) + 16 * i, kc = tid & 15;
        if (kc < nkc) {
          const uint4 v = *(const uint4*)(VT + (size_t)(kv * 64 + d) * LV + kseq0 + 48 + kc * 8);
          char* dst = lds + 16384 + d * 264 + kc * 16;
          *(uint2*)dst = make_uint2(v.x, v.y); *(uint2*)(dst + 8) = make_uint2(v.z, v.w);
        }
      }
    }
    __syncthreads();
    if (!wactive) continue;
    const int nj = st == 0 ? 1 : 4;
    for (int j = 0; j < nj; ++j) {
      const int kx0 = st == 0 ? 0 : kb * 128 + 32 * j;
      if (st != 0 && (kx0 + 31 < q0 - 128 || kx0 > q0 + 31 + 128)) continue;
      f32x16 s;
#pragma unroll
      for (int r = 0; r < 16; ++r) s[r] = 0.f;
#pragma unroll
      for (int kk = 0; kk < 4; ++kk) {
        const bf16x8 a = *(const bf16x8*)(lds + (32 * j + r31) * 128 + (((kk * 2 + hh) ^ swz) << 4));
        s = __builtin_amdgcn_mfma_f32_32x32x16_bf16(a, qf[kk], s, 0, 0, 0);
      }
      float tmax = -1e30f;
#pragma unroll
      for (int r = 0; r < 16; ++r) {
        const int key = 8 * (r >> 2) + 4 * hh + (r & 3);
        float sv; bool valid;
        if (st == 0) { valid = key < 16; sv = s[r]; }
        else { int dist = qx - (kx0 + key); dist = dist < 0 ? -dist : dist; valid = dist <= 128; sv = s[r] - slope * (float)dist; }
        sv = valid ? sv : -1e30f;
        s[r] = sv; tmax = fmaxf(tmax, sv);
      }
      tmax = fmaxf(tmax, __shfl_xor(tmax, 32));
      const float mnew = fmaxf(m, tmax);
      const float alpha = __expf(m - mnew);
      m = mnew;
      float psum = 0.f;
#pragma unroll
      for (int r = 0; r < 16; ++r) { s[r] = __expf(s[r] - mnew); psum += s[r]; }
      lsum = lsum * alpha + psum;
#pragma unroll
      for (int r = 0; r < 16; ++r) { o[0][r] *= alpha; o[1][r] *= alpha; }
      bf16x8 pf[2];
#pragma unroll
      for (int s2 = 0; s2 < 2; ++s2) {
        unsigned w0 = cvt_pk_bf16(s[8 * s2 + 0], s[8 * s2 + 1]), w1 = cvt_pk_bf16(s[8 * s2 + 2], s[8 * s2 + 3]);
        unsigned w2 = cvt_pk_bf16(s[8 * s2 + 4], s[8 * s2 + 5]), w3 = cvt_pk_bf16(s[8 * s2 + 6], s[8 * s2 + 7]);
        uint4 t = make_uint4(w0, w1, w2, w3);
        pf[s2] = *(bf16x8*)&t;
      }
#pragma unroll
      for (int s2 = 0; s2 < 2; ++s2)
#pragma unroll
        for (int di = 0; di < 2; ++di) {
          const char* vrow = lds + 16384 + (32 * di + r31) * 264 + (32 * j + 16 * s2 + 4 * hh) * 2;
          const uint2 lo = *(const uint2*)vrow, hi = *(const uint2*)(vrow + 16);
          uint4 t = make_uint4(lo.x, lo.y, hi.x, hi.y);
          o[di] = __builtin_amdgcn_mfma_f32_32x32x16_bf16(*(bf16x8*)&t, pf[s2], o[di], 0, 0, 0);
        }
    }
  }
  if (wactive) {
    const float lt = lsum + __shfl_xor(lsum, 32);
    const float inv = 1.0f / lt;
    if (qvalid) {
#pragma unroll
      for (int di = 0; di < 2; ++di)
#pragma unroll
        for (int q = 0; q < 4; ++q) {
          f32x4 a; a[0] = o[di][4 * q] * inv; a[1] = o[di][4 * q + 1] * inv; a[2] = o[di][4 * q + 2] * inv; a[3] = o[di][4 * q + 3] * inv;
          *(uint2*)(YA + blkidx(qseq, h * 64 + 32 * di + 8 * q + 4 * hh, 32)) = pack4(a);
        }
    }
  }
}

__device__ __forceinline__ void phase_attn_xend(const Params& p, int l, char* lds, int tid) {
  const bf16_t* ug = (const bf16_t*)(p.ws + OFF_UG); const bf16_t* Wend = (const bf16_t*)(p.ws + OFF_WEND); float* Xend = (float*)(p.ws + OFF_XEND);
  const int lane = tid & 63, wave = tid >> 6, wm = wave >> 1, wn = wave & 1, lrow = tid >> 2, lch = tid & 3; int le = lane;
  constexpr int NATT = 2048 + 16, NXM = 64, NXS = 512;
  unsigned* ctr = (unsigned*)(p.ws + OFF_BAR) + 2304 + 64 * l;
  if (tid == 0) s_unit = (int)__hip_atomic_fetch_add(ctr, 1u, __ATOMIC_RELAXED, __HIP_MEMORY_SCOPE_AGENT);
  __syncthreads();
  int uq = s_unit;
  __syncthreads();
  while (uq < NATT + NXM + NXS) {
    if (tid == 0) s_unit = (int)__hip_atomic_fetch_add(ctr, 1u, __ATOMIC_RELAXED, __HIP_MEMORY_SCOPE_AGENT);
    const int u = uq < NXM ? NATT + uq : (uq < NXM + NATT ? uq - NXM : uq);
    if (u < NATT) {
      if (u < 2048) attn_unit(p, l, u >> 4, u & 15, lds, tid); else attn_unit(p, l, -1, u - 2048, lds, tid);
    } else if (u < NATT + NXM) {
      const int v = u - NATT, g = v >> 1, tm = v & 1;
      const int k0 = 1 + tm * 128;
      f32x16 acc[2][4]; zero_acc(acc);
      int tl = tid; asm volatile("" : "+v"(tl));
      const int lrow = tl >> 2, lch = tl & 3;
      gemm_acc(acc, ug + ((size_t)g * LU + (size_t)(k0 + lrow) * 64) * 16 + lch * 8, 1024, 32,
               Wend + ((size_t)g * 256 + lrow) * 1024 + lch * 8, 1024, 32, 32, lds, tid);
      LAUNDER_LANE();
#pragma unroll
      for (int mi = 0; mi < 2; ++mi) {
        const int k = k0 + wm * 64 + mi * 32 + (le & 31);
#pragma unroll
        for (int ni = 0; ni < 4; ++ni)
#pragma unroll
          for (int q = 0; q < 4; ++q) {
            f32x4 a; a[0] = acc[mi][ni][4 * q]; a[1] = acc[mi][ni][4 * q + 1]; a[2] = acc[mi][ni][4 * q + 2]; a[3] = acc[mi][ni][4 * q + 3];
            *(f32x4*)(Xend + ((size_t)g * NCH + k) * 256 + wn * 128 + ni * 32 + 8 * q + 4 * (le >> 5)) = a;
          }
      }
    } else {
      {
      const int v = u - NATT - NXM, g = v >> 4, c0 = (v & 15) * 16;
      auto xa = [&](int m, int kc) { return ug + (size_t)g * LU * 16 + kc * 8; };
      auto wa = [&](int n, int kc) { return Wend + ((size_t)g * 256 + c0 + n) * 1024 + kc * 8; };
      const f32x4 a = skinny_acc(xa, wa, 32, lds, tid);
      if (wave == 0 && (lane & 15) == 0) *(f32x4*)(Xend + ((size_t)g * NCH + 0) * 256 + c0 + 4 * (lane >> 4)) = a;
      }
    }
    __syncthreads();
    uq = s_unit;
    __syncthreads();
  }
}

__device__ __forceinline__ void phase_scan(const Params& p, int l, int tid) {
  const float* Xend = (const float*)(p.ws + OFF_XEND); bf16_t* Xin = (bf16_t*)(p.ws + OFF_XIN);
  const float2* LP = (const float2*)(p.ws + OFF_LP) + (size_t)l * 2 * NG * NP * 65;
  const int gt = blockIdx.x * 256 + tid;
  if (gt >= 2 * NG * NP) return;
  const int pp = gt & 63, g = (gt >> 6) & 31, dr = gt >> 11;
  const float2 lam = LP[((size_t)(dr * NG + g) * NP + pp) * 65 + 64];
  const float* xe = Xend + (size_t)g * NCH * 256 + dr * 128 + pp;
  bf16_t* xi = Xin + (size_t)g * NCH * 256 + dr * 128 + pp;
  float xr = 0.f, xim = 0.f;
  for (int i0 = 0; i0 < NCH; i0 += 16) {
    float er[16], ei[16];
#pragma unroll
    for (int j = 0; j < 16; ++j) { const int i = i0 + j; const int ic = i < NCH ? i : NCH - 1; const int k = dr ? (NCH - 1 - ic) : ic; er[j] = xe[(size_t)k * 256]; ei[j] = xe[(size_t)k * 256 + 64]; }
#pragma unroll
    for (int j = 0; j < 16; ++j) {
      const int i = i0 + j; const int k = dr ? (NCH - 1 - i) : i;
      if (i < NCH) {
        xi[(size_t)k * 256] = (bf16_t)(cvt_pk_bf16(xr, 0.f) & 0xffffu); xi[(size_t)k * 256 + 64] = (bf16_t)(cvt_pk_bf16(xim, 0.f) & 0xffffu);
        const float nr = lam.x * xr - lam.y * xim + er[j], ni = lam.x * xim + lam.y * xr + ei[j];
        xr = nr; xim = ni;
      }
    }
  }
}

__device__ __forceinline__ uint2 ssm_load_u(const Params& p, int g, int k, int n) {
  const int t = n >> 4, c = n & 15;
  return *(const uint2*)((const bf16_t*)(p.ws + OFF_UG) + ((size_t)g * LU + 64 * k + t) * 16 + c);
}
__device__ __forceinline__ void ssm_store(const Params& p, int l, int g, int k, int n, f32x4 a, uint2 uw) {
  const int t = n >> 4, c = n & 15;
  const int pos = 64 * k + t, seq = pos - 48;
  if (seq < 0) return;
  const f32x4 dv = *(const f32x4*)(p.ssm_d + l * 512 + g * 16 + c);
  f32x4 y;
  y[0] = a[0] + dv[0] * __uint_as_float(uw.x << 16); y[1] = a[1] + dv[1] * __uint_as_float(uw.x & 0xffff0000u);
  y[2] = a[2] + dv[2] * __uint_as_float(uw.y << 16); y[3] = a[3] + dv[3] * __uint_as_float(uw.y & 0xffff0000u);
  y[0] = gelu_tanh(y[0]); y[1] = gelu_tanh(y[1]); y[2] = gelu_tanh(y[2]); y[3] = gelu_tanh(y[3]);
  *(uint2*)((bf16_t*)(p.ws + OFF_Z) + ((size_t)g * LZ + seq) * 16 + c) = pack4(y);
}
__device__ __forceinline__ void phase_ssm_out(const Params& p, int l, char* lds, int tid) {
  const bf16_t* ug = (const bf16_t*)(p.ws + OFF_UG); const bf16_t* Ktab = (const bf16_t*)(p.ws + OFF_KTAB);
  const bf16_t* Mcar = (const bf16_t*)(p.ws + OFF_MCAR); const bf16_t* Xin = (const bf16_t*)(p.ws + OFF_XIN);
  const int lane = tid & 63, wave = tid >> 6, wm = wave >> 1, wn = wave & 1, lrow = tid >> 2, lch = tid & 3; int le = lane;
  constexpr int NMAIN = 256, NSK = 512;
  for (int u = blockIdx.x; u < NMAIN + NSK; u += gridDim.x) {
    if (u < NMAIN) {
      const int g = u >> 3, tm = u & 1, tn = (u >> 1) & 3;
      const int k0 = 1 + tm * 128, n0 = tn * 256;
      f32x16 acc[2][4]; zero_acc(acc);
      int tl = tid; asm volatile("" : "+v"(tl));
      const int lrow = tl >> 2, lch = tl & 3;
      gemm_acc(acc, ug + ((size_t)g * LU + (size_t)(k0 + lrow) * 64) * 16 + lch * 8, 1024, 32,
               Ktab + (size_t)g * 127 * 256 + (size_t)(n0 + lrow) * 16 + (63 - (lch >> 1)) * 256 + (lch & 1) * 8, 16, -512, 32, lds, tid);
      LAUNDER_LANE();
      gemm_acc(acc, Xin + ((size_t)g * NCH + k0 + lrow) * 256 + lch * 8, 256, 32,
               Mcar + ((size_t)g * 1024 + n0 + lrow) * 256 + lch * 8, 256, 32, 8, lds, tid);
      LAUNDER_LANE();
#pragma unroll
      for (int mi = 0; mi < 2; ++mi) {
        const int k = k0 + wm * 64 + mi * 32 + (le & 31);
#pragma unroll
        for (int hf = 0; hf < 2; ++hf) {
        uint2 uw[2][4];
#pragma unroll
        for (int ni = 0; ni < 2; ++ni)
#pragma unroll
          for (int q = 0; q < 4; ++q) uw[ni][q] = ssm_load_u(p, g, k, n0 + wn * 128 + (2 * hf + ni) * 32 + 8 * q + 4 * (le >> 5));
#pragma unroll
        for (int ni = 0; ni < 2; ++ni)
#pragma unroll
          for (int q = 0; q < 4; ++q) {
            f32x4 a; a[0] = acc[mi][2 * hf + ni][4 * q]; a[1] = acc[mi][2 * hf + ni][4 * q + 1]; a[2] = acc[mi][2 * hf + ni][4 * q + 2]; a[3] = acc[mi][2 * hf + ni][4 * q + 3];
            ssm_store(p, l, g, k, n0 + wn * 128 + (2 * hf + ni) * 32 + 8 * q + 4 * (le >> 5), a, uw[ni][q]);
          }
        asm volatile("" ::: "memory");
        }
      }
    } else {
      {
      const int v = u - NMAIN, g = v >> 4, c0 = 768 + (v & 15) * 16;
      auto xa = [&](int m, int kc) { return kc < 128 ? ug + (size_t)g * LU * 16 + kc * 8 : Xin + (size_t)g * NCH * 256 + (kc - 128) * 8; };
      auto wa = [&](int n, int kc) {
        const int nn = c0 + n;
        return kc < 128 ? Ktab + (size_t)g * 127 * 256 + ((nn >> 4) + 63 - (kc >> 1)) * 256 + (nn & 15) * 16 + (kc & 1) * 8
                        : Mcar + ((size_t)g * 1024 + nn) * 256 + (kc - 128) * 8; };
      const f32x4 a = skinny_acc(xa, wa, 40, lds, tid);
      if (wave == 0 && (lane & 15) == 0) ssm_store(p, l, g, 0, c0 + 4 * (lane >> 4), a, ssm_load_u(p, g, 0, c0 + 4 * (lane >> 4)));
      }
    }
  }
}

__device__ __forceinline__ void phase_glu(const Params& p, char* lds, int tid) {
  const bf16_t* Z = (const bf16_t*)(p.ws + OFF_Z); const bf16_t* Wt = (const bf16_t*)(p.ws + OFF_W + W_GLU); bf16_t* YS = (bf16_t*)(p.ws + OFF_YS);
  const int lane = tid & 63, wave = tid >> 6, wm = wave >> 1, wn = wave & 1, lrow = tid >> 2, lch = tid & 3; int le = lane;
  constexpr int nN = 2;
  auto loadz = [&](int row, int col) { return *(const uint2*)(Z + ((size_t)(col >> 4) * LZ + row) * 16 + (col & 15)); };
  auto store = [&](int row, int col, f32x4 a, uint2 zw) {
    f32x4 o;
    o[0] = __uint_as_float(zw.x << 16) * sigmoidf_(a[0]); o[1] = __uint_as_float(zw.x & 0xffff0000u) * sigmoidf_(a[1]);
    o[2] = __uint_as_float(zw.y << 16) * sigmoidf_(a[2]); o[3] = __uint_as_float(zw.y & 0xffff0000u) * sigmoidf_(a[3]);
    *(uint2*)(YS + blkidx(row, col, 16)) = pack4(o);
  };
  const int nit = tile_iters(nN);
  for (int it = 0; it < nit + 1; ++it) {
    if (it < nit) {
      int tm, tn; if (!tile_of(it, nN, tm, tn)) continue;
      const int m0 = 16 + tm * 128;
      f32x16 acc[2][4]; zero_acc(acc);
      int tl = tid; asm volatile("" : "+v"(tl));
      const int lrow = tl >> 2, lch = tl & 3;
      gemm_acc(acc, Z + ((size_t)(lch >> 1) * LZ + m0 + lrow) * 16 + (lch & 1) * 8, 16, 2 * LZ * 16, Wt + ((size_t)tn * 16 * 256 + lrow) * 32 + lch * 8, 32, 8192, 16, lds, tid);
      LAUNDER_LANE();
#pragma unroll
      for (int mi = 0; mi < 2; ++mi) {
        const int row = m0 + wm * 64 + mi * 32 + (le & 31);
#pragma unroll
        for (int hf = 0; hf < 2; ++hf) {
        uint2 zw[2][4];
#pragma unroll
        for (int ni = 0; ni < 2; ++ni)
#pragma unroll
          for (int q = 0; q < 4; ++q) zw[ni][q] = loadz(row, tn * 256 + wn * 128 + (2 * hf + ni) * 32 + 8 * q + 4 * (le >> 5));
#pragma unroll
        for (int ni = 0; ni < 2; ++ni)
#pragma unroll
          for (int q = 0; q < 4; ++q) {
            f32x4 a; a[0] = acc[mi][2 * hf + ni][4 * q]; a[1] = acc[mi][2 * hf + ni][4 * q + 1]; a[2] = acc[mi][2 * hf + ni][4 * q + 2]; a[3] = acc[mi][2 * hf + ni][4 * q + 3];
            store(row, tn * 256 + wn * 128 + (2 * hf + ni) * 32 + 8 * q + 4 * (le >> 5), a, zw[ni][q]);
          }
        asm volatile("" ::: "memory");
        }
      }
    } else for (int v = sk_first(); v < 32; v += gridDim.x) {
      {
      const int c0 = v * 16;
      auto xa = [&](int m, int kc) { return Z + ((size_t)(kc >> 1) * LZ + m) * 16 + (kc & 1) * 8; };
      auto wa = [&](int n, int kc) { return wblk(Wt, 16, c0 + n, kc); };
      const f32x4 a = skinny_acc(xa, wa, 16, lds, tid);
      if (wave == 0) store(lane & 15, c0 + 4 * (lane >> 4), a, loadz(lane & 15, c0 + 4 * (lane >> 4)));
      }
    }
  }
}

__device__ __forceinline__ f32x4 un4bf(uint2 w) {
  f32x4 r; r[0] = __uint_as_float(w.x << 16); r[1] = __uint_as_float(w.x & 0xffff0000u); r[2] = __uint_as_float(w.y << 16); r[3] = __uint_as_float(w.y & 0xffff0000u); return r;
}
__device__ __forceinline__ f32x4 ld4bf(const bf16_t* ptr) {
  const uint2 w = *(const uint2*)ptr; f32x4 r;
  r[0] = __uint_as_float(w.x << 16); r[1] = __uint_as_float(w.x & 0xffff0000u); r[2] = __uint_as_float(w.y << 16); r[3] = __uint_as_float(w.y & 0xffff0000u); return r;
}
__device__ __forceinline__ void phase_merge(const Params& p, char* lds, int tid) {
  const bf16_t* YS = (const bf16_t*)(p.ws + OFF_YS); const bf16_t* YA = (const bf16_t*)(p.ws + OFF_YA);
  const bf16_t* GS = (const bf16_t*)(p.ws + OFF_GS); const bf16_t* GA = (const bf16_t*)(p.ws + OFF_GA);
  const bf16_t* Wbs = (const bf16_t*)(p.ws + OFF_W + W_BS); const bf16_t* Wba = (const bf16_t*)(p.ws + OFF_W + W_BA);
  bf16_t* MG = (bf16_t*)(p.ws + OFF_Q);
  const int lane = tid & 63, wave = tid >> 6, wm = wave >> 1, wn = wave & 1, lrow = tid >> 2, lch = tid & 3; int le = lane;
  constexpr int nN = 4;
  const int nit = tile_iters(nN);
  for (int it = 0; it < nit + 1; ++it) {
    if (it < nit) {
      int tm, tn; if (!tile_of(it, nN, tm, tn)) continue;
      const int m0 = 16 + tm * 128;
      f32x16 acc[2][4]; zero_acc(acc);
      int tl = tid; asm volatile("" : "+v"(tl));
      const int lrow = tl >> 2, lch = tl & 3;
      gemm_acc(acc, YS + ((size_t)tm * 16 * 128 + lrow) * 32 + lch * 8, 32, 4096, Wbs + ((size_t)tn * 16 * 256 + lrow) * 32 + lch * 8, 32, 8192, 16, lds, tid);
      LAUNDER_LANE();
#pragma unroll
      for (int mi = 0; mi < 2; ++mi) {
        const int row = m0 + wm * 64 + mi * 32 + (le & 31);
#pragma unroll
        for (int hf = 0; hf < 2; ++hf) {
        uint2 gw[2][4];
#pragma unroll
        for (int ni = 0; ni < 2; ++ni)
#pragma unroll
          for (int q = 0; q < 4; ++q) gw[ni][q] = *(const uint2*)(GS + (size_t)row * D + tn * 256 + wn * 128 + (2 * hf + ni) * 32 + 8 * q + 4 * (le >> 5));
#pragma unroll
        for (int ni = 0; ni < 2; ++ni)
#pragma unroll
          for (int q = 0; q < 4; ++q) {
            f32x4 gsv = un4bf(gw[ni][q]);
            gsv[0] = sigmoidf_(gsv[0]); gsv[1] = sigmoidf_(gsv[1]); gsv[2] = sigmoidf_(gsv[2]); gsv[3] = sigmoidf_(gsv[3]);
            f32x4 t;
#pragma unroll
            for (int j = 0; j < 4; ++j) t[j] = acc[mi][2 * hf + ni][4 * q + j] * gsv[j];
            *(uint2*)(MG + blkfast(tm, 32, tn * 8 + wn * 4 + 2 * hf + ni, (wm * 64 + mi * 32 + (le & 31)) * 32 + 8 * q + 4 * (le >> 5))) = pack4(t);
          }
        asm volatile("" ::: "memory");
        }
      }
      zero_acc(acc);
      gemm_acc(acc, YA + ((size_t)tm * 32 * 128 + lrow) * 32 + lch * 8, 32, 4096, Wba + ((size_t)tn * 32 * 256 + lrow) * 32 + lch * 8, 32, 8192, 32, lds, tid);
      LAUNDER_LANE();
#pragma unroll
      for (int mi = 0; mi < 2; ++mi) {
        const int row = m0 + wm * 64 + mi * 32 + (le & 31);
#pragma unroll
        for (int hf = 0; hf < 2; ++hf) {
        uint2 gw[2][4], pw[2][4];
#pragma unroll
        for (int ni = 0; ni < 2; ++ni)
#pragma unroll
          for (int q = 0; q < 4; ++q) {
            gw[ni][q] = *(const uint2*)(GA + (size_t)row * D + tn * 256 + wn * 128 + (2 * hf + ni) * 32 + 8 * q + 4 * (le >> 5));
            pw[ni][q] = *(const uint2*)(MG + blkfast(tm, 32, tn * 8 + wn * 4 + 2 * hf + ni, (wm * 64 + mi * 32 + (le & 31)) * 32 + 8 * q + 4 * (le >> 5)));
          }
#pragma unroll
        for (int ni = 0; ni < 2; ++ni)
#pragma unroll
          for (int q = 0; q < 4; ++q) {
            const int col = tn * 256 + wn * 128 + (2 * hf + ni) * 32 + 8 * q + 4 * (le >> 5);
            f32x4 gav = un4bf(gw[ni][q]);
            gav[0] = sigmoidf_(gav[0]); gav[1] = sigmoidf_(gav[1]); gav[2] = sigmoidf_(gav[2]); gav[3] = sigmoidf_(gav[3]);
            const uint2 pk = pw[ni][q];
            f32x4 o;
            o[0] = __uint_as_float(pk.x << 16) + gav[0] * acc[mi][2 * hf + ni][4 * q + 0];
            o[1] = __uint_as_float(pk.x & 0xffff0000u) + gav[1] * acc[mi][2 * hf + ni][4 * q + 1];
            o[2] = __uint_as_float(pk.y << 16) + gav[2] * acc[mi][2 * hf + ni][4 * q + 2];
            o[3] = __uint_as_float(pk.y & 0xffff0000u) + gav[3] * acc[mi][2 * hf + ni][4 * q + 3];
            *(uint2*)(MG + blkfast(tm, 32, tn * 8 + wn * 4 + 2 * hf + ni, (wm * 64 + mi * 32 + (le & 31)) * 32 + 8 * q + 4 * (le >> 5))) = pack4(o);
          }
        asm volatile("" ::: "memory");
        }
      }
    } else for (int v = sk_first(); v < 64; v += gridDim.x) {
      {
      const int c0 = v * 16;
      auto xs = [&](int m, int kc) { return YS + (((size_t)128 * 16 + (kc >> 2)) * 128 + m) * 32 + (kc & 3) * 8; };
      auto ws_ = [&](int n, int kc) { return wblk(Wbs, 16, c0 + n, kc); };
      auto xa = [&](int m, int kc) { return YA + (((size_t)128 * 32 + (kc >> 2)) * 128 + m) * 32 + (kc & 3) * 8; };
      auto wa = [&](int n, int kc) { return wblk(Wba, 32, c0 + n, kc); };
      const f32x4 a1 = skinny_acc(xs, ws_, 16, lds, tid);
      const f32x4 a2 = skinny_acc(xa, wa, 32, lds, tid);
      if (wave == 0) {
        const int row = lane & 15, col = c0 + 4 * (lane >> 4);
        f32x4 gsv = ld4bf(GS + (size_t)row * D + col), gav = ld4bf(GA + (size_t)row * D + col);
#pragma unroll
        for (int j = 0; j < 4; ++j) { gsv[j] = sigmoidf_(gsv[j]); gav[j] = sigmoidf_(gav[j]); }
        f32x4 o;
#pragma unroll
        for (int j = 0; j < 4; ++j) o[j] = gsv[j] * a1[j] + gav[j] * a2[j];
        *(uint2*)(MG + blkidx(row, col, 32)) = pack4(o);
      }
      }
    }
  }
}

__device__ __forceinline__ void phase_final(const Params& p, int tid) {
  const float* h = (const float*)(p.ws + OFF_H);
  const int lane = tid & 63, wave = tid >> 6;
  for (int r = blockIdx.x * 4 + wave; r < NX; r += gridDim.x * 4) {
    const float rs = row_rstd(p, 12, r + 16);
#pragma unroll
    for (int i = 0; i < 4; ++i) {
      const int c = i * 256 + lane * 4;
      f32x4 v = *(const f32x4*)(h + (size_t)(r + 16) * D + c);
      const f32x4 g = *(const f32x4*)(p.final_norm + c);
      v = v * rs * g;
      *(f32x4*)(p.out + (size_t)r * D + c) = v;
    }
  }
}

#define XB_XCNT(j) (64 * (j))
#define XB_XSUB(j) (1024 + 64 * (j))
#define XB_TOP 2048
#define XB_PLAIN 2112
#define XB_WORDS 2176
struct GridBar { unsigned* bar; unsigned xcc, nloc, nx, gen; };
__device__ __forceinline__ unsigned xb_ld(unsigned* q) { return __hip_atomic_load(q, __ATOMIC_RELAXED, __HIP_MEMORY_SCOPE_AGENT); }
__device__ __forceinline__ void grid_bar_setup(GridBar& gb, unsigned* bar, int tid) {
  gb.bar = bar; gb.gen = 0; gb.nloc = 1; gb.nx = 1;
  gb.xcc = (unsigned)__builtin_amdgcn_s_getreg((3 << 11) | 20) & 0xFu;
  if (tid == 0) {
    const unsigned rank = __hip_atomic_fetch_add(&bar[XB_XCNT(gb.xcc)], 1u, __ATOMIC_RELAXED, __HIP_MEMORY_SCOPE_AGENT);
    __hip_atomic_fetch_add(&bar[XB_PLAIN], 1u, __ATOMIC_RELAXED, __HIP_MEMORY_SCOPE_AGENT);
    while (xb_ld(&bar[XB_PLAIN]) < gridDim.x) __builtin_amdgcn_s_sleep(2);
    unsigned nx = 0; bool even = (gridDim.x & 7u) == 0u;
    for (int j = 0; j < 16; ++j) { const unsigned c = xb_ld(&bar[XB_XCNT(j)]); nx += c != 0u; if (j < 8 ? c != (gridDim.x >> 3) : c != 0u) even = false; }
    s_nx = nx; s_nloc = xb_ld(&bar[XB_XCNT(gb.xcc)]);
    s_vb = even ? (int)(rank * 8u + gb.xcc) : (int)blockIdx.x; s_vb_even = 1;
  }
  __syncthreads();
}
__device__ __forceinline__ void grid_bar(GridBar& gb, int tid) {
  asm volatile("s_waitcnt vmcnt(0) lgkmcnt(0)" ::: "memory");
  __syncthreads();
  gb.gen += 1;
  if (tid == 0) {
    const unsigned old = __hip_atomic_fetch_add(&gb.bar[XB_XSUB(gb.xcc)], 1u, __ATOMIC_RELAXED, __HIP_MEMORY_SCOPE_AGENT);
    if (old + 1 == s_nloc * gb.gen) {
      __builtin_amdgcn_fence(__ATOMIC_RELEASE, "agent");
      asm volatile("s_waitcnt vmcnt(0)" ::: "memory");
      __hip_atomic_fetch_add(&gb.bar[XB_TOP], 1u, __ATOMIC_RELAXED, __HIP_MEMORY_SCOPE_AGENT);
    }
    const unsigned target = s_nx * gb.gen;
    while (xb_ld(&gb.bar[XB_TOP]) < target) __builtin_amdgcn_s_sleep(1);
    __builtin_amdgcn_fence(__ATOMIC_ACQUIRE, "agent");
    asm volatile("s_waitcnt vmcnt(0)" ::: "memory");
  }
  __syncthreads();
}

__device__ __forceinline__ int lane_id_now() { int l; asm volatile("v_mbcnt_lo_u32_b32 %0, -1, 0\n\tv_mbcnt_hi_u32_b32 %0, -1, %0" : "=v"(l)); return l; }
__global__ void __launch_bounds__(256, 2) fwd_megakernel(Params p) {
  cg::grid_group grid = cg::this_grid();
  __shared__ __attribute__((aligned(16))) char lds[65536];
  const int wave_s = __builtin_amdgcn_readfirstlane((int)threadIdx.x >> 6);
#define MYTID() (wave_s * 64 + lane_id_now())
    const bf16_t* hb = (const bf16_t*)(p.ws + OFF_HB);
  GridBar gb;
  grid.sync();
  grid_bar_setup(gb, (unsigned*)(p.ws + OFF_BAR), MYTID());
  phase_init(p, MYTID());
  grid_bar(gb, MYTID());
  for (int l = 0; l < 4; ++l) {
#pragma nounroll
    for (int step0 = 0; step0 < 12 + PROBE_EXTRA; ++step0) {
      const int step = step0 < 12 ? step0 : PROBE_STEP;
      if (PROBE_STEP < 0 && step0 >= 12) { grid_bar(gb, MYTID()); continue; }
      int tid = MYTID(); asm volatile("" : "+v"(tid));
      if (step == 0) {}
      else if (step == 1 || step == 10) phase_ffn_up(p, (const bf16_t*)(p.ws + OFF_W + (step == 1 ? W_GU1 : W_GU2)), 3 * l + (step == 1 ? 0 : 2), lds, tid);
      else if (step == 2 || step == 9 || step == 11) {
        const bf16_t* A = (const bf16_t*)(p.ws + (step == 9 ? OFF_Q : OFF_ACT));
        const int K = step == 9 ? D : DFF;
        const bf16_t* Wt = (const bf16_t*)(p.ws + OFF_W + (step == 2 ? W_D1 : (step == 9 ? W_O : W_D2)));
        const int sn = 3 * l + (step == 2 ? 1 : (step == 9 ? 2 : 3));
        phase_resid(p, A, K, Wt, sn, lds, tid);
      }
      else if (step == 3) phase_win(p, 3 * l + 1, lds, tid);
      else if (step == 4) phase_attn_xend(p, l, lds, tid);
      else if (step == 5) phase_scan(p, l, tid);
      else if (step == 6) phase_ssm_out(p, l, lds, tid);
      else if (step == 7) phase_glu(p, lds, tid);
      else phase_merge(p, lds, tid);
      {
        int pl = l, pb = 0, pe = 0, skip = 0;
        if (step == 0) { pb = l == 0 ? 0 : 3136; pe = l == 0 ? 10560 : 5952; }
        else if (step == 5 && l < 3) { pl = l + 1; pb = 0; pe = 3136; skip = 16; }
        else if (step == 7 && l < 3) { pl = l + 1; pb = 5952; pe = 10560; }
        if (pe > pb) phase_prep(p, pl, pb, pe, skip, lds, tid);
      }
      grid_bar(gb, MYTID());
#ifdef DBG_STEPS
      if (l * 12 + step + 1 == DBG_STEPS) {
        const int gt = blockIdx.x * 256 + MYTID();
#if DBG_MODE == 0
        const float* hsrc = (const float*)(p.ws + OFF_H);
        for (int i = gt; i < NX * D; i += gridDim.x * 256) p.out[i] = hsrc[i + 16 * D];
#else
        const bf16_t* bsrc = (const bf16_t*)(p.ws + DBG_BUF);
        for (int i = gt; i < NX * D; i += gridDim.x * 256) p.out[i] = bf2f(bsrc[i % DBG_N]);
#endif
        return;
      }
#endif
    }
  }
  (void)hb;
  phase_final(p, MYTID());
}

extern "C" void kernel_launch(void* const* d_in, const int* in_sizes, int n_in, void* d_out, int out_size, void* d_ws, size_t ws_size,
                              hipStream_t stream) {
  static int grid_blocks = 0;
  if (!grid_blocks) {
    int dev = 0, cus = 0, per_cu = 0;
    (void)hipGetDevice(&dev);
    (void)hipDeviceGetAttribute(&cus, hipDeviceAttributeMultiprocessorCount, dev);
    (void)hipOccupancyMaxActiveBlocksPerMultiprocessor(&per_cu, fwd_megakernel, 256, 0);
    if (per_cu > 2) per_cu = 2;
    if (per_cu < 1) per_cu = 1;
    grid_blocks = cus * per_cu;
  }
  if (ws_size < WS_TOTAL) { fprintf(stderr, "workspace too small: %zu < %zu\n", ws_size, (size_t)WS_TOTAL); return; }
  Params p{};
  const float* const* in = (const float* const*)d_in;
  p.x = in[0]; p.meta = in[1]; p.ffn1_norm = in[2]; p.ffn1_wg = in[3]; p.ffn1_wu = in[4]; p.ffn1_wd = in[5];
  p.mix_norm = in[6]; p.w_in = in[7]; p.lam_re = in[8]; p.lam_im = in[9]; p.log_dt = in[10];
  p.b_re = in[11]; p.b_im = in[12]; p.c_re = in[13]; p.c_im = in[14]; p.ssm_d = in[15]; p.w_glu = in[16];
  p.sink = in[17]; p.w_bs = in[18]; p.w_ba = in[19]; p.w_out = in[20]; p.ffn2_norm = in[21];
  p.ffn2_wg = in[22]; p.ffn2_wu = in[23]; p.ffn2_wd = in[24]; p.final_norm = in[25];
  p.out = (float*)d_out; p.ws = (char*)d_ws;
  void* args[] = {&p};
  (void)hipMemsetAsync((char*)d_ws + OFF_BAR, 0, 16384, stream);
  hipError_t e = hipLaunchCooperativeKernel((void*)fwd_megakernel, dim3(grid_blocks), dim3(256), args, 0, stream);
  if (e != hipSuccess) fprintf(stderr, "cooperative launch failed: %s (grid %d)\n", hipGetErrorString(e), grid_blocks);
}
```

```cpp
#ifndef PROBE_EXTRA
#define PROBE_EXTRA 0
#define PROBE_STEP 0
#endif
#include <hip/hip_runtime.h>
#include <hip/hip_cooperative_groups.h>
#include <cstdio>
#include <cstdint>
namespace cg = cooperative_groups;

typedef unsigned short bf16_t;
typedef short bf16x8 __attribute__((ext_vector_type(8)));
typedef float f32x16 __attribute__((ext_vector_type(16)));
typedef float f32x4 __attribute__((ext_vector_type(4)));

constexpr int L = 16400, NX = 16384, D = 1024, DFF = 2816;
constexpr int NG = 32, NP = 64;
constexpr int NCH = 257, LU = NCH * 64;
constexpr int LV = 16640;
constexpr int PADK = 64;
constexpr int LDH = D + PADK;
constexpr int LS = 16512;
constexpr int LZ = 16400;

constexpr size_t AL(size_t x) { return (x + 255) & ~(size_t)255; }
constexpr size_t OFF_H = 0;
constexpr size_t OFF_HB = OFF_H + AL((size_t)L * D * 4);
constexpr size_t OFF_SSQ = OFF_HB + AL((size_t)L * LDH * 2);
constexpr size_t OFF_SSK = OFF_SSQ + AL((size_t)13 * 16 * LS * 4);
constexpr size_t OFF_ACT = OFF_SSK + AL((size_t)13 * 64 * 16 * 4);
constexpr size_t OFF_Q = OFF_ACT;
constexpr size_t OFF_GS = OFF_Q + AL((size_t)129 * 128 * D * 2);
constexpr size_t OFF_K = OFF_GS + AL((size_t)L * D * 2);
constexpr size_t OFF_VT = OFF_K + AL((size_t)L * 256 * 2);
constexpr size_t OFF_VT_END = OFF_VT + AL((size_t)256 * LV * 2);
constexpr size_t OFF_GA = OFF_ACT + AL((size_t)129 * 128 * DFF * 2);
static_assert(OFF_VT_END <= OFF_GA, "alias overflow");
constexpr size_t OFF_YA = OFF_GA + AL((size_t)L * D * 2);
constexpr size_t OFF_UG = OFF_YA + AL((size_t)129 * 128 * D * 2) + 65536;
constexpr size_t OFF_Z = OFF_UG + AL((size_t)NG * LU * 16 * 2);
constexpr size_t OFF_YS = OFF_Z + AL((size_t)L * 512 * 2);
constexpr size_t OFF_XEND = OFF_YS + AL((size_t)129 * 128 * 512 * 2);
constexpr size_t OFF_XIN = OFF_XEND + AL((size_t)NG * NCH * 256 * 4);
constexpr size_t OFF_W = OFF_XIN + AL((size_t)NG * NCH * 256 * 2);
constexpr size_t W_GU1 = 0;
constexpr size_t W_D1 = W_GU1 + (size_t)2 * DFF * (D + PADK) * 2;
constexpr size_t W_IN = W_D1 + (size_t)D * (DFF + PADK) * 2;
constexpr size_t W_GLU = W_IN + (size_t)4096 * (D + PADK) * 2;
constexpr size_t W_BS = W_GLU + (size_t)512 * (512 + PADK) * 2;
constexpr size_t W_BA = W_BS + (size_t)D * (512 + PADK) * 2;
constexpr size_t W_O = W_BA + (size_t)D * (D + PADK) * 2;
constexpr size_t W_GU2 = W_O + (size_t)D * (D + PADK) * 2;
constexpr size_t W_D2 = W_GU2 + (size_t)2 * DFF * (D + PADK) * 2;
constexpr size_t W_TOTAL = W_D2 + (size_t)D * (DFF + PADK) * 2;
constexpr size_t OFF_KTAB = OFF_W + AL(W_TOTAL);
constexpr size_t OFF_WEND = OFF_KTAB + AL((size_t)NG * 127 * 256 * 2);
constexpr size_t OFF_MCAR = OFF_WEND + AL((size_t)NG * 256 * 1024 * 2);
constexpr size_t OFF_LP = OFF_MCAR + AL((size_t)NG * 1024 * 256 * 2);
constexpr size_t OFF_BB = OFF_LP + AL((size_t)4 * 2 * NG * NP * 65 * 8);
constexpr size_t OFF_BAR = OFF_BB + AL((size_t)4 * 2 * NG * NP * 16 * 8);
constexpr size_t WS_TOTAL = OFF_BAR + 16384;

struct Params {
  const float* x; const float* meta; const float* ffn1_norm; const float* ffn1_wg; const float* ffn1_wu; const float* ffn1_wd;
  const float* mix_norm; const float* w_in; const float* lam_re; const float* lam_im; const float* log_dt;
  const float* b_re; const float* b_im; const float* c_re; const float* c_im; const float* ssm_d; const float* w_glu;
  const float* sink; const float* w_bs; const float* w_ba; const float* w_out; const float* ffn2_norm;
  const float* ffn2_wg; const float* ffn2_wu; const float* ffn2_wd; const float* final_norm;
  float* out; char* ws;
};

#define LAUNDER_LANE() do { le = lane; asm volatile("" : "+v"(le)); } while (0)
__device__ __forceinline__ const bf16_t* wblk(const bf16_t* W, int nkt, int R, int kc) { return W + (((size_t)(R >> 8) * nkt + (kc >> 2)) * 256 + (R & 255)) * 32 + (kc & 3) * 8; }
__device__ __forceinline__ size_t hbidx(int row, int col) {
  const int rr = row - 16; const int tmx = row < 16 ? 128 : (rr >> 7), r = row < 16 ? row : (rr & 127);
  return (((size_t)tmx * 32 + (col >> 5)) * 128 + r) * 32 + (col & 31);
}
__device__ __forceinline__ size_t blkidx(int row, int col, int nkt) {
  const int rr = row - 16; const int tmx = row < 16 ? 128 : (rr >> 7), r = row < 16 ? row : (rr & 127);
  return (((size_t)tmx * nkt + (col >> 5)) * 128 + r) * 32 + (col & 31);
}
__device__ __forceinline__ size_t blkfast(int tm, int nkt, int cb, int rl) { return ((size_t)tm * nkt + cb) * 4096 + rl; }
__device__ __forceinline__ unsigned cvt_pk_bf16(float lo, float hi) { unsigned r; asm volatile("v_cvt_pk_bf16_f32 %0, %1, %2" : "=v"(r) : "v"(lo), "v"(hi)); return r; }
__device__ __forceinline__ float bf2f(bf16_t v) { return __uint_as_float(((unsigned)v) << 16); }
__device__ __forceinline__ float sigmoidf_(float v) { return __builtin_amdgcn_rcpf(1.0f + __expf(-v)); }
__device__ __forceinline__ float gelu_tanh(float x) { const float u = 1.5957691216f * (x + 0.044715f * x * x * x); return x * sigmoidf_(u); }
__device__ __forceinline__ int lds_off(int row, int ch) { return row * 128 + ((ch ^ ((row >> 1) & 7)) << 4); }
__device__ __forceinline__ uint2 pack4(f32x4 v) { uint2 r; r.x = cvt_pk_bf16(v[0], v[1]); r.y = cvt_pk_bf16(v[2], v[3]); return r; }

__device__ __forceinline__ float row_rstd(const Params& p, int si, int row) {
  float s = 0.f;
  if (row >= 16) {
    const float* q = (const float*)(p.ws + OFF_SSQ) + (size_t)si * 16 * LS + row + 16;
#pragma unroll
    for (int i = 0; i < 16; ++i) s += q[(size_t)i * LS];
  } else {
    const float* q = (const float*)(p.ws + OFF_SSK) + (size_t)si * 64 * 16 + row;
    for (int i = 0; i < 64; ++i) s += q[i * 16];
  }
  return rsqrtf(s * (1.f / 1024.f) + 1e-6f);
}
__device__ __forceinline__ float* ssq_slot(const Params& p, int si, int slot, int row) { return (float*)(p.ws + OFF_SSQ) + ((size_t)si * 16 + slot) * LS + row + 16; }
__device__ __forceinline__ float* ssk_slot(const Params& p, int si, int slot, int row) { return (float*)(p.ws + OFF_SSK) + ((size_t)si * 64 + slot) * 16 + row; }

#define GSTAGE 24576
typedef __attribute__((address_space(3))) void* lds_ptr_t;
typedef const __attribute__((address_space(1))) void* glb_ptr_t;
typedef int i32x4 __attribute__((ext_vector_type(4)));
#define GDMA(stagebase) do { char* _d = (stagebase) + tid * 16; \
    __builtin_amdgcn_global_load_lds((glb_ptr_t)(xp), (lds_ptr_t)(_d), 16, 0, 0); \
    __builtin_amdgcn_global_load_lds((glb_ptr_t)(xp + (size_t)64 * xld), (lds_ptr_t)(_d + 4096), 16, 0, 0); \
    __builtin_amdgcn_global_load_lds((glb_ptr_t)(wp), (lds_ptr_t)(_d + 8192), 16, 0, 0); \
    __builtin_amdgcn_global_load_lds((glb_ptr_t)(wp + (size_t)64 * wld), (lds_ptr_t)(_d + 12288), 16, 0, 0); \
    __builtin_amdgcn_global_load_lds((glb_ptr_t)(wp + (size_t)128 * wld), (lds_ptr_t)(_d + 16384), 16, 0, 0); \
    __builtin_amdgcn_global_load_lds((glb_ptr_t)(wp + (size_t)192 * wld), (lds_ptr_t)(_d + 20480), 16, 0, 0); } while (0)
__device__ __forceinline__ void gemm_acc(f32x16 (&acc)[2][4], const bf16_t* xp, int xld, int xks, const bf16_t* wp, int wld, int wks,
                                         int nkt, char* lds, int tid) {
  const int lane = tid & 63, wave = tid >> 6, wm = wave >> 1, wn = wave & 1;
  __syncthreads();
  GDMA(lds);
  if (nkt > 1) { xp += xks; wp += wks; GDMA(lds + GSTAGE); asm volatile("s_waitcnt vmcnt(6)" ::: "memory"); }
  else asm volatile("s_waitcnt vmcnt(0)" ::: "memory");
  __builtin_amdgcn_s_barrier();
  const int r31 = lane & 31, hh = lane >> 5, swz = (r31 >> 2) & 3;
  const unsigned lbase = (unsigned)(size_t)lds;
  const unsigned ax0 = lbase + wm * 4096 + r31 * 64 + (((0 + hh) ^ swz) << 4), ax1 = lbase + wm * 4096 + r31 * 64 + (((2 + hh) ^ swz) << 4);
  const unsigned aw0 = ax0 - wm * 4096 + 8192 + wn * 8192, aw1 = ax1 - wm * 4096 + 8192 + wn * 8192;
#define KSTEP(AX, AW) do { i32x4 x0, x1, w0, w1, w2, w3; \
    asm volatile("ds_read_b128 %0, %6\n\tds_read_b128 %1, %6 offset:2048\n\tds_read_b128 %2, %7\n\tds_read_b128 %3, %7 offset:2048\n\t" \
                 "ds_read_b128 %4, %7 offset:4096\n\tds_read_b128 %5, %7 offset:6144\n\ts_waitcnt lgkmcnt(0)" \
                 : "=&v"(x0), "=&v"(x1), "=&v"(w0), "=&v"(w1), "=&v"(w2), "=&v"(w3) : "v"((AX) + soff), "v"((AW) + soff) : "memory"); \
    const bf16x8 xf0 = __builtin_bit_cast(bf16x8, x0), xf1 = __builtin_bit_cast(bf16x8, x1), wf0 = __builtin_bit_cast(bf16x8, w0), \
                 wf1 = __builtin_bit_cast(bf16x8, w1), wf2 = __builtin_bit_cast(bf16x8, w2), wf3 = __builtin_bit_cast(bf16x8, w3); \
    __builtin_amdgcn_s_setprio(1); \
    acc[0][0] = __builtin_amdgcn_mfma_f32_32x32x16_bf16(wf0, xf0, acc[0][0], 0, 0, 0); \
    acc[0][1] = __builtin_amdgcn_mfma_f32_32x32x16_bf16(wf1, xf0, acc[0][1], 0, 0, 0); \
    acc[0][2] = __builtin_amdgcn_mfma_f32_32x32x16_bf16(wf2, xf0, acc[0][2], 0, 0, 0); \
    acc[0][3] = __builtin_amdgcn_mfma_f32_32x32x16_bf16(wf3, xf0, acc[0][3], 0, 0, 0); \
    acc[1][0] = __builtin_amdgcn_mfma_f32_32x32x16_bf16(wf0, xf1, acc[1][0], 0, 0, 0); \
    acc[1][1] = __builtin_amdgcn_mfma_f32_32x32x16_bf16(wf1, xf1, acc[1][1], 0, 0, 0); \
    acc[1][2] = __builtin_amdgcn_mfma_f32_32x32x16_bf16(wf2, xf1, acc[1][2], 0, 0, 0); \
    acc[1][3] = __builtin_amdgcn_mfma_f32_32x32x16_bf16(wf3, xf1, acc[1][3], 0, 0, 0); \
    __builtin_amdgcn_s_setprio(0); } while (0)
  int st = 0;
#pragma unroll 1
  for (int kt = 0; kt < nkt; ++kt) {
    const unsigned soff = (unsigned)st * GSTAGE;
    const bool more2 = kt + 2 < nkt;
    if (more2) { xp += xks; wp += wks; const int s2 = st >= 1 ? st - 1 : 2; GDMA(lds + s2 * GSTAGE); }
    KSTEP(ax0, aw0); KSTEP(ax1, aw1);
    if (more2) asm volatile("s_waitcnt vmcnt(6)" ::: "memory");
    else asm volatile("s_waitcnt vmcnt(0)" ::: "memory");
    __builtin_amdgcn_s_barrier();
    st = st == 2 ? 0 : st + 1;
  }
#undef KSTEP
  __syncthreads();
}
__device__ __forceinline__ void zero_acc(f32x16 (&acc)[2][4]) {
#pragma unroll
  for (int a = 0; a < 2; ++a)
#pragma unroll
    for (int b = 0; b < 4; ++b)
#pragma unroll
      for (int r = 0; r < 16; ++r) acc[a][b][r] = 0.f;
}

template <class XA, class WA>
__device__ __forceinline__ f32x4 skinny_acc(XA xaddr, WA waddr, int nk32, char* lds, int tid) {
  int lane = tid & 63; const int wave = tid >> 6;
  asm volatile("" : "+v"(lane));
  const int per = nk32 >> 2;
  f32x4 acc = {0.f, 0.f, 0.f, 0.f};
  const int e = (wave + 1) * per;
  for (int s = wave * per; s < e; s += 8) {
    bf16x8 a0, a1, a2, a3, a4, a5, a6, a7, b0, b1, b2, b3, b4, b5, b6, b7;
#define SKL(j) { const int ss = (s + j < e) ? s + j : e - 1; const int kc = ss * 4 + (lane >> 4); a##j = *(const bf16x8*)waddr(lane & 15, kc); b##j = *(const bf16x8*)xaddr(lane & 15, kc); }
    SKL(0) SKL(1) SKL(2) SKL(3) SKL(4) SKL(5) SKL(6) SKL(7)
#undef SKL
#define SKM(j) if (s + j < e) acc = __builtin_amdgcn_mfma_f32_16x16x32_bf16(a##j, b##j, acc, 0, 0, 0);
    SKM(0) SKM(1) SKM(2) SKM(3) SKM(4) SKM(5) SKM(6) SKM(7)
#undef SKM
  }
  __syncthreads();
  f32x4* red = (f32x4*)lds;
  red[wave * 64 + lane] = acc;
  __syncthreads();
  if (wave == 0) acc = red[lane] + red[64 + lane] + red[128 + lane] + red[192 + lane];
  return acc;
}

__shared__ int s_unit;
__shared__ unsigned s_nx, s_nloc;
__shared__ int s_vb;
__device__ __forceinline__ bool tile_of(int it, int nN, int& tm, int& tn) {
  const int G = gridDim.x, b = s_vb;
  const int x = b & 7, j = b >> 3, tmPer = G >> 4;
  const int ptm = j % tmPer, ptn = j / tmPer;
  const int npn = nN >> 1, pi = it * 8 + x;
  tm = (pi / npn) * tmPer + ptm; tn = (pi % npn) * 2 + ptn;
  return tm < 128;
}
__device__ __forceinline__ int sk_first() { const int b = s_vb; return (7 - (b & 7)) * ((int)gridDim.x >> 3) + (b >> 3); }
__device__ __forceinline__ int tile_iters(int nN) { const int npatch = (128 / (gridDim.x >> 4)) * (nN >> 1); return (npatch + 7) >> 3; }

__device__ __forceinline__ void phase_init(const Params& p, int tid) {
  float* h = (float*)(p.ws + OFF_H); bf16_t* hb = (bf16_t*)(p.ws + OFF_HB);
  const int lane = tid & 63, wave = tid >> 6;
  const int gthreads = gridDim.x * 256, gtid = blockIdx.x * 256 + tid;
  for (int r0 = (int)blockIdx.x * 32 - 16; r0 < L; r0 += gridDim.x * 32)
  for (int r = r0 + wave; r < r0 + 32 && r < L; r += 4) {
    if (r < 0) continue;
    const float* src = r < 16 ? p.meta + (size_t)r * D : p.x + (size_t)(r - 16) * D;
    float ss = 0.f;
#pragma unroll
    for (int i = 0; i < 4; ++i) {
      const int c = i * 256 + lane * 4;
      const f32x4 v = *(const f32x4*)(src + c);
      *(f32x4*)(h + (size_t)r * D + c) = v;
      *(uint2*)(hb + hbidx(r, c)) = pack4(v);
      ss += v[0] * v[0] + v[1] * v[1] + v[2] * v[2] + v[3] * v[3];
    }
#pragma unroll
    for (int o = 32; o >= 1; o >>= 1) ss += __shfl_xor(ss, o);
    if (r >= 16) { if (lane < 16) *ssq_slot(p, 0, lane, r) = lane == 0 ? ss : 0.f; }
    else *ssk_slot(p, 0, lane, r) = lane == 0 ? ss : 0.f;
  }
  { bf16_t* ug = (bf16_t*)(p.ws + OFF_UG);
    for (int i = gtid; i < NG * 48 * 16 / 2; i += gthreads) { const int g = i / 384, w = i - g * 384; *(unsigned*)(ug + (size_t)g * LU * 16 + w * 2) = 0u; } }
  float2* LP = (float2*)(p.ws + OFF_LP); float2* BB = (float2*)(p.ws + OFF_BB);
  for (int i = gtid; i < 4 * 2 * NG * NP * 65; i += gthreads) {
    const int j = i % 65, q = i / 65;
    const float lre = p.lam_re[q], lim = p.lam_im[q];
    const float dt = expf(p.log_dt[q >> 6]);
    const float a = lre * dt;
    double ang = (double)j * ((double)lim * (double)dt);
    ang -= 6.283185307179586477 * rint(ang * 0.15915494309189533577);
    const float ra = (float)ang;
    const float mag = expf((float)j * a);
    LP[i] = make_float2(mag * cosf(ra), mag * sinf(ra));
  }
  for (int i = gtid; i < 4 * 2 * NG * NP * 16; i += gthreads) {
    const int q = i >> 4;
    const float lre = p.lam_re[q], lim = p.lam_im[q];
    const float dt = expf(p.log_dt[q >> 6]);
    const float a = lre * dt, b = lim * dt;
    const float sh = sinf(0.5f * b);
    const float nr = expm1f(a) * cosf(b) - 2.f * sh * sh, ni = expf(a) * sinf(b);
    const float den = 1.f / (lre * lre + lim * lim);
    const float cr = (nr * lre + ni * lim) * den, ci = (ni * lre - nr * lim) * den;
    const float br = p.b_re[i], bi = p.b_im[i];
    BB[i] = make_float2(cr * br - ci * bi, cr * bi + ci * br);
  }
}

__device__ __forceinline__ void phase_prep(const Params& p, int l, int ubeg, int uend, int bskip, char* lds, int tid) {
  char* W = p.ws + OFF_W;
  float* ldsf = (float*)lds;
  const float2* LP = (const float2*)(p.ws + OFF_LP) + (size_t)l * 2 * NG * NP * 65;
  const float2* BB = (const float2*)(p.ws + OFF_BB) + (size_t)l * 2 * NG * NP * 16;
  const float* Cre = p.c_re + (size_t)l * 2 * NG * 16 * NP; const float* Cim = p.c_im + (size_t)l * 2 * NG * 16 * NP;
  bf16_t* Ktab = (bf16_t*)(p.ws + OFF_KTAB); bf16_t* Wend = (bf16_t*)(p.ws + OFF_WEND); bf16_t* Mcar = (bf16_t*)(p.ws + OFF_MCAR);
  if ((int)blockIdx.x < bskip) return;
  for (int u = ubeg + (int)blockIdx.x - bskip; u < uend; u += (int)gridDim.x - bskip) {
    if (u < 5952) {
      const float* src; bf16_t* dst; int K, N; const float* rs = nullptr; float sc = 1.f; int perm = 0; int t;
      if (u < 704) { t = u; src = p.ffn1_wg + (size_t)l * D * DFF; dst = (bf16_t*)(W + W_GU1); K = D; N = DFF; rs = p.ffn1_norm + l * D; perm = 1; }
      else if (u < 1408) { t = u - 704; src = p.ffn1_wu + (size_t)l * D * DFF; dst = (bf16_t*)(W + W_GU1); K = D; N = DFF; rs = p.ffn1_norm + l * D; perm = 2; }
      else if (u < 2112) { t = u - 1408; src = p.ffn1_wd + (size_t)l * D * DFF; dst = (bf16_t*)(W + W_D1); K = DFF; N = D; sc = 0.5f; }
      else if (u < 3136) { t = u - 2112; src = p.w_in + (size_t)l * D * 4096; dst = (bf16_t*)(W + W_IN); K = D; N = 4096; rs = p.mix_norm + l * D; }
      else if (u < 3200) { t = u - 3136; src = p.w_glu + (size_t)l * 512 * 512; dst = (bf16_t*)(W + W_GLU); K = 512; N = 512; }
      else if (u < 3328) { t = u - 3200; src = p.w_bs + (size_t)l * 512 * D; dst = (bf16_t*)(W + W_BS); K = 512; N = D; }
      else if (u < 3584) { t = u - 3328; src = p.w_ba + (size_t)l * D * D; dst = (bf16_t*)(W + W_BA); K = D; N = D; }
      else if (u < 3840) { t = u - 3584; src = p.w_out + (size_t)l * D * D; dst = (bf16_t*)(W + W_O); K = D; N = D; }
      else if (u < 4544) { t = u - 3840; src = p.ffn2_wg + (size_t)l * D * DFF; dst = (bf16_t*)(W + W_GU2); K = D; N = DFF; rs = p.ffn2_norm + l * D; perm = 1; }
      else if (u < 5248) { t = u - 4544; src = p.ffn2_wu + (size_t)l * D * DFF; dst = (bf16_t*)(W + W_GU2); K = D; N = DFF; rs = p.ffn2_norm + l * D; perm = 2; }
      else { t = u - 5248; src = p.ffn2_wd + (size_t)l * D * DFF; dst = (bf16_t*)(W + W_D2); K = DFF; N = D; sc = 0.5f; }
      const int nkt = K >> 6; const int kt = t % nkt, nt = t / nkt;
      __syncthreads();
      f32x4 tv[4]; float tsc[4];
#pragma unroll
      for (int i = 0; i < 4; ++i) {
        const int idx = tid + 256 * i, kk = idx >> 4, n4 = idx & 15;
        tv[i] = *(const f32x4*)(src + (size_t)(kt * 64 + kk) * N + nt * 64 + n4 * 4);
        tsc[i] = rs ? rs[kt * 64 + kk] * sc : sc;
      }
#pragma unroll
      for (int i = 0; i < 4; ++i) {
        const int idx = tid + 256 * i, kk = idx >> 4, n4 = idx & 15;
        float* d4 = ldsf + kk * 65 + n4 * 4;
        d4[0] = tv[i][0] * tsc[i]; d4[1] = tv[i][1] * tsc[i]; d4[2] = tv[i][2] * tsc[i]; d4[3] = tv[i][3] * tsc[i];
      }
      __syncthreads();
      const int n = tid >> 2, kq = tid & 3;
      unsigned w[8];
#pragma unroll
      for (int j = 0; j < 8; ++j) w[j] = cvt_pk_bf16(ldsf[(kq * 16 + 2 * j) * 65 + n], ldsf[(kq * 16 + 2 * j + 1) * 65 + n]);
      int R = nt * 64 + n;
      if (perm) { const int tn = R >> 7, wn = (R >> 6) & 1, pr = (R >> 5) & 1, xx = R & 31; R = tn * 256 + wn * 128 + pr * 64 + xx + (perm == 2 ? 32 : 0); }
      const int k0 = kt * 64 + kq * 16;
      uint4* d = (uint4*)(dst + (((size_t)(R >> 8) * (K >> 5) + (k0 >> 5)) * 256 + (R & 255)) * 32 + (k0 & 31));
      d[0] = make_uint4(w[0], w[1], w[2], w[3]); d[1] = make_uint4(w[4], w[5], w[6], w[7]);
    } else if (u < 6464) {
      const int v = u - 5952, g = v >> 4, dd0 = (v & 15) * 8;
      float2* Cs = (float2*)lds;
      float2* Ws = (float2*)(lds + 16384);
      __syncthreads();
      for (int i = tid; i < 2048; i += 256) { const int dr = i >> 10, c = (i >> 6) & 15, pp = i & 63; const size_t ci = (size_t)((dr * NG + g) * 16 + c) * NP + pp; Cs[i] = make_float2(Cre[ci], Cim[ci]); }
      for (int j = 0; j < 8; ++j) {
        const int dd = dd0 + j; if (dd >= 127) break;
        const int d = dd - 63;
        __syncthreads();
#pragma unroll
        for (int ii = 0; ii < 8; ++ii) {
          const int i = tid + 256 * ii, dr = i >> 10, pp = (i >> 4) & 63, c2 = i & 15;
          const bool need = dr == 0 ? d >= 0 : d <= 0;
          float2 w = make_float2(0.f, 0.f);
          if (need) { const float2 a = LP[((size_t)(dr * NG + g) * NP + pp) * 65 + (d < 0 ? -d : d)], bb = BB[((size_t)(dr * NG + g) * NP + pp) * 16 + c2]; w = make_float2(a.x * bb.x - a.y * bb.y, a.x * bb.y + a.y * bb.x); }
          Ws[i] = w;
        }
        __syncthreads();
        const int c = tid >> 4, c2 = tid & 15;
        float sum = 0.f;
#pragma unroll 8
        for (int i = 0; i < 128; ++i) { const float2 cc = Cs[(i >> 6) * 1024 + c * 64 + (i & 63)], w = Ws[i * 16 + c2]; sum += cc.x * w.x - cc.y * w.y; }
        Ktab[((size_t)g * 127 + dd) * 256 + tid] = (bf16_t)(cvt_pk_bf16(sum, 0.f) & 0xffffu);
      }
    } else if (u < 8512) {
      const int v = u - 6464;
      const size_t e0 = ((size_t)v * 256 + tid) * 16;
      const int kk = (int)(e0 & 1023), pr = (int)((e0 >> 10) & 255), g = (int)(e0 >> 18);
      const int dr = pr >> 7, ri = (pr >> 6) & 1, pp = pr & 63, s = kk >> 4, c0 = kk & 15;
      const float2 a = LP[((size_t)(dr * NG + g) * NP + pp) * 65 + (dr ? s : 63 - s)];
      const float2* bb = BB + ((size_t)(dr * NG + g) * NP + pp) * 16 + c0;
      float o[16];
#pragma unroll
      for (int j = 0; j < 16; ++j) { const float2 b = bb[j]; o[j] = ri ? (a.x * b.y + a.y * b.x) : (a.x * b.x - a.y * b.y); }
      *(uint4*)(Wend + e0) = make_uint4(cvt_pk_bf16(o[0], o[1]), cvt_pk_bf16(o[2], o[3]), cvt_pk_bf16(o[4], o[5]), cvt_pk_bf16(o[6], o[7]));
      *(uint4*)(Wend + e0 + 8) = make_uint4(cvt_pk_bf16(o[8], o[9]), cvt_pk_bf16(o[10], o[11]), cvt_pk_bf16(o[12], o[13]), cvt_pk_bf16(o[14], o[15]));
    } else {
      const int v = u - 8512;
      const size_t e0 = ((size_t)v * 256 + tid) * 16;
      const int pr = (int)(e0 & 255), n = (int)((e0 >> 8) & 1023), g = (int)(e0 >> 18);
      const int dr = pr >> 7, ri = (pr >> 6) & 1, p0 = pr & 63, t = n >> 4, c = n & 15;
      const int e = dr ? 64 - t : t + 1;
      const float* cr = Cre + (size_t)((dr * NG + g) * 16 + c) * NP + p0; const float* ci = Cim + (size_t)((dr * NG + g) * 16 + c) * NP + p0;
      float o[16];
#pragma unroll
      for (int j = 0; j < 16; ++j) { const float2 a = LP[((size_t)(dr * NG + g) * NP + p0 + j) * 65 + e]; o[j] = ri ? -(cr[j] * a.y + ci[j] * a.x) : (cr[j] * a.x - ci[j] * a.y); }
      *(uint4*)(Mcar + e0) = make_uint4(cvt_pk_bf16(o[0], o[1]), cvt_pk_bf16(o[2], o[3]), cvt_pk_bf16(o[4], o[5]), cvt_pk_bf16(o[6], o[7]));
      *(uint4*)(Mcar + e0 + 8) = make_uint4(cvt_pk_bf16(o[8], o[9]), cvt_pk_bf16(o[10], o[11]), cvt_pk_bf16(o[12], o[13]), cvt_pk_bf16(o[14], o[15]));
    }
  }
}

__device__ __forceinline__ void phase_ffn_up(const Params& p, const bf16_t* Wgu, int si, char* lds, int tid) {
  const bf16_t* hb = (const bf16_t*)(p.ws + OFF_HB); bf16_t* act = (bf16_t*)(p.ws + OFF_ACT);
  const int lane = tid & 63, wave = tid >> 6, wm = wave >> 1, wn = wave & 1, lrow = tid >> 2, lch = tid & 3; int le = lane;
  constexpr int nN = 22;
  const int nit = tile_iters(nN);
  for (int it = 0; it < nit + 1; ++it) {
    if (it < nit) {
      int tm, tn; if (!tile_of(it, nN, tm, tn)) continue;
      const int m0 = 16 + tm * 128;
      f32x16 acc[2][4]; zero_acc(acc);
      int tl = tid; asm volatile("" : "+v"(tl));
      const int lrow = tl >> 2, lch = (tl & 3) ^ ((tl >> 4) & 3);
      float* rsl = (float*)(lds + 3 * GSTAGE) + (it & 1) * 128;
      if (tid < 128) rsl[tid] = row_rstd(p, si, m0 + tid);
      gemm_acc(acc, hb + ((size_t)tm * 32 * 128 + lrow) * 32 + lch * 8, 32, 4096, Wgu + ((size_t)tn * 32 * 256 + lrow) * 32 + lch * 8, 32, 8192, 32, lds, tid);
      LAUNDER_LANE();
#pragma unroll
      for (int mi = 0; mi < 2; ++mi) {
        const int row = m0 + wm * 64 + mi * 32 + (le & 31);
        const float rs = rsl[wm * 64 + mi * 32 + (le & 31)];
#pragma unroll
        for (int pr = 0; pr < 2; ++pr)
#pragma unroll
        for (int q = 0; q < 4; ++q) {
          f32x4 o;
#pragma unroll
          for (int j = 0; j < 4; ++j) { const float g = acc[mi][2 * pr][4 * q + j] * rs, uu = acc[mi][2 * pr + 1][4 * q + j] * rs; o[j] = g * sigmoidf_(g) * uu; }
          *(uint2*)(act + blkfast(tm, 88, tn * 4 + wn * 2 + pr, (wm * 64 + mi * 32 + (le & 31)) * 32 + 8 * q + 4 * (le >> 5))) = pack4(o);
        }
      }
    } else for (int v = sk_first(); v < 176; v += gridDim.x) {
      {
      const int c0 = v * 16, tn = c0 >> 7, wnn = (c0 >> 6) & 1, pr = (c0 >> 5) & 1, x0 = c0 & 31;
      const int Rg = tn * 256 + wnn * 128 + pr * 64 + x0;
      auto xa = [&](int m, int kc) { return hb + (((size_t)128 * 32 + (kc >> 2)) * 128 + m) * 32 + (kc & 3) * 8; };
      auto wg = [&](int n, int kc) { return wblk(Wgu, 32, Rg + n, kc); };
      auto wu = [&](int n, int kc) { return wblk(Wgu, 32, Rg + 32 + n, kc); };
      const f32x4 ag = skinny_acc(xa, wg, 32, lds, tid);
      const f32x4 au = skinny_acc(xa, wu, 32, lds, tid);
      if (wave == 0) {
        const int row = lane & 15;
        const float rs = row_rstd(p, si, row);
        f32x4 o;
#pragma unroll
        for (int j = 0; j < 4; ++j) { const float g = ag[j] * rs, uu = au[j] * rs; o[j] = g * sigmoidf_(g) * uu; }
        *(uint2*)(act + blkidx(row, c0 + 4 * (lane >> 4), 88)) = pack4(o);
      }
      }
    }
  }
}

__device__ __forceinline__ void resid_store(float* h, bf16_t* hb, int row, int col, f32x4 a, float& ss) {
  float* hp = h + (size_t)row * D + col;
  f32x4 hv = *(const f32x4*)hp;
  hv += a;
  *(f32x4*)hp = hv;
  *(uint2*)(hb + hbidx(row, col)) = pack4(hv);
  ss += hv[0] * hv[0] + hv[1] * hv[1] + hv[2] * hv[2] + hv[3] * hv[3];
}
__device__ __forceinline__ void phase_resid(const Params& p, const bf16_t* A, int K, const bf16_t* Wt, int si_next, char* lds, int tid) {
  float* h = (float*)(p.ws + OFF_H); bf16_t* hb = (bf16_t*)(p.ws + OFF_HB);
  const int lane = tid & 63, wave = tid >> 6, wm = wave >> 1, wn = wave & 1, lrow = tid >> 2, lch = tid & 3; int le = lane;
  constexpr int nN = 4;
  const int nit = tile_iters(nN);
  for (int it = 0; it < nit + 1; ++it) {
    if (it < nit) {
      int tm, tn; if (!tile_of(it, nN, tm, tn)) continue;
      const int m0 = 16 + tm * 128;
      f32x16 acc[2][4]; zero_acc(acc);
      int tl = tid; asm volatile("" : "+v"(tl));
      const int lrow = tl >> 2, lch = (tl & 3) ^ ((tl >> 4) & 3);
      gemm_acc(acc, A + ((size_t)tm * (K >> 5) * 128 + lrow) * 32 + lch * 8, 32, 4096, Wt + ((size_t)tn * (K >> 5) * 256 + lrow) * 32 + lch * 8, 32, 8192, K >> 5, lds, tid);
      LAUNDER_LANE();
#pragma unroll
      for (int mi = 0; mi < 2; ++mi) {
        const int row = m0 + wm * 64 + mi * 32 + (le & 31);
#pragma unroll
        for (int hf = 0; hf < 2; ++hf) {
        float ss = 0.f;
        f32x4 hv[2][4];
#pragma unroll
        for (int ni = 0; ni < 2; ++ni)
#pragma unroll
          for (int q = 0; q < 4; ++q) {
            hv[ni][q] = *(const f32x4*)(h + (size_t)row * D + tn * 256 + wn * 128 + (2 * hf + ni) * 32 + 8 * q + 4 * (le >> 5));
          }
#pragma unroll
        for (int ni = 0; ni < 2; ++ni)
#pragma unroll
          for (int q = 0; q < 4; ++q) {
            f32x4 a; a[0] = acc[mi][2 * hf + ni][4 * q]; a[1] = acc[mi][2 * hf + ni][4 * q + 1]; a[2] = acc[mi][2 * hf + ni][4 * q + 2]; a[3] = acc[mi][2 * hf + ni][4 * q + 3];
            const int col = tn * 256 + wn * 128 + (2 * hf + ni) * 32 + 8 * q + 4 * (le >> 5);
            const f32x4 hn = hv[ni][q] + a;
            *(f32x4*)(h + (size_t)row * D + col) = hn;
            *(uint2*)(hb + blkfast(tm, 32, tn * 8 + wn * 4 + 2 * hf + ni, (wm * 64 + mi * 32 + (le & 31)) * 32 + 8 * q + 4 * (le >> 5))) = pack4(hn);
            ss += hn[0] * hn[0] + hn[1] * hn[1] + hn[2] * hn[2] + hn[3] * hn[3];
          }
        ss += __shfl_xor(ss, 32);
        if (lane < 32) *ssq_slot(p, si_next, tn * 4 + wn * 2 + hf, row) = ss;
        asm volatile("" ::: "memory");
        }
      }
    } else for (int v = sk_first(); v < 64; v += gridDim.x) {
      {
      const int c0 = v * 16;
      auto xa = [&](int m, int kc) { return A + (((size_t)128 * (K >> 5) + (kc >> 2)) * 128 + m) * 32 + (kc & 3) * 8; };
      auto wa = [&](int n, int kc) { return wblk(Wt, K >> 5, c0 + n, kc); };
      const f32x4 a = skinny_acc(xa, wa, K >> 5, lds, tid);
      if (wave == 0) {
        const int row = lane & 15;
        float ss = 0.f;
        resid_store(h, hb, row, c0 + 4 * (lane >> 4), a, ss);
        ss += __shfl_xor(ss, 16); ss += __shfl_xor(ss, 32);
        if (lane < 16) *ssk_slot(p, si_next, c0 >> 4, row) = ss;
      }
      }
    }
  }
}

template <int SEL>
__device__ __forceinline__ void win_store(const Params& p, int row, int col, f32x4 a, float rs) {
  a *= rs;
  if (SEL == 0) { a *= 0.125f; *(uint2*)((bf16_t*)(p.ws + OFF_Q) + (size_t)row * D + col) = pack4(a); }
  else if (SEL == 1) { *(uint2*)((bf16_t*)(p.ws + OFF_K) + (size_t)row * 256 + (col - 1024)) = pack4(a); }
  else if (SEL == 2) {
    bf16_t* vt = (bf16_t*)(p.ws + OFF_VT) + (size_t)(col - 1280) * LV + row + 48;
    const uint2 w = pack4(a);
    vt[0] = (bf16_t)(w.x & 0xffffu); vt[LV] = (bf16_t)(w.x >> 16); vt[2 * LV] = (bf16_t)(w.y & 0xffffu); vt[3 * LV] = (bf16_t)(w.y >> 16);
  } else if (SEL == 3) {
    const int cc = col - 1536, g = cc >> 4, c = cc & 15;
    *(uint2*)((bf16_t*)(p.ws + OFF_UG) + ((size_t)g * LU + row + 48) * 16 + c) = pack4(a);
  } else {
    const f32x4 s = a;
    bf16_t* dst = (bf16_t*)(p.ws + (SEL == 4 ? OFF_GS : OFF_GA)) + (size_t)row * D + (col - (SEL == 4 ? 2048 : 3072));
    *(uint2*)dst = pack4(s);
  }
}
template <int SEL>
__device__ __forceinline__ void win_epi(const Params& p, const f32x16 (&acc)[2][4], const float* rsl, int m0, int tn, int tid) {
  const int lane = tid & 63, wave = tid >> 6, wm = wave >> 1, wn = wave & 1; int le = lane; LAUNDER_LANE();
#pragma unroll
  for (int mi = 0; mi < 2; ++mi) {
    const int row = m0 + wm * 64 + mi * 32 + (le & 31);
    const float rs = rsl[wm * 64 + mi * 32 + (le & 31)];
#pragma unroll
    for (int ni = 0; ni < 4; ++ni)
#pragma unroll
      for (int q = 0; q < 4; ++q) {
        f32x4 a; a[0] = acc[mi][ni][4 * q]; a[1] = acc[mi][ni][4 * q + 1]; a[2] = acc[mi][ni][4 * q + 2]; a[3] = acc[mi][ni][4 * q + 3];
        win_store<SEL>(p, row, tn * 256 + wn * 128 + ni * 32 + 8 * q + 4 * (le >> 5), a, rs);
      }
  }
}
__device__ __forceinline__ int win_sel(int col) { return col < 1024 ? 0 : col < 1280 ? 1 : col < 1536 ? 2 : col < 2048 ? 3 : col < 3072 ? 4 : 5; }
__device__ __forceinline__ void phase_win(const Params& p, int si, char* lds, int tid) {
  const bf16_t* hb = (const bf16_t*)(p.ws + OFF_HB); const bf16_t* Wt = (const bf16_t*)(p.ws + OFF_W + W_IN);
  const int lane = tid & 63, wave = tid >> 6, wm = wave >> 1, wn = wave & 1, lrow = tid >> 2, lch = tid & 3; int le = lane;
  constexpr int nN = 16;
  const int nit = tile_iters(nN);
  for (int it = 0; it < nit + 1; ++it) {
    if (it < nit) {
      int tm, tn; if (!tile_of(it, nN, tm, tn)) continue;
      const int m0 = 16 + tm * 128;
      f32x16 acc[2][4]; zero_acc(acc);
      int tl = tid; asm volatile("" : "+v"(tl));
      const int lrow = tl >> 2, lch = (tl & 3) ^ ((tl >> 4) & 3);
      float* rsl = (float*)(lds + 3 * GSTAGE) + (it & 1) * 128;
      if (tid < 128) rsl[tid] = row_rstd(p, si, m0 + tid);
      gemm_acc(acc, hb + ((size_t)tm * 32 * 128 + lrow) * 32 + lch * 8, 32, 4096, Wt + ((size_t)tn * 32 * 256 + lrow) * 32 + lch * 8, 32, 8192, 32, lds, tid);
      LAUNDER_LANE();
      switch (win_sel(tn * 256)) {
        case 0: win_epi<0>(p, acc, rsl, m0, tn, tid); break;
        case 1: win_epi<1>(p, acc, rsl, m0, tn, tid); break;
        case 2: win_epi<2>(p, acc, rsl, m0, tn, tid); break;
        case 3: win_epi<3>(p, acc, rsl, m0, tn, tid); break;
        case 4: win_epi<4>(p, acc, rsl, m0, tn, tid); break;
        default: win_epi<5>(p, acc, rsl, m0, tn, tid); break;
      }
    } else for (int v = sk_first(); v < 256; v += gridDim.x) {
      {
      const int c0 = v * 16;
      auto xa = [&](int m, int kc) { return hb + (((size_t)128 * 32 + (kc >> 2)) * 128 + m) * 32 + (kc & 3) * 8; };
      auto wa = [&](int n, int kc) { return wblk(Wt, 32, c0 + n, kc); };
      const f32x4 a = skinny_acc(xa, wa, 32, lds, tid);
      if (wave == 0) {
        const int row = lane & 15;
        const float rs = row_rstd(p, si, row);
        const int cc = c0 + 4 * (lane >> 4);
        switch (win_sel(c0)) {
          case 0: win_store<0>(p, row, cc, a, rs); break;
          case 1: win_store<1>(p, row, cc, a, rs); break;
          case 2: win_store<2>(p, row, cc, a, rs); break;
          case 3: win_store<3>(p, row, cc, a, rs); break;
          case 4: win_store<4>(p, row, cc, a, rs); break;
          default: win_store<5>(p, row, cc, a, rs); break;
        }
      }
      }
    }
  }
}

__device__ __forceinline__ void attn_unit(const Params& p, int l, int b, int h, char* lds, int tid) {
  const bf16_t* Q = (const bf16_t*)(p.ws + OFF_Q); const bf16_t* Kb = (const bf16_t*)(p.ws + OFF_K); const bf16_t* VT = (const bf16_t*)(p.ws + OFF_VT);
  bf16_t* YA = (bf16_t*)(p.ws + OFF_YA);
  const int lane = tid & 63, wave = tid >> 6, r31 = lane & 31, hh = lane >> 5;
  const int kv = h >> 2;
  const float slope = exp2f(-0.5f * (float)(h + 1));
  const float sinkv = p.sink[l * 16 + h];
  const int q0 = b * 128 + wave * 32;
  const int qx = q0 + r31;
  const bool wactive = (b >= 0) || (wave == 3);
  int qseq = qx + 16; const bool qvalid = qseq >= 0; if (qseq < 0) qseq = 0;
  bf16x8 qf[4];
#pragma unroll
  for (int kk = 0; kk < 4; ++kk) qf[kk] = *(const bf16x8*)(Q + (size_t)qseq * D + h * 64 + kk * 16 + 8 * hh);
  f32x16 o[2];
#pragma unroll
  for (int r = 0; r < 16; ++r) { o[0][r] = 0.f; o[1][r] = 0.f; }
  float m = sinkv, lsum = hh == 0 ? 1.f : 0.f;
  const int swz = (r31 >> 1) & 7;
  for (int st = 0; st < 4; ++st) {
    const int kb = b - 2 + st;
    if (st != 0 && (kb < 0 || kb >= 128)) continue;
    const int kseq0 = st == 0 ? 0 : kb * 128 + 16;
    __syncthreads();
    {
      const int nrow = st == 0 ? 32 : 128;
#pragma unroll
      for (int i = 0; i < 4; ++i) {
        const int row = (tid >> 3) + 32 * i;
        if (row < nrow) *(uint4*)(lds + lds_off(row, tid & 7)) = *(const uint4*)(Kb + (size_t)(kseq0 + row) * 256 + kv * 64 + (tid & 7) * 8);
      }
      const int nkc = st == 0 ? 4 : 16;
#pragma unroll
      for (int i = 0; i < 4; ++i) {
        const int d = (tid >> 4) + 16 * i, kc = tid & 15;
        if (kc < nkc) {
          const uint4 v = *(const uint4*)(VT + (size_t)(kv * 64 + d) * LV + kseq0 + 48 + kc * 8);
          char* dst = lds + 16384 + d * 264 + kc * 16;
          *(uint2*)dst = make_uint2(v.x, v.y); *(uint2*)(dst + 8) = make_uint2(v.z, v.w);
        }
      }
    }
    __syncthreads();
    if (!wactive) continue;
    const int nj = st == 0 ? 1 : 4;
    for (int j = 0; j < nj; ++j) {
      const int kx0 = st == 0 ? 0 : kb * 128 + 32 * j;
      if (st != 0 && (kx0 + 31 < q0 - 128 || kx0 > q0 + 31 + 128)) continue;
      f32x16 s;
#pragma unroll
      for (int r = 0; r < 16; ++r) s[r] = 0.f;
#pragma unroll
      for (int kk = 0; kk < 4; ++kk) {
        const bf16x8 a = *(const bf16x8*)(lds + (32 * j + r31) * 128 + (((kk * 2 + hh) ^ swz) << 4));
        s = __builtin_amdgcn_mfma_f32_32x32x16_bf16(a, qf[kk], s, 0, 0, 0);
      }
      float tmax = -1e30f;
#pragma unroll
      for (int r = 0; r < 16; ++r) {
        const int key = 8 * (r >> 2) + 4 * hh + (r & 3);
        float sv; bool valid;
        if (st == 0) { valid = key < 16; sv = s[r]; }
        else { int dist = qx - (kx0 + key); dist = dist < 0 ? -dist : dist; valid = dist <= 128; sv = s[r] - slope * (float)dist; }
        sv = valid ? sv : -1e30f;
        s[r] = sv; tmax = fmaxf(tmax, sv);
      }
      tmax = fmaxf(tmax, __shfl_xor(tmax, 32));
      const float mnew = fmaxf(m, tmax);
      const float alpha = __expf(m - mnew);
      m = mnew;
      float psum = 0.f;
#pragma unroll
      for (int r = 0; r < 16; ++r) { s[r] = __expf(s[r] - mnew); psum += s[r]; }
      lsum = lsum * alpha + psum;
#pragma unroll
      for (int r = 0; r < 16; ++r) { o[0][r] *= alpha; o[1][r] *= alpha; }
      bf16x8 pf[2];
#pragma unroll
      for (int s2 = 0; s2 < 2; ++s2) {
        unsigned w0 = cvt_pk_bf16(s[8 * s2 + 0], s[8 * s2 + 1]), w1 = cvt_pk_bf16(s[8 * s2 + 2], s[8 * s2 + 3]);
        unsigned w2 = cvt_pk_bf16(s[8 * s2 + 4], s[8 * s2 + 5]), w3 = cvt_pk_bf16(s[8 * s2 + 6], s[8 * s2 + 7]);
        uint4 t = make_uint4(w0, w1, w2, w3);
        pf[s2] = *(bf16x8*)&t;
      }
#pragma unroll
      for (int s2 = 0; s2 < 2; ++s2)
#pragma unroll
        for (int di = 0; di < 2; ++di) {
          const char* vrow = lds + 16384 + (32 * di + r31) * 264 + (32 * j + 16 * s2 + 4 * hh) * 2;
          const uint2 lo = *(const uint2*)vrow, hi = *(const uint2*)(vrow + 16);
          uint4 t = make_uint4(lo.x, lo.y, hi.x, hi.y);
          o[di] = __builtin_amdgcn_mfma_f32_32x32x16_bf16(*(bf16x8*)&t, pf[s2], o[di], 0, 0, 0);
        }
    }
  }
  if (wactive) {
    const float lt = lsum + __shfl_xor(lsum, 32);
    const float inv = 1.0f / lt;
    if (qvalid) {
#pragma unroll
      for (int di = 0; di < 2; ++di)
#pragma unroll
        for (int q = 0; q < 4; ++q) {
          f32x4 a; a[0] = o[di][4 * q] * inv; a[1] = o[di][4 * q + 1] * inv; a[2] = o[di][4 * q + 2] * inv; a[3] = o[di][4 * q + 3] * inv;
          *(uint2*)(YA + blkidx(qseq, h * 64 + 32 * di + 8 * q + 4 * hh, 32)) = pack4(a);
        }
    }
  }
}

__device__ __forceinline__ void phase_attn_xend(const Params& p, int l, char* lds, int tid) {
  const bf16_t* ug = (const bf16_t*)(p.ws + OFF_UG); const bf16_t* Wend = (const bf16_t*)(p.ws + OFF_WEND); float* Xend = (float*)(p.ws + OFF_XEND);
  const int lane = tid & 63, wave = tid >> 6, wm = wave >> 1, wn = wave & 1, lrow = tid >> 2, lch = tid & 3; int le = lane;
  constexpr int NATT = 2048 + 16, NXM = 64, NXS = 512;
  unsigned* ctr = (unsigned*)(p.ws + OFF_BAR) + 2304 + 64 * l;
  if (tid == 0) s_unit = (int)__hip_atomic_fetch_add(ctr, 1u, __ATOMIC_RELAXED, __HIP_MEMORY_SCOPE_AGENT);
  __syncthreads();
  int uq = s_unit;
  __syncthreads();
  while (uq < NATT + NXM + NXS) {
    if (tid == 0) s_unit = (int)__hip_atomic_fetch_add(ctr, 1u, __ATOMIC_RELAXED, __HIP_MEMORY_SCOPE_AGENT);
    const int u = uq < NXM ? NATT + uq : (uq < NXM + NATT ? uq - NXM : uq);
    if (u < NATT) {
      if (u < 2048) attn_unit(p, l, u >> 4, u & 15, lds, tid); else attn_unit(p, l, -1, u - 2048, lds, tid);
    } else if (u < NATT + NXM) {
      const int v = u - NATT, g = v >> 1, tm = v & 1;
      const int k0 = 1 + tm * 128;
      f32x16 acc[2][4]; zero_acc(acc);
      int tl = tid; asm volatile("" : "+v"(tl));
      const int lrow = tl >> 2, lch = (tl & 3) ^ ((tl >> 4) & 3);
      gemm_acc(acc, ug + ((size_t)g * LU + (size_t)(k0 + lrow) * 64) * 16 + lch * 8, 1024, 32,
               Wend + ((size_t)g * 256 + lrow) * 1024 + lch * 8, 1024, 32, 32, lds, tid);
      LAUNDER_LANE();
#pragma unroll
      for (int mi = 0; mi < 2; ++mi) {
        const int k = k0 + wm * 64 + mi * 32 + (le & 31);
#pragma unroll
        for (int ni = 0; ni < 4; ++ni)
#pragma unroll
          for (int q = 0; q < 4; ++q) {
            f32x4 a; a[0] = acc[mi][ni][4 * q]; a[1] = acc[mi][ni][4 * q + 1]; a[2] = acc[mi][ni][4 * q + 2]; a[3] = acc[mi][ni][4 * q + 3];
            *(f32x4*)(Xend + ((size_t)g * NCH + k) * 256 + wn * 128 + ni * 32 + 8 * q + 4 * (le >> 5)) = a;
          }
      }
    } else {
      {
      const int v = u - NATT - NXM, g = v >> 4, c0 = (v & 15) * 16;
      auto xa = [&](int m, int kc) { return ug + (size_t)g * LU * 16 + kc * 8; };
      auto wa = [&](int n, int kc) { return Wend + ((size_t)g * 256 + c0 + n) * 1024 + kc * 8; };
      const f32x4 a = skinny_acc(xa, wa, 32, lds, tid);
      if (wave == 0 && (lane & 15) == 0) *(f32x4*)(Xend + ((size_t)g * NCH + 0) * 256 + c0 + 4 * (lane >> 4)) = a;
      }
    }
    __syncthreads();
    uq = s_unit;
    __syncthreads();
  }
}

__device__ __forceinline__ void phase_scan(const Params& p, int l, int tid) {
  const float* Xend = (const float*)(p.ws + OFF_XEND); bf16_t* Xin = (bf16_t*)(p.ws + OFF_XIN);
  const float2* LP = (const float2*)(p.ws + OFF_LP) + (size_t)l * 2 * NG * NP * 65;
  const int gt = blockIdx.x * 256 + tid;
  if (gt >= 2 * NG * NP) return;
  const int pp = gt & 63, g = (gt >> 6) & 31, dr = gt >> 11;
  const float2 lam = LP[((size_t)(dr * NG + g) * NP + pp) * 65 + 64];
  const float* xe = Xend + (size_t)g * NCH * 256 + dr * 128 + pp;
  bf16_t* xi = Xin + (size_t)g * NCH * 256 + dr * 128 + pp;
  float xr = 0.f, xim = 0.f;
  for (int i0 = 0; i0 < NCH; i0 += 16) {
    float er[16], ei[16];
#pragma unroll
    for (int j = 0; j < 16; ++j) { const int i = i0 + j; const int ic = i < NCH ? i : NCH - 1; const int k = dr ? (NCH - 1 - ic) : ic; er[j] = xe[(size_t)k * 256]; ei[j] = xe[(size_t)k * 256 + 64]; }
#pragma unroll
    for (int j = 0; j < 16; ++j) {
      const int i = i0 + j; const int k = dr ? (NCH - 1 - i) : i;
      if (i < NCH) {
        xi[(size_t)k * 256] = (bf16_t)(cvt_pk_bf16(xr, 0.f) & 0xffffu); xi[(size_t)k * 256 + 64] = (bf16_t)(cvt_pk_bf16(xim, 0.f) & 0xffffu);
        const float nr = lam.x * xr - lam.y * xim + er[j], ni = lam.x * xim + lam.y * xr + ei[j];
        xr = nr; xim = ni;
      }
    }
  }
}

__device__ __forceinline__ uint2 ssm_load_u(const Params& p, int g, int k, int n) {
  const int t = n >> 4, c = n & 15;
  return *(const uint2*)((const bf16_t*)(p.ws + OFF_UG) + ((size_t)g * LU + 64 * k + t) * 16 + c);
}
__device__ __forceinline__ void ssm_store(const Params& p, int l, int g, int k, int n, f32x4 a, uint2 uw) {
  const int t = n >> 4, c = n & 15;
  const int pos = 64 * k + t, seq = pos - 48;
  if (seq < 0) return;
  const f32x4 dv = *(const f32x4*)(p.ssm_d + l * 512 + g * 16 + c);
  f32x4 y;
  y[0] = a[0] + dv[0] * __uint_as_float(uw.x << 16); y[1] = a[1] + dv[1] * __uint_as_float(uw.x & 0xffff0000u);
  y[2] = a[2] + dv[2] * __uint_as_float(uw.y << 16); y[3] = a[3] + dv[3] * __uint_as_float(uw.y & 0xffff0000u);
  y[0] = gelu_tanh(y[0]); y[1] = gelu_tanh(y[1]); y[2] = gelu_tanh(y[2]); y[3] = gelu_tanh(y[3]);
  *(uint2*)((bf16_t*)(p.ws + OFF_Z) + ((size_t)g * LZ + seq) * 16 + c) = pack4(y);
}
__device__ __forceinline__ void phase_ssm_out(const Params& p, int l, char* lds, int tid) {
  const bf16_t* ug = (const bf16_t*)(p.ws + OFF_UG); const bf16_t* Ktab = (const bf16_t*)(p.ws + OFF_KTAB);
  const bf16_t* Mcar = (const bf16_t*)(p.ws + OFF_MCAR); const bf16_t* Xin = (const bf16_t*)(p.ws + OFF_XIN);
  const int lane = tid & 63, wave = tid >> 6, wm = wave >> 1, wn = wave & 1, lrow = tid >> 2, lch = tid & 3; int le = lane;
  constexpr int NMAIN = 256, NSK = 512;
  for (int u = blockIdx.x; u < NMAIN + NSK; u += gridDim.x) {
    if (u < NMAIN) {
      const int g = u >> 3, tm = u & 1, tn = (u >> 1) & 3;
      const int k0 = 1 + tm * 128, n0 = tn * 256;
      f32x16 acc[2][4]; zero_acc(acc);
      int tl = tid; asm volatile("" : "+v"(tl));
      const int lrow = tl >> 2, lch = (tl & 3) ^ ((tl >> 4) & 3);
      gemm_acc(acc, ug + ((size_t)g * LU + (size_t)(k0 + lrow) * 64) * 16 + lch * 8, 1024, 32,
               Ktab + (size_t)g * 127 * 256 + (size_t)(n0 + lrow) * 16 + (63 - (lch >> 1)) * 256 + (lch & 1) * 8, 16, -512, 32, lds, tid);
      LAUNDER_LANE();
      gemm_acc(acc, Xin + ((size_t)g * NCH + k0 + lrow) * 256 + lch * 8, 256, 32,
               Mcar + ((size_t)g * 1024 + n0 + lrow) * 256 + lch * 8, 256, 32, 8, lds, tid);
      LAUNDER_LANE();
#pragma unroll
      for (int mi = 0; mi < 2; ++mi) {
        const int k = k0 + wm * 64 + mi * 32 + (le & 31);
#pragma unroll
        for (int hf = 0; hf < 2; ++hf) {
        uint2 uw[2][4];
#pragma unroll
        for (int ni = 0; ni < 2; ++ni)
#pragma unroll
          for (int q = 0; q < 4; ++q) uw[ni][q] = ssm_load_u(p, g, k, n0 + wn * 128 + (2 * hf + ni) * 32 + 8 * q + 4 * (le >> 5));
#pragma unroll
        for (int ni = 0; ni < 2; ++ni)
#pragma unroll
          for (int q = 0; q < 4; ++q) {
            f32x4 a; a[0] = acc[mi][2 * hf + ni][4 * q]; a[1] = acc[mi][2 * hf + ni][4 * q + 1]; a[2] = acc[mi][2 * hf + ni][4 * q + 2]; a[3] = acc[mi][2 * hf + ni][4 * q + 3];
            ssm_store(p, l, g, k, n0 + wn * 128 + (2 * hf + ni) * 32 + 8 * q + 4 * (le >> 5), a, uw[ni][q]);
          }
        asm volatile("" ::: "memory");
        }
      }
    } else {
      {
      const int v = u - NMAIN, g = v >> 4, c0 = 768 + (v & 15) * 16;
      auto xa = [&](int m, int kc) { return kc < 128 ? ug + (size_t)g * LU * 16 + kc * 8 : Xin + (size_t)g * NCH * 256 + (kc - 128) * 8; };
      auto wa = [&](int n, int kc) {
        const int nn = c0 + n;
        return kc < 128 ? Ktab + (size_t)g * 127 * 256 + ((nn >> 4) + 63 - (kc >> 1)) * 256 + (nn & 15) * 16 + (kc & 1) * 8
                        : Mcar + ((size_t)g * 1024 + nn) * 256 + (kc - 128) * 8; };
      const f32x4 a = skinny_acc(xa, wa, 40, lds, tid);
      if (wave == 0 && (lane & 15) == 0) ssm_store(p, l, g, 0, c0 + 4 * (lane >> 4), a, ssm_load_u(p, g, 0, c0 + 4 * (lane >> 4)));
      }
    }
  }
}

__device__ __forceinline__ void phase_glu(const Params& p, char* lds, int tid) {
  const bf16_t* Z = (const bf16_t*)(p.ws + OFF_Z); const bf16_t* Wt = (const bf16_t*)(p.ws + OFF_W + W_GLU); bf16_t* YS = (bf16_t*)(p.ws + OFF_YS);
  const int lane = tid & 63, wave = tid >> 6, wm = wave >> 1, wn = wave & 1, lrow = tid >> 2, lch = tid & 3; int le = lane;
  constexpr int nN = 2;
  auto loadz = [&](int row, int col) { return *(const uint2*)(Z + ((size_t)(col >> 4) * LZ + row) * 16 + (col & 15)); };
  auto store = [&](int row, int col, f32x4 a, uint2 zw) {
    f32x4 o;
    o[0] = __uint_as_float(zw.x << 16) * sigmoidf_(a[0]); o[1] = __uint_as_float(zw.x & 0xffff0000u) * sigmoidf_(a[1]);
    o[2] = __uint_as_float(zw.y << 16) * sigmoidf_(a[2]); o[3] = __uint_as_float(zw.y & 0xffff0000u) * sigmoidf_(a[3]);
    *(uint2*)(YS + blkidx(row, col, 16)) = pack4(o);
  };
  const int nit = tile_iters(nN);
  for (int it = 0; it < nit + 1; ++it) {
    if (it < nit) {
      int tm, tn; if (!tile_of(it, nN, tm, tn)) continue;
      const int m0 = 16 + tm * 128;
      f32x16 acc[2][4]; zero_acc(acc);
      int tl = tid; asm volatile("" : "+v"(tl));
      const int lrow = tl >> 2, lch = (tl & 3) ^ ((tl >> 4) & 3);
      gemm_acc(acc, Z + ((size_t)(lch >> 1) * LZ + m0 + lrow) * 16 + (lch & 1) * 8, 16, 2 * LZ * 16, Wt + ((size_t)tn * 16 * 256 + lrow) * 32 + lch * 8, 32, 8192, 16, lds, tid);
      LAUNDER_LANE();
#pragma unroll
      for (int mi = 0; mi < 2; ++mi) {
        const int row = m0 + wm * 64 + mi * 32 + (le & 31);
#pragma unroll
        for (int hf = 0; hf < 2; ++hf) {
        uint2 zw[2][4];
#pragma unroll
        for (int ni = 0; ni < 2; ++ni)
#pragma unroll
          for (int q = 0; q < 4; ++q) zw[ni][q] = loadz(row, tn * 256 + wn * 128 + (2 * hf + ni) * 32 + 8 * q + 4 * (le >> 5));
#pragma unroll
        for (int ni = 0; ni < 2; ++ni)
#pragma unroll
          for (int q = 0; q < 4; ++q) {
            f32x4 a; a[0] = acc[mi][2 * hf + ni][4 * q]; a[1] = acc[mi][2 * hf + ni][4 * q + 1]; a[2] = acc[mi][2 * hf + ni][4 * q + 2]; a[3] = acc[mi][2 * hf + ni][4 * q + 3];
            store(row, tn * 256 + wn * 128 + (2 * hf + ni) * 32 + 8 * q + 4 * (le >> 5), a, zw[ni][q]);
          }
        asm volatile("" ::: "memory");
        }
      }
    } else for (int v = sk_first(); v < 32; v += gridDim.x) {
      {
      const int c0 = v * 16;
      auto xa = [&](int m, int kc) { return Z + ((size_t)(kc >> 1) * LZ + m) * 16 + (kc & 1) * 8; };
      auto wa = [&](int n, int kc) { return wblk(Wt, 16, c0 + n, kc); };
      const f32x4 a = skinny_acc(xa, wa, 16, lds, tid);
      if (wave == 0) store(lane & 15, c0 + 4 * (lane >> 4), a, loadz(lane & 15, c0 + 4 * (lane >> 4)));
      }
    }
  }
}

__device__ __forceinline__ f32x4 un4bf(uint2 w) {
  f32x4 r; r[0] = __uint_as_float(w.x << 16); r[1] = __uint_as_float(w.x & 0xffff0000u); r[2] = __uint_as_float(w.y << 16); r[3] = __uint_as_float(w.y & 0xffff0000u); return r;
}
__device__ __forceinline__ f32x4 ld4bf(const bf16_t* ptr) {
  const uint2 w = *(const uint2*)ptr; f32x4 r;
  r[0] = __uint_as_float(w.x << 16); r[1] = __uint_as_float(w.x & 0xffff0000u); r[2] = __uint_as_float(w.y << 16); r[3] = __uint_as_float(w.y & 0xffff0000u); return r;
}
__device__ __forceinline__ void phase_merge(const Params& p, char* lds, int tid) {
  const bf16_t* YS = (const bf16_t*)(p.ws + OFF_YS); const bf16_t* YA = (const bf16_t*)(p.ws + OFF_YA);
  const bf16_t* GS = (const bf16_t*)(p.ws + OFF_GS); const bf16_t* GA = (const bf16_t*)(p.ws + OFF_GA);
  const bf16_t* Wbs = (const bf16_t*)(p.ws + OFF_W + W_BS); const bf16_t* Wba = (const bf16_t*)(p.ws + OFF_W + W_BA);
  bf16_t* MG = (bf16_t*)(p.ws + OFF_Q);
  const int lane = tid & 63, wave = tid >> 6, wm = wave >> 1, wn = wave & 1, lrow = tid >> 2, lch = tid & 3; int le = lane;
  constexpr int nN = 4;
  const int nit = tile_iters(nN);
  for (int it = 0; it < nit + 1; ++it) {
    if (it < nit) {
      int tm, tn; if (!tile_of(it, nN, tm, tn)) continue;
      const int m0 = 16 + tm * 128;
      f32x16 acc[2][4]; zero_acc(acc);
      int tl = tid; asm volatile("" : "+v"(tl));
      const int lrow = tl >> 2, lch = (tl & 3) ^ ((tl >> 4) & 3);
      gemm_acc(acc, YS + ((size_t)tm * 16 * 128 + lrow) * 32 + lch * 8, 32, 4096, Wbs + ((size_t)tn * 16 * 256 + lrow) * 32 + lch * 8, 32, 8192, 16, lds, tid);
      LAUNDER_LANE();
#pragma unroll
      for (int mi = 0; mi < 2; ++mi) {
        const int row = m0 + wm * 64 + mi * 32 + (le & 31);
#pragma unroll
        for (int hf = 0; hf < 2; ++hf) {
        uint2 gw[2][4];
#pragma unroll
        for (int ni = 0; ni < 2; ++ni)
#pragma unroll
          for (int q = 0; q < 4; ++q) gw[ni][q] = *(const uint2*)(GS + (size_t)row * D + tn * 256 + wn * 128 + (2 * hf + ni) * 32 + 8 * q + 4 * (le >> 5));
#pragma unroll
        for (int ni = 0; ni < 2; ++ni)
#pragma unroll
          for (int q = 0; q < 4; ++q) {
            f32x4 gsv = un4bf(gw[ni][q]);
            gsv[0] = sigmoidf_(gsv[0]); gsv[1] = sigmoidf_(gsv[1]); gsv[2] = sigmoidf_(gsv[2]); gsv[3] = sigmoidf_(gsv[3]);
            f32x4 t;
#pragma unroll
            for (int j = 0; j < 4; ++j) t[j] = acc[mi][2 * hf + ni][4 * q + j] * gsv[j];
            *(uint2*)(MG + blkfast(tm, 32, tn * 8 + wn * 4 + 2 * hf + ni, (wm * 64 + mi * 32 + (le & 31)) * 32 + 8 * q + 4 * (le >> 5))) = pack4(t);
          }
        asm volatile("" ::: "memory");
        }
      }
      zero_acc(acc);
      gemm_acc(acc, YA + ((size_t)tm * 32 * 128 + lrow) * 32 + lch * 8, 32, 4096, Wba + ((size_t)tn * 32 * 256 + lrow) * 32 + lch * 8, 32, 8192, 32, lds, tid);
      LAUNDER_LANE();
#pragma unroll
      for (int mi = 0; mi < 2; ++mi) {
        const int row = m0 + wm * 64 + mi * 32 + (le & 31);
#pragma unroll
        for (int hf = 0; hf < 2; ++hf) {
        uint2 gw[2][4], pw[2][4];
#pragma unroll
        for (int ni = 0; ni < 2; ++ni)
#pragma unroll
          for (int q = 0; q < 4; ++q) {
            gw[ni][q] = *(const uint2*)(GA + (size_t)row * D + tn * 256 + wn * 128 + (2 * hf + ni) * 32 + 8 * q + 4 * (le >> 5));
            pw[ni][q] = *(const uint2*)(MG + blkfast(tm, 32, tn * 8 + wn * 4 + 2 * hf + ni, (wm * 64 + mi * 32 + (le & 31)) * 32 + 8 * q + 4 * (le >> 5)));
          }
#pragma unroll
        for (int ni = 0; ni < 2; ++ni)
#pragma unroll
          for (int q = 0; q < 4; ++q) {
            const int col = tn * 256 + wn * 128 + (2 * hf + ni) * 32 + 8 * q + 4 * (le >> 5);
            f32x4 gav = un4bf(gw[ni][q]);
            gav[0] = sigmoidf_(gav[0]); gav[1] = sigmoidf_(gav[1]); gav[2] = sigmoidf_(gav[2]); gav[3] = sigmoidf_(gav[3]);
            const uint2 pk = pw[ni][q];
            f32x4 o;
            o[0] = __uint_as_float(pk.x << 16) + gav[0] * acc[mi][2 * hf + ni][4 * q + 0];
            o[1] = __uint_as_float(pk.x & 0xffff0000u) + gav[1] * acc[mi][2 * hf + ni][4 * q + 1];
            o[2] = __uint_as_float(pk.y << 16) + gav[2] * acc[mi][2 * hf + ni][4 * q + 2];
            o[3] = __uint_as_float(pk.y & 0xffff0000u) + gav[3] * acc[mi][2 * hf + ni][4 * q + 3];
            *(uint2*)(MG + blkfast(tm, 32, tn * 8 + wn * 4 + 2 * hf + ni, (wm * 64 + mi * 32 + (le & 31)) * 32 + 8 * q + 4 * (le >> 5))) = pack4(o);
          }
        asm volatile("" ::: "memory");
        }
      }
    } else for (int v = sk_first(); v < 64; v += gridDim.x) {
      {
      const int c0 = v * 16;
      auto xs = [&](int m, int kc) { return YS + (((size_t)128 * 16 + (kc >> 2)) * 128 + m) * 32 + (kc & 3) * 8; };
      auto ws_ = [&](int n, int kc) { return wblk(Wbs, 16, c0 + n, kc); };
      auto xa = [&](int m, int kc) { return YA + (((size_t)128 * 32 + (kc >> 2)) * 128 + m) * 32 + (kc & 3) * 8; };
      auto wa = [&](int n, int kc) { return wblk(Wba, 32, c0 + n, kc); };
      const f32x4 a1 = skinny_acc(xs, ws_, 16, lds, tid);
      const f32x4 a2 = skinny_acc(xa, wa, 32, lds, tid);
      if (wave == 0) {
        const int row = lane & 15, col = c0 + 4 * (lane >> 4);
        f32x4 gsv = ld4bf(GS + (size_t)row * D + col), gav = ld4bf(GA + (size_t)row * D + col);
#pragma unroll
        for (int j = 0; j < 4; ++j) { gsv[j] = sigmoidf_(gsv[j]); gav[j] = sigmoidf_(gav[j]); }
        f32x4 o;
#pragma unroll
        for (int j = 0; j < 4; ++j) o[j] = gsv[j] * a1[j] + gav[j] * a2[j];
        *(uint2*)(MG + blkidx(row, col, 32)) = pack4(o);
      }
      }
    }
  }
}

__device__ __forceinline__ void phase_final(const Params& p, int tid) {
  const float* h = (const float*)(p.ws + OFF_H);
  const int lane = tid & 63, wave = tid >> 6;
  for (int r = blockIdx.x * 4 + wave; r < NX; r += gridDim.x * 4) {
    const float rs = row_rstd(p, 12, r + 16);
#pragma unroll
    for (int i = 0; i < 4; ++i) {
      const int c = i * 256 + lane * 4;
      f32x4 v = *(const f32x4*)(h + (size_t)(r + 16) * D + c);
      const f32x4 g = *(const f32x4*)(p.final_norm + c);
      v = v * rs * g;
      *(f32x4*)(p.out + (size_t)r * D + c) = v;
    }
  }
}

#define XB_XCNT(j) (64 * (j))
#define XB_XSUB(j) (1024 + 64 * (j))
#define XB_TOP 2048
#define XB_PLAIN 2112
#define XB_WORDS 2176
struct GridBar { unsigned* bar; unsigned xcc, nloc, nx, gen; };
__device__ __forceinline__ unsigned xb_ld(unsigned* q) { return __hip_atomic_load(q, __ATOMIC_RELAXED, __HIP_MEMORY_SCOPE_AGENT); }
__device__ __forceinline__ void grid_bar_setup(GridBar& gb, unsigned* bar, int tid) {
  gb.bar = bar; gb.gen = 0; gb.nloc = 1; gb.nx = 1;
  gb.xcc = (unsigned)__builtin_amdgcn_s_getreg((3 << 11) | 20) & 0xFu;
  if (tid == 0) {
    const unsigned rank = __hip_atomic_fetch_add(&bar[XB_XCNT(gb.xcc)], 1u, __ATOMIC_RELAXED, __HIP_MEMORY_SCOPE_AGENT);
    __hip_atomic_fetch_add(&bar[XB_PLAIN], 1u, __ATOMIC_RELAXED, __HIP_MEMORY_SCOPE_AGENT);
    while (xb_ld(&bar[XB_PLAIN]) < gridDim.x) __builtin_amdgcn_s_sleep(2);
    unsigned nx = 0; bool even = (gridDim.x & 7u) == 0u;
    for (int j = 0; j < 16; ++j) { const unsigned c = xb_ld(&bar[XB_XCNT(j)]); nx += c != 0u; if (j < 8 ? c != (gridDim.x >> 3) : c != 0u) even = false; }
    s_nx = nx; s_nloc = xb_ld(&bar[XB_XCNT(gb.xcc)]);
    s_vb = even ? (int)(rank * 8u + gb.xcc) : (int)blockIdx.x;
  }
  __syncthreads();
}
__device__ __forceinline__ void grid_bar(GridBar& gb, int tid) {
  asm volatile("s_waitcnt vmcnt(0) lgkmcnt(0)" ::: "memory");
  __syncthreads();
  gb.gen += 1;
  if (tid == 0) {
    const unsigned old = __hip_atomic_fetch_add(&gb.bar[XB_XSUB(gb.xcc)], 1u, __ATOMIC_RELAXED, __HIP_MEMORY_SCOPE_AGENT);
    if (old + 1 == s_nloc * gb.gen) {
      __builtin_amdgcn_fence(__ATOMIC_RELEASE, "agent");
      asm volatile("s_waitcnt vmcnt(0)" ::: "memory");
      __hip_atomic_fetch_add(&gb.bar[XB_TOP], 1u, __ATOMIC_RELAXED, __HIP_MEMORY_SCOPE_AGENT);
    }
    const unsigned target = s_nx * gb.gen;
    while (xb_ld(&gb.bar[XB_TOP]) < target) __builtin_amdgcn_s_sleep(1);
    __builtin_amdgcn_fence(__ATOMIC_ACQUIRE, "agent");
    asm volatile("s_waitcnt vmcnt(0)" ::: "memory");
  }
  __syncthreads();
}

__device__ __forceinline__ int lane_id_now() { int l; asm volatile("v_mbcnt_lo_u32_b32 %0, -1, 0\n\tv_mbcnt_hi_u32_b32 %0, -1, %0" : "=v"(l)); return l; }
__global__ void __launch_bounds__(256, 2) fwd_megakernel(Params p) {
  cg::grid_group grid = cg::this_grid();
  __shared__ __attribute__((aligned(16))) char lds[3 * 24576 + 1024];
  const int wave_s = __builtin_amdgcn_readfirstlane((int)threadIdx.x >> 6);
#define MYTID() (wave_s * 64 + lane_id_now())
    const bf16_t* hb = (const bf16_t*)(p.ws + OFF_HB);
  GridBar gb;
  grid.sync();
  grid_bar_setup(gb, (unsigned*)(p.ws + OFF_BAR), MYTID());
  phase_init(p, MYTID());
  grid_bar(gb, MYTID());
  for (int l = 0; l < 4; ++l) {
#pragma nounroll
    for (int step0 = 0; step0 < 12 + PROBE_EXTRA; ++step0) {
      const int step = step0 < 12 ? step0 : PROBE_STEP;
      if (PROBE_STEP < 0 && step0 >= 12) { grid_bar(gb, MYTID()); continue; }
      int tid = MYTID(); asm volatile("" : "+v"(tid));
      if (step == 0) {}
      else if (step == 1 || step == 10) phase_ffn_up(p, (const bf16_t*)(p.ws + OFF_W + (step == 1 ? W_GU1 : W_GU2)), 3 * l + (step == 1 ? 0 : 2), lds, tid);
      else if (step == 2 || step == 9 || step == 11) {
        const bf16_t* A = (const bf16_t*)(p.ws + (step == 9 ? OFF_Q : OFF_ACT));
        const int K = step == 9 ? D : DFF;
        const bf16_t* Wt = (const bf16_t*)(p.ws + OFF_W + (step == 2 ? W_D1 : (step == 9 ? W_O : W_D2)));
        const int sn = 3 * l + (step == 2 ? 1 : (step == 9 ? 2 : 3));
        phase_resid(p, A, K, Wt, sn, lds, tid);
      }
      else if (step == 3) phase_win(p, 3 * l + 1, lds, tid);
      else if (step == 4) phase_attn_xend(p, l, lds, tid);
      else if (step == 5) phase_scan(p, l, tid);
      else if (step == 6) phase_ssm_out(p, l, lds, tid);
      else if (step == 7) phase_glu(p, lds, tid);
      else phase_merge(p, lds, tid);
      {
        int pl = l, pb = 0, pe = 0, skip = 0;
        if (step == 0) { pb = l == 0 ? 0 : 3136; pe = l == 0 ? 10560 : 5952; }
        else if (step == 5 && l < 3) { pl = l + 1; pb = 0; pe = 3136; skip = 16; }
        else if (step == 7 && l < 3) { pl = l + 1; pb = 5952; pe = 10560; }
        if (pe > pb) phase_prep(p, pl, pb, pe, skip, lds, tid);
      }
      grid_bar(gb, MYTID());
#ifdef DBG_STEPS
      if (l * 12 + step + 1 == DBG_STEPS) {
        const int gt = blockIdx.x * 256 + MYTID();
#if DBG_MODE == 0
        const float* hsrc = (const float*)(p.ws + OFF_H);
        for (int i = gt; i < NX * D; i += gridDim.x * 256) p.out[i] = hsrc[i + 16 * D];
#else
        const bf16_t* bsrc = (const bf16_t*)(p.ws + DBG_BUF);
        for (int i = gt; i < NX * D; i += gridDim.x * 256) p.out[i] = bf2f(bsrc[i % DBG_N]);
#endif
        return;
      }
#endif
    }
  }
  (void)hb;
  phase_final(p, MYTID());
}

extern "C" void kernel_launch(void* const* d_in, const int* in_sizes, int n_in, void* d_out, int out_size, void* d_ws, size_t ws_size,
                              hipStream_t stream) {
  static int grid_blocks = 0;
  if (!grid_blocks) {
    int dev = 0, cus = 0, per_cu = 0;
    (void)hipGetDevice(&dev);
    (void)hipDeviceGetAttribute(&cus, hipDeviceAttributeMultiprocessorCount, dev);
    (void)hipOccupancyMaxActiveBlocksPerMultiprocessor(&per_cu, fwd_megakernel, 256, 0);
    if (per_cu > 2) per_cu = 2;
    if (per_cu < 1) per_cu = 1;
    grid_blocks = cus * per_cu;
  }
  if (ws_size < WS_TOTAL) { fprintf(stderr, "workspace too small: %zu < %zu\n", ws_size, (size_t)WS_TOTAL); return; }
  Params p{};
  const float* const* in = (const float* const*)d_in;
  p.x = in[0]; p.meta = in[1]; p.ffn1_norm = in[2]; p.ffn1_wg = in[3]; p.ffn1_wu = in[4]; p.ffn1_wd = in[5];
  p.mix_norm = in[6]; p.w_in = in[7]; p.lam_re = in[8]; p.lam_im = in[9]; p.log_dt = in[10];
  p.b_re = in[11]; p.b_im = in[12]; p.c_re = in[13]; p.c_im = in[14]; p.ssm_d = in[15]; p.w_glu = in[16];
  p.sink = in[17]; p.w_bs = in[18]; p.w_ba = in[19]; p.w_out = in[20]; p.ffn2_norm = in[21];
  p.ffn2_wg = in[22]; p.ffn2_wu = in[23]; p.ffn2_wd = in[24]; p.final_norm = in[25];
  p.out = (float*)d_out; p.ws = (char*)d_ws;
  void* args[] = {&p};
  (void)hipMemsetAsync((char*)d_ws + OFF_BAR, 0, 16384, stream);
  hipError_t e = hipLaunchCooperativeKernel((void*)fwd_megakernel, dim3(grid_blocks), dim3(256), args, 0, stream);
  if (e != hipSuccess) fprintf(stderr, "cooperative launch failed: %s (grid %d)\n", hipGetErrorString(e), grid_blocks);
}
```

```cpp
#ifndef PROBE_EXTRA
#define PROBE_EXTRA 0
#define PROBE_STEP 0
#endif
#include <hip/hip_runtime.h>
#include <hip/hip_cooperative_groups.h>
#include <cstdio>
#include <cstdint>
namespace cg = cooperative_groups;

typedef unsigned short bf16_t;
typedef short bf16x8 __attribute__((ext_vector_type(8)));
typedef float f32x16 __attribute__((ext_vector_type(16)));
typedef float f32x4 __attribute__((ext_vector_type(4)));

constexpr int L = 16400, NX = 16384, D = 1024, DFF = 2816;
constexpr int NG = 32, NP = 64;
constexpr int NCH = 257, LU = NCH * 64;
constexpr int LV = 16640;
constexpr int PADK = 64;
constexpr int LDH = D + PADK;
constexpr int LS = 16512;
constexpr int LZ = 16400;

constexpr size_t AL(size_t x) { return (x + 255) & ~(size_t)255; }
constexpr size_t OFF_H = 0;
constexpr size_t OFF_HB = OFF_H + AL((size_t)L * D * 4);
constexpr size_t OFF_SSQ = OFF_HB + AL((size_t)L * LDH * 2);
constexpr size_t OFF_SSK = OFF_SSQ + AL((size_t)13 * 16 * LS * 4);
constexpr size_t OFF_ACT = OFF_SSK + AL((size_t)13 * 64 * 16 * 4);
constexpr size_t OFF_Q = OFF_ACT;
constexpr size_t OFF_GS = OFF_Q + AL((size_t)129 * 128 * D * 2);
constexpr size_t OFF_K = OFF_GS + AL((size_t)L * D * 2);
constexpr size_t OFF_VT = OFF_K + AL((size_t)L * 256 * 2);
constexpr size_t OFF_VT_END = OFF_VT + AL((size_t)256 * LV * 2);
constexpr size_t OFF_GA = OFF_ACT + AL((size_t)129 * 128 * DFF * 2);
static_assert(OFF_VT_END <= OFF_GA, "alias overflow");
constexpr size_t OFF_YA = OFF_GA + AL((size_t)L * D * 2);
constexpr size_t OFF_UG = OFF_YA + AL((size_t)129 * 128 * D * 2) + 65536;
constexpr size_t OFF_Z = OFF_UG + AL((size_t)NG * LU * 16 * 2);
constexpr size_t OFF_YS = OFF_Z + AL((size_t)L * 512 * 2);
constexpr size_t OFF_XEND = OFF_YS + AL((size_t)129 * 128 * 512 * 2);
constexpr size_t OFF_XIN = OFF_XEND + AL((size_t)NG * NCH * 256 * 4);
constexpr size_t OFF_W = OFF_XIN + AL((size_t)NG * NCH * 256 * 2);
constexpr size_t W_GU1 = 0;
constexpr size_t W_D1 = W_GU1 + (size_t)2 * DFF * (D + PADK) * 2;
constexpr size_t W_IN = W_D1 + (size_t)D * (DFF + PADK) * 2;
constexpr size_t W_GLU = W_IN + (size_t)4096 * (D + PADK) * 2;
constexpr size_t W_BS = W_GLU + (size_t)512 * (512 + PADK) * 2;
constexpr size_t W_BA = W_BS + (size_t)D * (512 + PADK) * 2;
constexpr size_t W_O = W_BA + (size_t)D * (D + PADK) * 2;
constexpr size_t W_GU2 = W_O + (size_t)D * (D + PADK) * 2;
constexpr size_t W_D2 = W_GU2 + (size_t)2 * DFF * (D + PADK) * 2;
constexpr size_t W_TOTAL = W_D2 + (size_t)D * (DFF + PADK) * 2;
constexpr size_t OFF_KTAB = OFF_W + AL(W_TOTAL);
constexpr size_t OFF_WEND = OFF_KTAB + AL((size_t)NG * 127 * 256 * 2);
constexpr size_t OFF_MCAR = OFF_WEND + AL((size_t)NG * 256 * 1024 * 2);
constexpr size_t OFF_LP = OFF_MCAR + AL((size_t)NG * 1024 * 256 * 2);
constexpr size_t OFF_BB = OFF_LP + AL((size_t)4 * 2 * NG * NP * 65 * 8);
constexpr size_t OFF_BAR = OFF_BB + AL((size_t)4 * 2 * NG * NP * 16 * 8);
constexpr size_t WS_TOTAL = OFF_BAR + 16384;

struct Params {
  const float* x; const float* meta; const float* ffn1_norm; const float* ffn1_wg; const float* ffn1_wu; const float* ffn1_wd;
  const float* mix_norm; const float* w_in; const float* lam_re; const float* lam_im; const float* log_dt;
  const float* b_re; const float* b_im; const float* c_re; const float* c_im; const float* ssm_d; const float* w_glu;
  const float* sink; const float* w_bs; const float* w_ba; const float* w_out; const float* ffn2_norm;
  const float* ffn2_wg; const float* ffn2_wu; const float* ffn2_wd; const float* final_norm;
  float* out; char* ws;
};

#define LAUNDER_LANE() do { le = lane; asm volatile("" : "+v"(le)); } while (0)
__device__ __forceinline__ const bf16_t* wblk(const bf16_t* W, int nkt, int R, int kc) { return W + (((size_t)(R >> 8) * nkt + (kc >> 2)) * 256 + (R & 255)) * 32 + (kc & 3) * 8; }
__device__ __forceinline__ size_t hbidx(int row, int col) {
  const int rr = row - 16; const int tmx = row < 16 ? 128 : (rr >> 7), r = row < 16 ? row : (rr & 127);
  return (((size_t)tmx * 32 + (col >> 5)) * 128 + r) * 32 + (col & 31);
}
__device__ __forceinline__ size_t blkidx(int row, int col, int nkt) {
  const int rr = row - 16; const int tmx = row < 16 ? 128 : (rr >> 7), r = row < 16 ? row : (rr & 127);
  return (((size_t)tmx * nkt + (col >> 5)) * 128 + r) * 32 + (col & 31);
}
__device__ __forceinline__ size_t blkfast(int tm, int nkt, int cb, int rl) { return ((size_t)tm * nkt + cb) * 4096 + rl; }
__device__ __forceinline__ unsigned cvt_pk_bf16(float lo, float hi) { unsigned r; asm volatile("v_cvt_pk_bf16_f32 %0, %1, %2" : "=v"(r) : "v"(lo), "v"(hi)); return r; }
__device__ __forceinline__ float bf2f(bf16_t v) { return __uint_as_float(((unsigned)v) << 16); }
__device__ __forceinline__ float sigmoidf_(float v) { return __builtin_amdgcn_rcpf(1.0f + __expf(-v)); }
__device__ __forceinline__ float gelu_tanh(float x) { const float u = 1.5957691216f * (x + 0.044715f * x * x * x); return x * sigmoidf_(u); }
__device__ __forceinline__ int lds_off(int row, int ch) { return row * 128 + ((ch ^ ((row >> 1) & 7)) << 4); }
__device__ __forceinline__ uint2 pack4(f32x4 v) { uint2 r; r.x = cvt_pk_bf16(v[0], v[1]); r.y = cvt_pk_bf16(v[2], v[3]); return r; }

__device__ __forceinline__ float row_rstd(const Params& p, int si, int row) {
  float s = 0.f;
  if (row >= 16) {
    const float* q = (const float*)(p.ws + OFF_SSQ) + (size_t)si * 16 * LS + row + 16;
#pragma unroll
    for (int i = 0; i < 16; ++i) s += q[(size_t)i * LS];
  } else {
    const float* q = (const float*)(p.ws + OFF_SSK) + (size_t)si * 64 * 16 + row;
    for (int i = 0; i < 64; ++i) s += q[i * 16];
  }
  return rsqrtf(s * (1.f / 1024.f) + 1e-6f);
}
__device__ __forceinline__ float* ssq_slot(const Params& p, int si, int slot, int row) { return (float*)(p.ws + OFF_SSQ) + ((size_t)si * 16 + slot) * LS + row + 16; }
__device__ __forceinline__ float* ssk_slot(const Params& p, int si, int slot, int row) { return (float*)(p.ws + OFF_SSK) + ((size_t)si * 64 + slot) * 16 + row; }

#define GSTAGE 24576
typedef __attribute__((address_space(3))) void* lds_ptr_t;
typedef const __attribute__((address_space(1))) void* glb_ptr_t;
typedef int i32x4 __attribute__((ext_vector_type(4)));
#define GDMA(stagebase) do { char* _d = (stagebase) + tid * 16; \
    __builtin_amdgcn_global_load_lds((glb_ptr_t)(xp), (lds_ptr_t)(_d), 16, 0, 0); \
    __builtin_amdgcn_global_load_lds((glb_ptr_t)(xp + (size_t)64 * xld), (lds_ptr_t)(_d + 4096), 16, 0, 0); \
    __builtin_amdgcn_global_load_lds((glb_ptr_t)(wp), (lds_ptr_t)(_d + 8192), 16, 0, 0); \
    __builtin_amdgcn_global_load_lds((glb_ptr_t)(wp + (size_t)64 * wld), (lds_ptr_t)(_d + 12288), 16, 0, 0); \
    __builtin_amdgcn_global_load_lds((glb_ptr_t)(wp + (size_t)128 * wld), (lds_ptr_t)(_d + 16384), 16, 0, 0); \
    __builtin_amdgcn_global_load_lds((glb_ptr_t)(wp + (size_t)192 * wld), (lds_ptr_t)(_d + 20480), 16, 0, 0); } while (0)
__device__ __forceinline__ void gemm_acc(f32x16 (&acc)[2][4], const bf16_t* xp, int xld, int xks, const bf16_t* wp, int wld, int wks,
                                         int nkt, char* lds, int tid) {
  const int lane = tid & 63, wave = tid >> 6, wm = wave >> 1, wn = wave & 1;
  __syncthreads();
  GDMA(lds);
  if (nkt > 1) { xp += xks; wp += wks; GDMA(lds + GSTAGE); asm volatile("s_waitcnt vmcnt(6)" ::: "memory"); }
  else asm volatile("s_waitcnt vmcnt(0)" ::: "memory");
  __builtin_amdgcn_s_barrier();
  const int r31 = lane & 31, hh = lane >> 5, swz = (r31 >> 2) & 3;
  const unsigned lbase = (unsigned)(size_t)lds;
  const unsigned ax0 = lbase + wm * 4096 + r31 * 64 + (((0 + hh) ^ swz) << 4), ax1 = lbase + wm * 4096 + r31 * 64 + (((2 + hh) ^ swz) << 4);
  const unsigned aw0 = ax0 - wm * 4096 + 8192 + wn * 8192, aw1 = ax1 - wm * 4096 + 8192 + wn * 8192;
#define MMA8(x0, x1, w0, w1, w2, w3) do { \
    const bf16x8 xf0 = __builtin_bit_cast(bf16x8, x0), xf1 = __builtin_bit_cast(bf16x8, x1), wf0 = __builtin_bit_cast(bf16x8, w0), \
                 wf1 = __builtin_bit_cast(bf16x8, w1), wf2 = __builtin_bit_cast(bf16x8, w2), wf3 = __builtin_bit_cast(bf16x8, w3); \
    __builtin_amdgcn_s_setprio(1); \
    acc[0][0] = __builtin_amdgcn_mfma_f32_32x32x16_bf16(wf0, xf0, acc[0][0], 0, 0, 0); \
    acc[0][1] = __builtin_amdgcn_mfma_f32_32x32x16_bf16(wf1, xf0, acc[0][1], 0, 0, 0); \
    acc[0][2] = __builtin_amdgcn_mfma_f32_32x32x16_bf16(wf2, xf0, acc[0][2], 0, 0, 0); \
    acc[0][3] = __builtin_amdgcn_mfma_f32_32x32x16_bf16(wf3, xf0, acc[0][3], 0, 0, 0); \
    acc[1][0] = __builtin_amdgcn_mfma_f32_32x32x16_bf16(wf0, xf1, acc[1][0], 0, 0, 0); \
    acc[1][1] = __builtin_amdgcn_mfma_f32_32x32x16_bf16(wf1, xf1, acc[1][1], 0, 0, 0); \
    acc[1][2] = __builtin_amdgcn_mfma_f32_32x32x16_bf16(wf2, xf1, acc[1][2], 0, 0, 0); \
    acc[1][3] = __builtin_amdgcn_mfma_f32_32x32x16_bf16(wf3, xf1, acc[1][3], 0, 0, 0); \
    __builtin_amdgcn_s_setprio(0); } while (0)
#define KTILE() do { i32x4 x0, x1, w0, w1, w2, w3, y0, y1, v0, v1, v2, v3; \
    asm volatile("ds_read_b128 %0, %12\n\tds_read_b128 %1, %12 offset:2048\n\tds_read_b128 %2, %13\n\tds_read_b128 %3, %13 offset:2048\n\t" \
                 "ds_read_b128 %4, %13 offset:4096\n\tds_read_b128 %5, %13 offset:6144\n\t" \
                 "ds_read_b128 %6, %14\n\tds_read_b128 %7, %14 offset:2048\n\tds_read_b128 %8, %15\n\tds_read_b128 %9, %15 offset:2048\n\t" \
                 "ds_read_b128 %10, %15 offset:4096\n\tds_read_b128 %11, %15 offset:6144\n\ts_waitcnt lgkmcnt(6)" \
                 : "=&v"(x0), "=&v"(x1), "=&v"(w0), "=&v"(w1), "=&v"(w2), "=&v"(w3), "=&v"(y0), "=&v"(y1), "=&v"(v0), "=&v"(v1), "=&v"(v2), "=&v"(v3) \
                 : "v"(ax0 + soff), "v"(aw0 + soff), "v"(ax1 + soff), "v"(aw1 + soff) : "memory"); \
    MMA8(x0, x1, w0, w1, w2, w3); \
    asm volatile("s_waitcnt lgkmcnt(0)" : "+v"(y0), "+v"(y1), "+v"(v0), "+v"(v1), "+v"(v2), "+v"(v3) :: "memory"); \
    MMA8(y0, y1, v0, v1, v2, v3); } while (0)
  int st = 0;
#pragma unroll 1
  for (int kt = 0; kt < nkt; ++kt) {
    const unsigned soff = (unsigned)st * GSTAGE;
    const bool more2 = kt + 2 < nkt;
    if (more2) { xp += xks; wp += wks; const int s2 = st >= 1 ? st - 1 : 2; GDMA(lds + s2 * GSTAGE); }
    KTILE();
    if (more2) asm volatile("s_waitcnt vmcnt(6)" ::: "memory");
    else asm volatile("s_waitcnt vmcnt(0)" ::: "memory");
    __builtin_amdgcn_s_barrier();
    st = st == 2 ? 0 : st + 1;
  }
#undef KTILE
#undef MMA8
  __syncthreads();
}
__device__ __forceinline__ void zero_acc(f32x16 (&acc)[2][4]) {
#pragma unroll
  for (int a = 0; a < 2; ++a)
#pragma unroll
    for (int b = 0; b < 4; ++b)
#pragma unroll
      for (int r = 0; r < 16; ++r) acc[a][b][r] = 0.f;
}

template <class XA, class WA>
__device__ __forceinline__ f32x4 skinny_acc(XA xaddr, WA waddr, int nk32, char* lds, int tid) {
  int lane = tid & 63; const int wave = tid >> 6;
  asm volatile("" : "+v"(lane));
  const int per = nk32 >> 2;
  f32x4 acc = {0.f, 0.f, 0.f, 0.f};
  const int e = (wave + 1) * per;
  for (int s = wave * per; s < e; s += 8) {
    bf16x8 a0, a1, a2, a3, a4, a5, a6, a7, b0, b1, b2, b3, b4, b5, b6, b7;
#define SKL(j) { const int ss = (s + j < e) ? s + j : e - 1; const int kc = ss * 4 + (lane >> 4); a##j = *(const bf16x8*)waddr(lane & 15, kc); b##j = *(const bf16x8*)xaddr(lane & 15, kc); }
    SKL(0) SKL(1) SKL(2) SKL(3) SKL(4) SKL(5) SKL(6) SKL(7)
#undef SKL
#define SKM(j) if (s + j < e) acc = __builtin_amdgcn_mfma_f32_16x16x32_bf16(a##j, b##j, acc, 0, 0, 0);
    SKM(0) SKM(1) SKM(2) SKM(3) SKM(4) SKM(5) SKM(6) SKM(7)
#undef SKM
  }
  __syncthreads();
  f32x4* red = (f32x4*)lds;
  red[wave * 64 + lane] = acc;
  __syncthreads();
  if (wave == 0) acc = red[lane] + red[64 + lane] + red[128 + lane] + red[192 + lane];
  return acc;
}

__shared__ int s_unit;
__shared__ unsigned s_nx, s_nloc;
__shared__ int s_vb;
__device__ __forceinline__ bool tile_of(int it, int nN, int& tm, int& tn) {
  const int G = gridDim.x, b = s_vb;
  const int x = b & 7, j = b >> 3, tmPer = G >> 4;
  const int ptm = j % tmPer, ptn = j / tmPer;
  const int npn = nN >> 1, pi = it * 8 + x;
  tm = (pi / npn) * tmPer + ptm; tn = (pi % npn) * 2 + ptn;
  return tm < 128;
}
__device__ __forceinline__ int sk_first() { const int b = s_vb; return (7 - (b & 7)) * ((int)gridDim.x >> 3) + (b >> 3); }
__device__ __forceinline__ int tile_iters(int nN) { const int npatch = (128 / (gridDim.x >> 4)) * (nN >> 1); return (npatch + 7) >> 3; }

__device__ __forceinline__ void phase_init(const Params& p, int tid) {
  float* h = (float*)(p.ws + OFF_H); bf16_t* hb = (bf16_t*)(p.ws + OFF_HB);
  const int lane = tid & 63, wave = tid >> 6;
  const int gthreads = gridDim.x * 256, gtid = blockIdx.x * 256 + tid;
  for (int r0 = (int)blockIdx.x * 32 - 16; r0 < L; r0 += gridDim.x * 32)
  for (int r = r0 + wave; r < r0 + 32 && r < L; r += 4) {
    if (r < 0) continue;
    const float* src = r < 16 ? p.meta + (size_t)r * D : p.x + (size_t)(r - 16) * D;
    float ss = 0.f;
#pragma unroll
    for (int i = 0; i < 4; ++i) {
      const int c = i * 256 + lane * 4;
      const f32x4 v = *(const f32x4*)(src + c);
      *(f32x4*)(h + (size_t)r * D + c) = v;
      *(uint2*)(hb + hbidx(r, c)) = pack4(v);
      ss += v[0] * v[0] + v[1] * v[1] + v[2] * v[2] + v[3] * v[3];
    }
#pragma unroll
    for (int o = 32; o >= 1; o >>= 1) ss += __shfl_xor(ss, o);
    if (r >= 16) { if (lane < 16) *ssq_slot(p, 0, lane, r) = lane == 0 ? ss : 0.f; }
    else *ssk_slot(p, 0, lane, r) = lane == 0 ? ss : 0.f;
  }
  { bf16_t* ug = (bf16_t*)(p.ws + OFF_UG);
    for (int i = gtid; i < NG * 48 * 16 / 2; i += gthreads) { const int g = i / 384, w = i - g * 384; *(unsigned*)(ug + (size_t)g * LU * 16 + w * 2) = 0u; } }
  float2* LP = (float2*)(p.ws + OFF_LP); float2* BB = (float2*)(p.ws + OFF_BB);
  for (int i = gtid; i < 4 * 2 * NG * NP * 65; i += gthreads) {
    const int j = i % 65, q = i / 65;
    const float lre = p.lam_re[q], lim = p.lam_im[q];
    const float dt = expf(p.log_dt[q >> 6]);
    const float a = lre * dt;
    double ang = (double)j * ((double)lim * (double)dt);
    ang -= 6.283185307179586477 * rint(ang * 0.15915494309189533577);
    const float ra = (float)ang;
    const float mag = expf((float)j * a);
    LP[i] = make_float2(mag * cosf(ra), mag * sinf(ra));
  }
  for (int i = gtid; i < 4 * 2 * NG * NP * 16; i += gthreads) {
    const int q = i >> 4;
    const float lre = p.lam_re[q], lim = p.lam_im[q];
    const float dt = expf(p.log_dt[q >> 6]);
    const float a = lre * dt, b = lim * dt;
    const float sh = sinf(0.5f * b);
    const float nr = expm1f(a) * cosf(b) - 2.f * sh * sh, ni = expf(a) * sinf(b);
    const float den = 1.f / (lre * lre + lim * lim);
    const float cr = (nr * lre + ni * lim) * den, ci = (ni * lre - nr * lim) * den;
    const float br = p.b_re[i], bi = p.b_im[i];
    BB[i] = make_float2(cr * br - ci * bi, cr * bi + ci * br);
  }
}

__device__ __forceinline__ void phase_prep(const Params& p, int l, int ubeg, int uend, int bskip, char* lds, int tid) {
  char* W = p.ws + OFF_W;
  float* ldsf = (float*)lds;
  const float2* LP = (const float2*)(p.ws + OFF_LP) + (size_t)l * 2 * NG * NP * 65;
  const float2* BB = (const float2*)(p.ws + OFF_BB) + (size_t)l * 2 * NG * NP * 16;
  const float* Cre = p.c_re + (size_t)l * 2 * NG * 16 * NP; const float* Cim = p.c_im + (size_t)l * 2 * NG * 16 * NP;
  bf16_t* Ktab = (bf16_t*)(p.ws + OFF_KTAB); bf16_t* Wend = (bf16_t*)(p.ws + OFF_WEND); bf16_t* Mcar = (bf16_t*)(p.ws + OFF_MCAR);
  if ((int)blockIdx.x < bskip) return;
  for (int u = ubeg + (int)blockIdx.x - bskip; u < uend; u += (int)gridDim.x - bskip) {
    if (u < 5952) {
      const float* src; bf16_t* dst; int K, N; const float* rs = nullptr; float sc = 1.f; int perm = 0; int t;
      if (u < 704) { t = u; src = p.ffn1_wg + (size_t)l * D * DFF; dst = (bf16_t*)(W + W_GU1); K = D; N = DFF; rs = p.ffn1_norm + l * D; perm = 1; }
      else if (u < 1408) { t = u - 704; src = p.ffn1_wu + (size_t)l * D * DFF; dst = (bf16_t*)(W + W_GU1); K = D; N = DFF; rs = p.ffn1_norm + l * D; perm = 2; }
      else if (u < 2112) { t = u - 1408; src = p.ffn1_wd + (size_t)l * D * DFF; dst = (bf16_t*)(W + W_D1); K = DFF; N = D; sc = 0.5f; }
      else if (u < 3136) { t = u - 2112; src = p.w_in + (size_t)l * D * 4096; dst = (bf16_t*)(W + W_IN); K = D; N = 4096; rs = p.mix_norm + l * D; }
      else if (u < 3200) { t = u - 3136; src = p.w_glu + (size_t)l * 512 * 512; dst = (bf16_t*)(W + W_GLU); K = 512; N = 512; }
      else if (u < 3328) { t = u - 3200; src = p.w_bs + (size_t)l * 512 * D; dst = (bf16_t*)(W + W_BS); K = 512; N = D; }
      else if (u < 3584) { t = u - 3328; src = p.w_ba + (size_t)l * D * D; dst = (bf16_t*)(W + W_BA); K = D; N = D; }
      else if (u < 3840) { t = u - 3584; src = p.w_out + (size_t)l * D * D; dst = (bf16_t*)(W + W_O); K = D; N = D; }
      else if (u < 4544) { t = u - 3840; src = p.ffn2_wg + (size_t)l * D * DFF; dst = (bf16_t*)(W + W_GU2); K = D; N = DFF; rs = p.ffn2_norm + l * D; perm = 1; }
      else if (u < 5248) { t = u - 4544; src = p.ffn2_wu + (size_t)l * D * DFF; dst = (bf16_t*)(W + W_GU2); K = D; N = DFF; rs = p.ffn2_norm + l * D; perm = 2; }
      else { t = u - 5248; src = p.ffn2_wd + (size_t)l * D * DFF; dst = (bf16_t*)(W + W_D2); K = DFF; N = D; sc = 0.5f; }
      const int nkt = K >> 6; const int kt = t % nkt, nt = t / nkt;
      __syncthreads();
      f32x4 tv[4]; float tsc[4];
#pragma unroll
      for (int i = 0; i < 4; ++i) {
        const int idx = tid + 256 * i, kk = idx >> 4, n4 = idx & 15;
        tv[i] = *(const f32x4*)(src + (size_t)(kt * 64 + kk) * N + nt * 64 + n4 * 4);
        tsc[i] = rs ? rs[kt * 64 + kk] * sc : sc;
      }
#pragma unroll
      for (int i = 0; i < 4; ++i) {
        const int idx = tid + 256 * i, kk = idx >> 4, n4 = idx & 15;
        float* d4 = ldsf + kk * 65 + n4 * 4;
        d4[0] = tv[i][0] * tsc[i]; d4[1] = tv[i][1] * tsc[i]; d4[2] = tv[i][2] * tsc[i]; d4[3] = tv[i][3] * tsc[i];
      }
      __syncthreads();
      const int n = tid >> 2, kq = tid & 3;
      unsigned w[8];
#pragma unroll
      for (int j = 0; j < 8; ++j) w[j] = cvt_pk_bf16(ldsf[(kq * 16 + 2 * j) * 65 + n], ldsf[(kq * 16 + 2 * j + 1) * 65 + n]);
      int R = nt * 64 + n;
      if (perm) { const int tn = R >> 7, wn = (R >> 6) & 1, pr = (R >> 5) & 1, xx = R & 31; R = tn * 256 + wn * 128 + pr * 64 + xx + (perm == 2 ? 32 : 0); }
      const int k0 = kt * 64 + kq * 16;
      uint4* d = (uint4*)(dst + (((size_t)(R >> 8) * (K >> 5) + (k0 >> 5)) * 256 + (R & 255)) * 32 + (k0 & 31));
      d[0] = make_uint4(w[0], w[1], w[2], w[3]); d[1] = make_uint4(w[4], w[5], w[6], w[7]);
    } else if (u < 6464) {
      const int v = u - 5952, g = v >> 4, dd0 = (v & 15) * 8;
      float2* Cs = (float2*)lds;
      float2* Ws = (float2*)(lds + 16384);
      __syncthreads();
      for (int i = tid; i < 2048; i += 256) { const int dr = i >> 10, c = (i >> 6) & 15, pp = i & 63; const size_t ci = (size_t)((dr * NG + g) * 16 + c) * NP + pp; Cs[i] = make_float2(Cre[ci], Cim[ci]); }
      for (int j = 0; j < 8; ++j) {
        const int dd = dd0 + j; if (dd >= 127) break;
        const int d = dd - 63;
        __syncthreads();
#pragma unroll
        for (int ii = 0; ii < 8; ++ii) {
          const int i = tid + 256 * ii, dr = i >> 10, pp = (i >> 4) & 63, c2 = i & 15;
          const bool need = dr == 0 ? d >= 0 : d <= 0;
          float2 w = make_float2(0.f, 0.f);
          if (need) { const float2 a = LP[((size_t)(dr * NG + g) * NP + pp) * 65 + (d < 0 ? -d : d)], bb = BB[((size_t)(dr * NG + g) * NP + pp) * 16 + c2]; w = make_float2(a.x * bb.x - a.y * bb.y, a.x * bb.y + a.y * bb.x); }
          Ws[i] = w;
        }
        __syncthreads();
        const int c = tid >> 4, c2 = tid & 15;
        float sum = 0.f;
#pragma unroll 8
        for (int i = 0; i < 128; ++i) { const float2 cc = Cs[(i >> 6) * 1024 + c * 64 + (i & 63)], w = Ws[i * 16 + c2]; sum += cc.x * w.x - cc.y * w.y; }
        Ktab[((size_t)g * 127 + dd) * 256 + tid] = (bf16_t)(cvt_pk_bf16(sum, 0.f) & 0xffffu);
      }
    } else if (u < 8512) {
      const int v = u - 6464;
      const size_t e0 = ((size_t)v * 256 + tid) * 16;
      const int kk = (int)(e0 & 1023), pr = (int)((e0 >> 10) & 255), g = (int)(e0 >> 18);
      const int dr = pr >> 7, ri = (pr >> 6) & 1, pp = pr & 63, s = kk >> 4, c0 = kk & 15;
      const float2 a = LP[((size_t)(dr * NG + g) * NP + pp) * 65 + (dr ? s : 63 - s)];
      const float2* bb = BB + ((size_t)(dr * NG + g) * NP + pp) * 16 + c0;
      float o[16];
#pragma unroll
      for (int j = 0; j < 16; ++j) { const float2 b = bb[j]; o[j] = ri ? (a.x * b.y + a.y * b.x) : (a.x * b.x - a.y * b.y); }
      *(uint4*)(Wend + e0) = make_uint4(cvt_pk_bf16(o[0], o[1]), cvt_pk_bf16(o[2], o[3]), cvt_pk_bf16(o[4], o[5]), cvt_pk_bf16(o[6], o[7]));
      *(uint4*)(Wend + e0 + 8) = make_uint4(cvt_pk_bf16(o[8], o[9]), cvt_pk_bf16(o[10], o[11]), cvt_pk_bf16(o[12], o[13]), cvt_pk_bf16(o[14], o[15]));
    } else {
      const int v = u - 8512;
      const size_t e0 = ((size_t)v * 256 + tid) * 16;
      const int pr = (int)(e0 & 255), n = (int)((e0 >> 8) & 1023), g = (int)(e0 >> 18);
      const int dr = pr >> 7, ri = (pr >> 6) & 1, p0 = pr & 63, t = n >> 4, c = n & 15;
      const int e = dr ? 64 - t : t + 1;
      const float* cr = Cre + (size_t)((dr * NG + g) * 16 + c) * NP + p0; const float* ci = Cim + (size_t)((dr * NG + g) * 16 + c) * NP + p0;
      float o[16];
#pragma unroll
      for (int j = 0; j < 16; ++j) { const float2 a = LP[((size_t)(dr * NG + g) * NP + p0 + j) * 65 + e]; o[j] = ri ? -(cr[j] * a.y + ci[j] * a.x) : (cr[j] * a.x - ci[j] * a.y); }
      *(uint4*)(Mcar + e0) = make_uint4(cvt_pk_bf16(o[0], o[1]), cvt_pk_bf16(o[2], o[3]), cvt_pk_bf16(o[4], o[5]), cvt_pk_bf16(o[6], o[7]));
      *(uint4*)(Mcar + e0 + 8) = make_uint4(cvt_pk_bf16(o[8], o[9]), cvt_pk_bf16(o[10], o[11]), cvt_pk_bf16(o[12], o[13]), cvt_pk_bf16(o[14], o[15]));
    }
  }
}

__device__ __forceinline__ void phase_ffn_up(const Params& p, const bf16_t* Wgu, int si, char* lds, int tid) {
  const bf16_t* hb = (const bf16_t*)(p.ws + OFF_HB); bf16_t* act = (bf16_t*)(p.ws + OFF_ACT);
  const int lane = tid & 63, wave = tid >> 6, wm = wave >> 1, wn = wave & 1, lrow = tid >> 2, lch = tid & 3; int le = lane;
  constexpr int nN = 22;
  const int nit = tile_iters(nN);
  for (int it = 0; it < nit + 1; ++it) {
    if (it < nit) {
      int tm, tn; if (!tile_of(it, nN, tm, tn)) continue;
      const int m0 = 16 + tm * 128;
      f32x16 acc[2][4]; zero_acc(acc);
      int tl = tid; asm volatile("" : "+v"(tl));
      const int lrow = tl >> 2, lch = (tl & 3) ^ ((tl >> 4) & 3);
      float* rsl = (float*)(lds + 3 * GSTAGE) + (it & 1) * 128;
      if (tid < 128) rsl[tid] = row_rstd(p, si, m0 + tid);
      gemm_acc(acc, hb + ((size_t)tm * 32 * 128 + lrow) * 32 + lch * 8, 32, 4096, Wgu + ((size_t)tn * 32 * 256 + lrow) * 32 + lch * 8, 32, 8192, 32, lds, tid);
      LAUNDER_LANE();
#pragma unroll
      for (int mi = 0; mi < 2; ++mi) {
        const int row = m0 + wm * 64 + mi * 32 + (le & 31);
        const float rs = rsl[wm * 64 + mi * 32 + (le & 31)];
#pragma unroll
        for (int pr = 0; pr < 2; ++pr)
#pragma unroll
        for (int q = 0; q < 4; ++q) {
          f32x4 o;
#pragma unroll
          for (int j = 0; j < 4; ++j) { const float g = acc[mi][2 * pr][4 * q + j] * rs, uu = acc[mi][2 * pr + 1][4 * q + j] * rs; o[j] = g * sigmoidf_(g) * uu; }
          *(uint2*)(act + blkfast(tm, 88, tn * 4 + wn * 2 + pr, (wm * 64 + mi * 32 + (le & 31)) * 32 + 8 * q + 4 * (le >> 5))) = pack4(o);
        }
      }
    } else for (int v = sk_first(); v < 176; v += gridDim.x) {
      {
      const int c0 = v * 16, tn = c0 >> 7, wnn = (c0 >> 6) & 1, pr = (c0 >> 5) & 1, x0 = c0 & 31;
      const int Rg = tn * 256 + wnn * 128 + pr * 64 + x0;
      auto xa = [&](int m, int kc) { return hb + (((size_t)128 * 32 + (kc >> 2)) * 128 + m) * 32 + (kc & 3) * 8; };
      auto wg = [&](int n, int kc) { return wblk(Wgu, 32, Rg + n, kc); };
      auto wu = [&](int n, int kc) { return wblk(Wgu, 32, Rg + 32 + n, kc); };
      const f32x4 ag = skinny_acc(xa, wg, 32, lds, tid);
      const f32x4 au = skinny_acc(xa, wu, 32, lds, tid);
      if (wave == 0) {
        const int row = lane & 15;
        const float rs = row_rstd(p, si, row);
        f32x4 o;
#pragma unroll
        for (int j = 0; j < 4; ++j) { const float g = ag[j] * rs, uu = au[j] * rs; o[j] = g * sigmoidf_(g) * uu; }
        *(uint2*)(act + blkidx(row, c0 + 4 * (lane >> 4), 88)) = pack4(o);
      }
      }
    }
  }
}

__device__ __forceinline__ void resid_store(float* h, bf16_t* hb, int row, int col, f32x4 a, float& ss) {
  float* hp = h + (size_t)row * D + col;
  f32x4 hv = *(const f32x4*)hp;
  hv += a;
  *(f32x4*)hp = hv;
  *(uint2*)(hb + hbidx(row, col)) = pack4(hv);
  ss += hv[0] * hv[0] + hv[1] * hv[1] + hv[2] * hv[2] + hv[3] * hv[3];
}
__device__ __forceinline__ void phase_resid(const Params& p, const bf16_t* A, int K, const bf16_t* Wt, int si_next, char* lds, int tid) {
  float* h = (float*)(p.ws + OFF_H); bf16_t* hb = (bf16_t*)(p.ws + OFF_HB);
  const int lane = tid & 63, wave = tid >> 6, wm = wave >> 1, wn = wave & 1, lrow = tid >> 2, lch = tid & 3; int le = lane;
  constexpr int nN = 4;
  const int nit = tile_iters(nN);
  for (int it = 0; it < nit + 1; ++it) {
    if (it < nit) {
      int tm, tn; if (!tile_of(it, nN, tm, tn)) continue;
      const int m0 = 16 + tm * 128;
      f32x16 acc[2][4]; zero_acc(acc);
      int tl = tid; asm volatile("" : "+v"(tl));
      const int lrow = tl >> 2, lch = (tl & 3) ^ ((tl >> 4) & 3);
      gemm_acc(acc, A + ((size_t)tm * (K >> 5) * 128 + lrow) * 32 + lch * 8, 32, 4096, Wt + ((size_t)tn * (K >> 5) * 256 + lrow) * 32 + lch * 8, 32, 8192, K >> 5, lds, tid);
      LAUNDER_LANE();
#pragma unroll
      for (int mi = 0; mi < 2; ++mi) {
        const int row = m0 + wm * 64 + mi * 32 + (le & 31);
#pragma unroll
        for (int hf = 0; hf < 2; ++hf) {
        float ss = 0.f;
        f32x4 hv[2][4];
#pragma unroll
        for (int ni = 0; ni < 2; ++ni)
#pragma unroll
          for (int q = 0; q < 4; ++q) {
            hv[ni][q] = *(const f32x4*)(h + (size_t)row * D + tn * 256 + wn * 128 + (2 * hf + ni) * 32 + 8 * q + 4 * (le >> 5));
          }
#pragma unroll
        for (int ni = 0; ni < 2; ++ni)
#pragma unroll
          for (int q = 0; q < 4; ++q) {
            f32x4 a; a[0] = acc[mi][2 * hf + ni][4 * q]; a[1] = acc[mi][2 * hf + ni][4 * q + 1]; a[2] = acc[mi][2 * hf + ni][4 * q + 2]; a[3] = acc[mi][2 * hf + ni][4 * q + 3];
            const int col = tn * 256 + wn * 128 + (2 * hf + ni) * 32 + 8 * q + 4 * (le >> 5);
            const f32x4 hn = hv[ni][q] + a;
            *(f32x4*)(h + (size_t)row * D + col) = hn;
            *(uint2*)(hb + blkfast(tm, 32, tn * 8 + wn * 4 + 2 * hf + ni, (wm * 64 + mi * 32 + (le & 31)) * 32 + 8 * q + 4 * (le >> 5))) = pack4(hn);
            ss += hn[0] * hn[0] + hn[1] * hn[1] + hn[2] * hn[2] + hn[3] * hn[3];
          }
        ss += __shfl_xor(ss, 32);
        if (lane < 32) *ssq_slot(p, si_next, tn * 4 + wn * 2 + hf, row) = ss;
        asm volatile("" ::: "memory");
        }
      }
    } else for (int v = sk_first(); v < 64; v += gridDim.x) {
      {
      const int c0 = v * 16;
      auto xa = [&](int m, int kc) { return A + (((size_t)128 * (K >> 5) + (kc >> 2)) * 128 + m) * 32 + (kc & 3) * 8; };
      auto wa = [&](int n, int kc) { return wblk(Wt, K >> 5, c0 + n, kc); };
      const f32x4 a = skinny_acc(xa, wa, K >> 5, lds, tid);
      if (wave == 0) {
        const int row = lane & 15;
        float ss = 0.f;
        resid_store(h, hb, row, c0 + 4 * (lane >> 4), a, ss);
        ss += __shfl_xor(ss, 16); ss += __shfl_xor(ss, 32);
        if (lane < 16) *ssk_slot(p, si_next, c0 >> 4, row) = ss;
      }
      }
    }
  }
}

template <int SEL>
__device__ __forceinline__ void win_store(const Params& p, int row, int col, f32x4 a, float rs) {
  a *= rs;
  if (SEL == 0) { a *= 0.125f; *(uint2*)((bf16_t*)(p.ws + OFF_Q) + (size_t)row * D + col) = pack4(a); }
  else if (SEL == 1) { *(uint2*)((bf16_t*)(p.ws + OFF_K) + (size_t)row * 256 + (col - 1024)) = pack4(a); }
  else if (SEL == 2) {
    bf16_t* vt = (bf16_t*)(p.ws + OFF_VT) + (size_t)(col - 1280) * LV + row + 48;
    const uint2 w = pack4(a);
    vt[0] = (bf16_t)(w.x & 0xffffu); vt[LV] = (bf16_t)(w.x >> 16); vt[2 * LV] = (bf16_t)(w.y & 0xffffu); vt[3 * LV] = (bf16_t)(w.y >> 16);
  } else if (SEL == 3) {
    const int cc = col - 1536, g = cc >> 4, c = cc & 15;
    *(uint2*)((bf16_t*)(p.ws + OFF_UG) + ((size_t)g * LU + row + 48) * 16 + c) = pack4(a);
  } else {
    const f32x4 s = a;
    bf16_t* dst = (bf16_t*)(p.ws + (SEL == 4 ? OFF_GS : OFF_GA)) + (size_t)row * D + (col - (SEL == 4 ? 2048 : 3072));
    *(uint2*)dst = pack4(s);
  }
}
template <int SEL>
__device__ __forceinline__ void win_epi(const Params& p, const f32x16 (&acc)[2][4], const float* rsl, int m0, int tn, int tid) {
  const int lane = tid & 63, wave = tid >> 6, wm = wave >> 1, wn = wave & 1; int le = lane; LAUNDER_LANE();
#pragma unroll
  for (int mi = 0; mi < 2; ++mi) {
    const int row = m0 + wm * 64 + mi * 32 + (le & 31);
    const float rs = rsl[wm * 64 + mi * 32 + (le & 31)];
#pragma unroll
    for (int ni = 0; ni < 4; ++ni)
#pragma unroll
      for (int q = 0; q < 4; ++q) {
        f32x4 a; a[0] = acc[mi][ni][4 * q]; a[1] = acc[mi][ni][4 * q + 1]; a[2] = acc[mi][ni][4 * q + 2]; a[3] = acc[mi][ni][4 * q + 3];
        win_store<SEL>(p, row, tn * 256 + wn * 128 + ni * 32 + 8 * q + 4 * (le >> 5), a, rs);
      }
  }
}
__device__ __forceinline__ int win_sel(int col) { return col < 1024 ? 0 : col < 1280 ? 1 : col < 1536 ? 2 : col < 2048 ? 3 : col < 3072 ? 4 : 5; }
__device__ __forceinline__ void phase_win(const Params& p, int si, char* lds, int tid) {
  const bf16_t* hb = (const bf16_t*)(p.ws + OFF_HB); const bf16_t* Wt = (const bf16_t*)(p.ws + OFF_W + W_IN);
  const int lane = tid & 63, wave = tid >> 6, wm = wave >> 1, wn = wave & 1, lrow = tid >> 2, lch = tid & 3; int le = lane;
  constexpr int nN = 16;
  const int nit = tile_iters(nN);
  for (int it = 0; it < nit + 1; ++it) {
    if (it < nit) {
      int tm, tn; if (!tile_of(it, nN, tm, tn)) continue;
      const int m0 = 16 + tm * 128;
      f32x16 acc[2][4]; zero_acc(acc);
      int tl = tid; asm volatile("" : "+v"(tl));
      const int lrow = tl >> 2, lch = (tl & 3) ^ ((tl >> 4) & 3);
      float* rsl = (float*)(lds + 3 * GSTAGE) + (it & 1) * 128;
      if (tid < 128) rsl[tid] = row_rstd(p, si, m0 + tid);
      gemm_acc(acc, hb + ((size_t)tm * 32 * 128 + lrow) * 32 + lch * 8, 32, 4096, Wt + ((size_t)tn * 32 * 256 + lrow) * 32 + lch * 8, 32, 8192, 32, lds, tid);
      LAUNDER_LANE();
      switch (win_sel(tn * 256)) {
        case 0: win_epi<0>(p, acc, rsl, m0, tn, tid); break;
        case 1: win_epi<1>(p, acc, rsl, m0, tn, tid); break;
        case 2: win_epi<2>(p, acc, rsl, m0, tn, tid); break;
        case 3: win_epi<3>(p, acc, rsl, m0, tn, tid); break;
        case 4: win_epi<4>(p, acc, rsl, m0, tn, tid); break;
        default: win_epi<5>(p, acc, rsl, m0, tn, tid); break;
      }
    } else for (int v = sk_first(); v < 256; v += gridDim.x) {
      {
      const int c0 = v * 16;
      auto xa = [&](int m, int kc) { return hb + (((size_t)128 * 32 + (kc >> 2)) * 128 + m) * 32 + (kc & 3) * 8; };
      auto wa = [&](int n, int kc) { return wblk(Wt, 32, c0 + n, kc); };
      const f32x4 a = skinny_acc(xa, wa, 32, lds, tid);
      if (wave == 0) {
        const int row = lane & 15;
        const float rs = row_rstd(p, si, row);
        const int cc = c0 + 4 * (lane >> 4);
        switch (win_sel(c0)) {
          case 0: win_store<0>(p, row, cc, a, rs); break;
          case 1: win_store<1>(p, row, cc, a, rs); break;
          case 2: win_store<2>(p, row, cc, a, rs); break;
          case 3: win_store<3>(p, row, cc, a, rs); break;
          case 4: win_store<4>(p, row, cc, a, rs); break;
          default: win_store<5>(p, row, cc, a, rs); break;
        }
      }
      }
    }
  }
}

__device__ __forceinline__ void attn_unit(const Params& p, int l, int b, int h, char* lds, int tid) {
  const bf16_t* Q = (const bf16_t*)(p.ws + OFF_Q); const bf16_t* Kb = (const bf16_t*)(p.ws + OFF_K); const bf16_t* VT = (const bf16_t*)(p.ws + OFF_VT);
  bf16_t* YA = (bf16_t*)(p.ws + OFF_YA);
  const int lane = tid & 63, wave = tid >> 6, r31 = lane & 31, hh = lane >> 5;
  const int kv = h >> 2;
  const float slope = exp2f(-0.5f * (float)(h + 1));
  const float sinkv = p.sink[l * 16 + h];
  const int q0 = b * 128 + wave * 32;
  const int qx = q0 + r31;
  const bool wactive = (b >= 0) || (wave == 3);
  int qseq = qx + 16; const bool qvalid = qseq >= 0; if (qseq < 0) qseq = 0;
  bf16x8 qf[4];
#pragma unroll
  for (int kk = 0; kk < 4; ++kk) qf[kk] = *(const bf16x8*)(Q + (size_t)qseq * D + h * 64 + kk * 16 + 8 * hh);
  f32x16 o[2];
#pragma unroll
  for (int r = 0; r < 16; ++r) { o[0][r] = 0.f; o[1][r] = 0.f; }
  float m = sinkv, lsum = hh == 0 ? 1.f : 0.f;
  const int swz = (r31 >> 1) & 7;
  for (int st = 0; st < 4; ++st) {
    const int kb = b - 2 + st;
    if (st != 0 && (kb < 0 || kb >= 128)) continue;
    const int kseq0 = st == 0 ? 0 : kb * 128 + 16;
    __syncthreads();
    {
      const int nrow = st == 0 ? 32 : 128;
#pragma unroll
      for (int i = 0; i < 4; ++i) {
        const int row = (tid >> 3) + 32 * i;
        if (row < nrow) *(uint4*)(lds + lds_off(row, tid & 7)) = *(const uint4*)(Kb + (size_t)(kseq0 + row) * 256 + kv * 64 + (tid & 7) * 8);
      }
      const int nkc = st == 0 ? 4 : 16;
#pragma unroll
      for (int i = 0; i < 4; ++i) {
        const int d = (tid >> 4) + 16 * i, kc = tid & 15;
        if (kc < nkc) {
          const uint4 v = *(const uint4*)(VT + (size_t)(kv * 64 + d) * LV + kseq0 + 48 + kc * 8);
          char* dst = lds + 16384 + d * 264 + kc * 16;
          *(uint2*)dst = make_uint2(v.x, v.y); *(uint2*)(dst + 8) = make_uint2(v.z, v.w);
        }
      }
    }
    __syncthreads();
    if (!wactive) continue;
    const int nj = st == 0 ? 1 : 4;
    for (int j = 0; j < nj; ++j) {
      const int kx0 = st == 0 ? 0 : kb * 128 + 32 * j;
      if (st != 0 && (kx0 + 31 < q0 - 128 || kx0 > q0 + 31 + 128)) continue;
      f32x16 s;
#pragma unroll
      for (int r = 0; r < 16; ++r) s[r] = 0.f;
#pragma unroll
      for (int kk = 0; kk < 4; ++kk) {
        const bf16x8 a = *(const bf16x8*)(lds + (32 * j + r31) * 128 + (((kk * 2 + hh) ^ swz) << 4));
        s = __builtin_amdgcn_mfma_f32_32x32x16_bf16(a, qf[kk], s, 0, 0, 0);
      }
      float tmax = -1e30f;
#pragma unroll
      for (int r = 0; r < 16; ++r) {
        const int key = 8 * (r >> 2) + 4 * hh + (r & 3);
        float sv; bool valid;
        if (st == 0) { valid = key < 16; sv = s[r]; }
        else { int dist = qx - (kx0 + key); dist = dist < 0 ? -dist : dist; valid = dist <= 128; sv = s[r] - slope * (float)dist; }
        sv = valid ? sv : -1e30f;
        s[r] = sv; tmax = fmaxf(tmax, sv);
      }
      tmax = fmaxf(tmax, __shfl_xor(tmax, 32));
      const float mnew = fmaxf(m, tmax);
      const float alpha = __expf(m - mnew);
      m = mnew;
      float psum = 0.f;
#pragma unroll
      for (int r = 0; r < 16; ++r) { s[r] = __expf(s[r] - mnew); psum += s[r]; }
      lsum = lsum * alpha + psum;
#pragma unroll
      for (int r = 0; r < 16; ++r) { o[0][r] *= alpha; o[1][r] *= alpha; }
      bf16x8 pf[2];
#pragma unroll
      for (int s2 = 0; s2 < 2; ++s2) {
        unsigned w0 = cvt_pk_bf16(s[8 * s2 + 0], s[8 * s2 + 1]), w1 = cvt_pk_bf16(s[8 * s2 + 2], s[8 * s2 + 3]);
        unsigned w2 = cvt_pk_bf16(s[8 * s2 + 4], s[8 * s2 + 5]), w3 = cvt_pk_bf16(s[8 * s2 + 6], s[8 * s2 + 7]);
        uint4 t = make_uint4(w0, w1, w2, w3);
        pf[s2] = *(bf16x8*)&t;
      }
#pragma unroll
      for (int s2 = 0; s2 < 2; ++s2)
#pragma unroll
        for (int di = 0; di < 2; ++di) {
          const char* vrow = lds + 16384 + (32 * di + r31) * 264 + (32 * j + 16 * s2 + 4 * hh) * 2;
          const uint2 lo = *(const uint2*)vrow, hi = *(const uint2*)(vrow + 16);
          uint4 t = make_uint4(lo.x, lo.y, hi.x, hi.y);
          o[di] = __builtin_amdgcn_mfma_f32_32x32x16_bf16(*(bf16x8*)&t, pf[s2], o[di], 0, 0, 0);
        }
    }
  }
  if (wactive) {
    const float lt = lsum + __shfl_xor(lsum, 32);
    const float inv = 1.0f / lt;
    if (qvalid) {
#pragma unroll
      for (int di = 0; di < 2; ++di)
#pragma unroll
        for (int q = 0; q < 4; ++q) {
          f32x4 a; a[0] = o[di][4 * q] * inv; a[1] = o[di][4 * q + 1] * inv; a[2] = o[di][4 * q + 2] * inv; a[3] = o[di][4 * q + 3] * inv;
          *(uint2*)(YA + blkidx(qseq, h * 64 + 32 * di + 8 * q + 4 * hh, 32)) = pack4(a);
        }
    }
  }
}

__device__ __forceinline__ void phase_attn_xend(const Params& p, int l, char* lds, int tid) {
  const bf16_t* ug = (const bf16_t*)(p.ws + OFF_UG); const bf16_t* Wend = (const bf16_t*)(p.ws + OFF_WEND); float* Xend = (float*)(p.ws + OFF_XEND);
  const int lane = tid & 63, wave = tid >> 6, wm = wave >> 1, wn = wave & 1, lrow = tid >> 2, lch = tid & 3; int le = lane;
  constexpr int NATT = 2048 + 16, NXM = 64, NXS = 512;
  unsigned* ctr = (unsigned*)(p.ws + OFF_BAR) + 2304 + 64 * l;
  if (tid == 0) s_unit = (int)__hip_atomic_fetch_add(ctr, 1u, __ATOMIC_RELAXED, __HIP_MEMORY_SCOPE_AGENT);
  __syncthreads();
  int uq = s_unit;
  __syncthreads();
  while (uq < NATT + NXM + NXS) {
    if (tid == 0) s_unit = (int)__hip_atomic_fetch_add(ctr, 1u, __ATOMIC_RELAXED, __HIP_MEMORY_SCOPE_AGENT);
    const int u = uq < NXM ? NATT + uq : (uq < NXM + NATT ? uq - NXM : uq);
    if (u < NATT) {
      if (u < 2048) attn_unit(p, l, u >> 4, u & 15, lds, tid); else attn_unit(p, l, -1, u - 2048, lds, tid);
    } else if (u < NATT + NXM) {
      const int v = u - NATT, g = v >> 1, tm = v & 1;
      const int k0 = 1 + tm * 128;
      f32x16 acc[2][4]; zero_acc(acc);
      int tl = tid; asm volatile("" : "+v"(tl));
      const int lrow = tl >> 2, lch = (tl & 3) ^ ((tl >> 4) & 3);
      gemm_acc(acc, ug + ((size_t)g * LU + (size_t)(k0 + lrow) * 64) * 16 + lch * 8, 1024, 32,
               Wend + ((size_t)g * 256 + lrow) * 1024 + lch * 8, 1024, 32, 32, lds, tid);
      LAUNDER_LANE();
#pragma unroll
      for (int mi = 0; mi < 2; ++mi) {
        const int k = k0 + wm * 64 + mi * 32 + (le & 31);
#pragma unroll
        for (int ni = 0; ni < 4; ++ni)
#pragma unroll
          for (int q = 0; q < 4; ++q) {
            f32x4 a; a[0] = acc[mi][ni][4 * q]; a[1] = acc[mi][ni][4 * q + 1]; a[2] = acc[mi][ni][4 * q + 2]; a[3] = acc[mi][ni][4 * q + 3];
            *(f32x4*)(Xend + ((size_t)g * NCH + k) * 256 + wn * 128 + ni * 32 + 8 * q + 4 * (le >> 5)) = a;
          }
      }
    } else {
      {
      const int v = u - NATT - NXM, g = v >> 4, c0 = (v & 15) * 16;
      auto xa = [&](int m, int kc) { return ug + (size_t)g * LU * 16 + kc * 8; };
      auto wa = [&](int n, int kc) { return Wend + ((size_t)g * 256 + c0 + n) * 1024 + kc * 8; };
      const f32x4 a = skinny_acc(xa, wa, 32, lds, tid);
      if (wave == 0 && (lane & 15) == 0) *(f32x4*)(Xend + ((size_t)g * NCH + 0) * 256 + c0 + 4 * (lane >> 4)) = a;
      }
    }
    __syncthreads();
    uq = s_unit;
    __syncthreads();
  }
}

__device__ __forceinline__ void phase_scan(const Params& p, int l, int tid) {
  const float* Xend = (const float*)(p.ws + OFF_XEND); bf16_t* Xin = (bf16_t*)(p.ws + OFF_XIN);
  const float2* LP = (const float2*)(p.ws + OFF_LP) + (size_t)l * 2 * NG * NP * 65;
  const int gt = blockIdx.x * 256 + tid;
  if (gt >= 2 * NG * NP) return;
  const int pp = gt & 63, g = (gt >> 6) & 31, dr = gt >> 11;
  const float2 lam = LP[((size_t)(dr * NG + g) * NP + pp) * 65 + 64];
  const float* xe = Xend + (size_t)g * NCH * 256 + dr * 128 + pp;
  bf16_t* xi = Xin + (size_t)g * NCH * 256 + dr * 128 + pp;
  float xr = 0.f, xim = 0.f;
  for (int i0 = 0; i0 < NCH; i0 += 16) {
    float er[16], ei[16];
#pragma unroll
    for (int j = 0; j < 16; ++j) { const int i = i0 + j; const int ic = i < NCH ? i : NCH - 1; const int k = dr ? (NCH - 1 - ic) : ic; er[j] = xe[(size_t)k * 256]; ei[j] = xe[(size_t)k * 256 + 64]; }
#pragma unroll
    for (int j = 0; j < 16; ++j) {
      const int i = i0 + j; const int k = dr ? (NCH - 1 - i) : i;
      if (i < NCH) {
        xi[(size_t)k * 256] = (bf16_t)(cvt_pk_bf16(xr, 0.f) & 0xffffu); xi[(size_t)k * 256 + 64] = (bf16_t)(cvt_pk_bf16(xim, 0.f) & 0xffffu);
        const float nr = lam.x * xr - lam.y * xim + er[j], ni = lam.x * xim + lam.y * xr + ei[j];
        xr = nr; xim = ni;
      }
    }
  }
}

__device__ __forceinline__ uint2 ssm_load_u(const Params& p, int g, int k, int n) {
  const int t = n >> 4, c = n & 15;
  return *(const uint2*)((const bf16_t*)(p.ws + OFF_UG) + ((size_t)g * LU + 64 * k + t) * 16 + c);
}
__device__ __forceinline__ void ssm_store(const Params& p, int l, int g, int k, int n, f32x4 a, uint2 uw) {
  const int t = n >> 4, c = n & 15;
  const int pos = 64 * k + t, seq = pos - 48;
  if (seq < 0) return;
  const f32x4 dv = *(const f32x4*)(p.ssm_d + l * 512 + g * 16 + c);
  f32x4 y;
  y[0] = a[0] + dv[0] * __uint_as_float(uw.x << 16); y[1] = a[1] + dv[1] * __uint_as_float(uw.x & 0xffff0000u);
  y[2] = a[2] + dv[2] * __uint_as_float(uw.y << 16); y[3] = a[3] + dv[3] * __uint_as_float(uw.y & 0xffff0000u);
  y[0] = gelu_tanh(y[0]); y[1] = gelu_tanh(y[1]); y[2] = gelu_tanh(y[2]); y[3] = gelu_tanh(y[3]);
  *(uint2*)((bf16_t*)(p.ws + OFF_Z) + ((size_t)g * LZ + seq) * 16 + c) = pack4(y);
}
__device__ __forceinline__ void phase_ssm_out(const Params& p, int l, char* lds, int tid) {
  const bf16_t* ug = (const bf16_t*)(p.ws + OFF_UG); const bf16_t* Ktab = (const bf16_t*)(p.ws + OFF_KTAB);
  const bf16_t* Mcar = (const bf16_t*)(p.ws + OFF_MCAR); const bf16_t* Xin = (const bf16_t*)(p.ws + OFF_XIN);
  const int lane = tid & 63, wave = tid >> 6, wm = wave >> 1, wn = wave & 1, lrow = tid >> 2, lch = tid & 3; int le = lane;
  constexpr int NMAIN = 256, NSK = 512;
  for (int u = blockIdx.x; u < NMAIN + NSK; u += gridDim.x) {
    if (u < NMAIN) {
      const int g = u >> 3, tm = u & 1, tn = (u >> 1) & 3;
      const int k0 = 1 + tm * 128, n0 = tn * 256;
      f32x16 acc[2][4]; zero_acc(acc);
      int tl = tid; asm volatile("" : "+v"(tl));
      const int lrow = tl >> 2, lch = (tl & 3) ^ ((tl >> 4) & 3);
      gemm_acc(acc, ug + ((size_t)g * LU + (size_t)(k0 + lrow) * 64) * 16 + lch * 8, 1024, 32,
               Ktab + (size_t)g * 127 * 256 + (size_t)(n0 + lrow) * 16 + (63 - (lch >> 1)) * 256 + (lch & 1) * 8, 16, -512, 32, lds, tid);
      LAUNDER_LANE();
      gemm_acc(acc, Xin + ((size_t)g * NCH + k0 + lrow) * 256 + lch * 8, 256, 32,
               Mcar + ((size_t)g * 1024 + n0 + lrow) * 256 + lch * 8, 256, 32, 8, lds, tid);
      LAUNDER_LANE();
#pragma unroll
      for (int mi = 0; mi < 2; ++mi) {
        const int k = k0 + wm * 64 + mi * 32 + (le & 31);
#pragma unroll
        for (int hf = 0; hf < 2; ++hf) {
        uint2 uw[2][4];
#pragma unroll
        for (int ni = 0; ni < 2; ++ni)
#pragma unroll
          for (int q = 0; q < 4; ++q) uw[ni][q] = ssm_load_u(p, g, k, n0 + wn * 128 + (2 * hf + ni) * 32 + 8 * q + 4 * (le >> 5));
#pragma unroll
        for (int ni = 0; ni < 2; ++ni)
#pragma unroll
          for (int q = 0; q < 4; ++q) {
            f32x4 a; a[0] = acc[mi][2 * hf + ni][4 * q]; a[1] = acc[mi][2 * hf + ni][4 * q + 1]; a[2] = acc[mi][2 * hf + ni][4 * q + 2]; a[3] = acc[mi][2 * hf + ni][4 * q + 3];
            ssm_store(p, l, g, k, n0 + wn * 128 + (2 * hf + ni) * 32 + 8 * q + 4 * (le >> 5), a, uw[ni][q]);
          }
        asm volatile("" ::: "memory");
        }
      }
    } else {
      {
      const int v = u - NMAIN, g = v >> 4, c0 = 768 + (v & 15) * 16;
      auto xa = [&](int m, int kc) { return kc < 128 ? ug + (size_t)g * LU * 16 + kc * 8 : Xin + (size_t)g * NCH * 256 + (kc - 128) * 8; };
      auto wa = [&](int n, int kc) {
        const int nn = c0 + n;
        return kc < 128 ? Ktab + (size_t)g * 127 * 256 + ((nn >> 4) + 63 - (kc >> 1)) * 256 + (nn & 15) * 16 + (kc & 1) * 8
                        : Mcar + ((size_t)g * 1024 + nn) * 256 + (kc - 128) * 8; };
      const f32x4 a = skinny_acc(xa, wa, 40, lds, tid);
      if (wave == 0 && (lane & 15) == 0) ssm_store(p, l, g, 0, c0 + 4 * (lane >> 4), a, ssm_load_u(p, g, 0, c0 + 4 * (lane >> 4)));
      }
    }
  }
}

__device__ __forceinline__ void phase_glu(const Params& p, char* lds, int tid) {
  const bf16_t* Z = (const bf16_t*)(p.ws + OFF_Z); const bf16_t* Wt = (const bf16_t*)(p.ws + OFF_W + W_GLU); bf16_t* YS = (bf16_t*)(p.ws + OFF_YS);
  const int lane = tid & 63, wave = tid >> 6, wm = wave >> 1, wn = wave & 1, lrow = tid >> 2, lch = tid & 3; int le = lane;
  constexpr int nN = 2;
  auto loadz = [&](int row, int col) { return *(const uint2*)(Z + ((size_t)(col >> 4) * LZ + row) * 16 + (col & 15)); };
  auto store = [&](int row, int col, f32x4 a, uint2 zw) {
    f32x4 o;
    o[0] = __uint_as_float(zw.x << 16) * sigmoidf_(a[0]); o[1] = __uint_as_float(zw.x & 0xffff0000u) * sigmoidf_(a[1]);
    o[2] = __uint_as_float(zw.y << 16) * sigmoidf_(a[2]); o[3] = __uint_as_float(zw.y & 0xffff0000u) * sigmoidf_(a[3]);
    *(uint2*)(YS + blkidx(row, col, 16)) = pack4(o);
  };
  const int nit = tile_iters(nN);
  for (int it = 0; it < nit + 1; ++it) {
    if (it < nit) {
      int tm, tn; if (!tile_of(it, nN, tm, tn)) continue;
      const int m0 = 16 + tm * 128;
      f32x16 acc[2][4]; zero_acc(acc);
      int tl = tid; asm volatile("" : "+v"(tl));
      const int lrow = tl >> 2, lch = (tl & 3) ^ ((tl >> 4) & 3);
      gemm_acc(acc, Z + ((size_t)(lch >> 1) * LZ + m0 + lrow) * 16 + (lch & 1) * 8, 16, 2 * LZ * 16, Wt + ((size_t)tn * 16 * 256 + lrow) * 32 + lch * 8, 32, 8192, 16, lds, tid);
      LAUNDER_LANE();
#pragma unroll
      for (int mi = 0; mi < 2; ++mi) {
        const int row = m0 + wm * 64 + mi * 32 + (le & 31);
#pragma unroll
        for (int hf = 0; hf < 2; ++hf) {
        uint2 zw[2][4];
#pragma unroll
        for (int ni = 0; ni < 2; ++ni)
#pragma unroll
          for (int q = 0; q < 4; ++q) zw[ni][q] = loadz(row, tn * 256 + wn * 128 + (2 * hf + ni) * 32 + 8 * q + 4 * (le >> 5));
#pragma unroll
        for (int ni = 0; ni < 2; ++ni)
#pragma unroll
          for (int q = 0; q < 4; ++q) {
            f32x4 a; a[0] = acc[mi][2 * hf + ni][4 * q]; a[1] = acc[mi][2 * hf + ni][4 * q + 1]; a[2] = acc[mi][2 * hf + ni][4 * q + 2]; a[3] = acc[mi][2 * hf + ni][4 * q + 3];
            store(row, tn * 256 + wn * 128 + (2 * hf + ni) * 32 + 8 * q + 4 * (le >> 5), a, zw[ni][q]);
          }
        asm volatile("" ::: "memory");
        }
      }
    } else for (int v = sk_first(); v < 32; v += gridDim.x) {
      {
      const int c0 = v * 16;
      auto xa = [&](int m, int kc) { return Z + ((size_t)(kc >> 1) * LZ + m) * 16 + (kc & 1) * 8; };
      auto wa = [&](int n, int kc) { return wblk(Wt, 16, c0 + n, kc); };
      const f32x4 a = skinny_acc(xa, wa, 16, lds, tid);
      if (wave == 0) store(lane & 15, c0 + 4 * (lane >> 4), a, loadz(lane & 15, c0 + 4 * (lane >> 4)));
      }
    }
  }
}

__device__ __forceinline__ f32x4 un4bf(uint2 w) {
  f32x4 r; r[0] = __uint_as_float(w.x << 16); r[1] = __uint_as_float(w.x & 0xffff0000u); r[2] = __uint_as_float(w.y << 16); r[3] = __uint_as_float(w.y & 0xffff0000u); return r;
}
__device__ __forceinline__ f32x4 ld4bf(const bf16_t* ptr) {
  const uint2 w = *(const uint2*)ptr; f32x4 r;
  r[0] = __uint_as_float(w.x << 16); r[1] = __uint_as_float(w.x & 0xffff0000u); r[2] = __uint_as_float(w.y << 16); r[3] = __uint_as_float(w.y & 0xffff0000u); return r;
}
__device__ __forceinline__ void phase_merge(const Params& p, char* lds, int tid) {
  const bf16_t* YS = (const bf16_t*)(p.ws + OFF_YS); const bf16_t* YA = (const bf16_t*)(p.ws + OFF_YA);
  const bf16_t* GS = (const bf16_t*)(p.ws + OFF_GS); const bf16_t* GA = (const bf16_t*)(p.ws + OFF_GA);
  const bf16_t* Wbs = (const bf16_t*)(p.ws + OFF_W + W_BS); const bf16_t* Wba = (const bf16_t*)(p.ws + OFF_W + W_BA);
  bf16_t* MG = (bf16_t*)(p.ws + OFF_Q);
  const int lane = tid & 63, wave = tid >> 6, wm = wave >> 1, wn = wave & 1, lrow = tid >> 2, lch = tid & 3; int le = lane;
  constexpr int nN = 4;
  const int nit = tile_iters(nN);
  for (int it = 0; it < nit + 1; ++it) {
    if (it < nit) {
      int tm, tn; if (!tile_of(it, nN, tm, tn)) continue;
      const int m0 = 16 + tm * 128;
      f32x16 acc[2][4]; zero_acc(acc);
      int tl = tid; asm volatile("" : "+v"(tl));
      const int lrow = tl >> 2, lch = (tl & 3) ^ ((tl >> 4) & 3);
      gemm_acc(acc, YS + ((size_t)tm * 16 * 128 + lrow) * 32 + lch * 8, 32, 4096, Wbs + ((size_t)tn * 16 * 256 + lrow) * 32 + lch * 8, 32, 8192, 16, lds, tid);
      LAUNDER_LANE();
#pragma unroll
      for (int mi = 0; mi < 2; ++mi) {
        const int row = m0 + wm * 64 + mi * 32 + (le & 31);
#pragma unroll
        for (int hf = 0; hf < 2; ++hf) {
        uint2 gw[2][4];
#pragma unroll
        for (int ni = 0; ni < 2; ++ni)
#pragma unroll
          for (int q = 0; q < 4; ++q) gw[ni][q] = *(const uint2*)(GS + (size_t)row * D + tn * 256 + wn * 128 + (2 * hf + ni) * 32 + 8 * q + 4 * (le >> 5));
#pragma unroll
        for (int ni = 0; ni < 2; ++ni)
#pragma unroll
          for (int q = 0; q < 4; ++q) {
            f32x4 gsv = un4bf(gw[ni][q]);
            gsv[0] = sigmoidf_(gsv[0]); gsv[1] = sigmoidf_(gsv[1]); gsv[2] = sigmoidf_(gsv[2]); gsv[3] = sigmoidf_(gsv[3]);
            f32x4 t;
#pragma unroll
            for (int j = 0; j < 4; ++j) t[j] = acc[mi][2 * hf + ni][4 * q + j] * gsv[j];
            *(uint2*)(MG + blkfast(tm, 32, tn * 8 + wn * 4 + 2 * hf + ni, (wm * 64 + mi * 32 + (le & 31)) * 32 + 8 * q + 4 * (le >> 5))) = pack4(t);
          }
        asm volatile("" ::: "memory");
        }
      }
      zero_acc(acc);
      gemm_acc(acc, YA + ((size_t)tm * 32 * 128 + lrow) * 32 + lch * 8, 32, 4096, Wba + ((size_t)tn * 32 * 256 + lrow) * 32 + lch * 8, 32, 8192, 32, lds, tid);
      LAUNDER_LANE();
#pragma unroll
      for (int mi = 0; mi < 2; ++mi) {
        const int row = m0 + wm * 64 + mi * 32 + (le & 31);
#pragma unroll
        for (int hf = 0; hf < 2; ++hf) {
        uint2 gw[2][4], pw[2][4];
#pragma unroll
        for (int ni = 0; ni < 2; ++ni)
#pragma unroll
          for (int q = 0; q < 4; ++q) {
            gw[ni][q] = *(const uint2*)(GA + (size_t)row * D + tn * 256 + wn * 128 + (2 * hf + ni) * 32 + 8 * q + 4 * (le >> 5));
            pw[ni][q] = *(const uint2*)(MG + blkfast(tm, 32, tn * 8 + wn * 4 + 2 * hf + ni, (wm * 64 + mi * 32 + (le & 31)) * 32 + 8 * q + 4 * (le >> 5)));
          }
#pragma unroll
        for (int ni = 0; ni < 2; ++ni)
#pragma unroll
          for (int q = 0; q < 4; ++q) {
            const int col = tn * 256 + wn * 128 + (2 * hf + ni) * 32 + 8 * q + 4 * (le >> 5);
            f32x4 gav = un4bf(gw[ni][q]);
            gav[0] = sigmoidf_(gav[0]); gav[1] = sigmoidf_(gav[1]); gav[2] = sigmoidf_(gav[2]); gav[3] = sigmoidf_(gav[3]);
            const uint2 pk = pw[ni][q];
            f32x4 o;
            o[0] = __uint_as_float(pk.x << 16) + gav[0] * acc[mi][2 * hf + ni][4 * q + 0];
            o[1] = __uint_as_float(pk.x & 0xffff0000u) + gav[1] * acc[mi][2 * hf + ni][4 * q + 1];
            o[2] = __uint_as_float(pk.y << 16) + gav[2] * acc[mi][2 * hf + ni][4 * q + 2];
            o[3] = __uint_as_float(pk.y & 0xffff0000u) + gav[3] * acc[mi][2 * hf + ni][4 * q + 3];
            *(uint2*)(MG + blkfast(tm, 32, tn * 8 + wn * 4 + 2 * hf + ni, (wm * 64 + mi * 32 + (le & 31)) * 32 + 8 * q + 4 * (le >> 5))) = pack4(o);
          }
        asm volatile("" ::: "memory");
        }
      }
    } else for (int v = sk_first(); v < 64; v += gridDim.x) {
      {
      const int c0 = v * 16;
      auto xs = [&](int m, int kc) { return YS + (((size_t)128 * 16 + (kc >> 2)) * 128 + m) * 32 + (kc & 3) * 8; };
      auto ws_ = [&](int n, int kc) { return wblk(Wbs, 16, c0 + n, kc); };
      auto xa = [&](int m, int kc) { return YA + (((size_t)128 * 32 + (kc >> 2)) * 128 + m) * 32 + (kc & 3) * 8; };
      auto wa = [&](int n, int kc) { return wblk(Wba, 32, c0 + n, kc); };
      const f32x4 a1 = skinny_acc(xs, ws_, 16, lds, tid);
      const f32x4 a2 = skinny_acc(xa, wa, 32, lds, tid);
      if (wave == 0) {
        const int row = lane & 15, col = c0 + 4 * (lane >> 4);
        f32x4 gsv = ld4bf(GS + (size_t)row * D + col), gav = ld4bf(GA + (size_t)row * D + col);
#pragma unroll
        for (int j = 0; j < 4; ++j) { gsv[j] = sigmoidf_(gsv[j]); gav[j] = sigmoidf_(gav[j]); }
        f32x4 o;
#pragma unroll
        for (int j = 0; j < 4; ++j) o[j] = gsv[j] * a1[j] + gav[j] * a2[j];
        *(uint2*)(MG + blkidx(row, col, 32)) = pack4(o);
      }
      }
    }
  }
}

__device__ __forceinline__ void phase_final(const Params& p, int tid) {
  const float* h = (const float*)(p.ws + OFF_H);
  const int lane = tid & 63, wave = tid >> 6;
  for (int r = blockIdx.x * 4 + wave; r < NX; r += gridDim.x * 4) {
    const float rs = row_rstd(p, 12, r + 16);
#pragma unroll
    for (int i = 0; i < 4; ++i) {
      const int c = i * 256 + lane * 4;
      f32x4 v = *(const f32x4*)(h + (size_t)(r + 16) * D + c);
      const f32x4 g = *(const f32x4*)(p.final_norm + c);
      v = v * rs * g;
      *(f32x4*)(p.out + (size_t)r * D + c) = v;
    }
  }
}

#define XB_XCNT(j) (64 * (j))
#define XB_XSUB(j) (1024 + 64 * (j))
#define XB_TOP 2048
#define XB_PLAIN 2112
#define XB_WORDS 2176
struct GridBar { unsigned* bar; unsigned xcc, nloc, nx, gen; };
__device__ __forceinline__ unsigned xb_ld(unsigned* q) { return __hip_atomic_load(q, __ATOMIC_RELAXED, __HIP_MEMORY_SCOPE_AGENT); }
__device__ __forceinline__ void grid_bar_setup(GridBar& gb, unsigned* bar, int tid) {
  gb.bar = bar; gb.gen = 0; gb.nloc = 1; gb.nx = 1;
  gb.xcc = (unsigned)__builtin_amdgcn_s_getreg((3 << 11) | 20) & 0xFu;
  if (tid == 0) {
    const unsigned rank = __hip_atomic_fetch_add(&bar[XB_XCNT(gb.xcc)], 1u, __ATOMIC_RELAXED, __HIP_MEMORY_SCOPE_AGENT);
    __hip_atomic_fetch_add(&bar[XB_PLAIN], 1u, __ATOMIC_RELAXED, __HIP_MEMORY_SCOPE_AGENT);
    while (xb_ld(&bar[XB_PLAIN]) < gridDim.x) __builtin_amdgcn_s_sleep(2);
    unsigned nx = 0; bool even = (gridDim.x & 7u) == 0u;
    for (int j = 0; j < 16; ++j) { const unsigned c = xb_ld(&bar[XB_XCNT(j)]); nx += c != 0u; if (j < 8 ? c != (gridDim.x >> 3) : c != 0u) even = false; }
    s_nx = nx; s_nloc = xb_ld(&bar[XB_XCNT(gb.xcc)]);
    s_vb = even ? (int)(rank * 8u + gb.xcc) : (int)blockIdx.x;
  }
  __syncthreads();
}
__device__ __forceinline__ void grid_bar(GridBar& gb, int tid) {
  asm volatile("s_waitcnt vmcnt(0) lgkmcnt(0)" ::: "memory");
  __syncthreads();
  gb.gen += 1;
  if (tid == 0) {
    const unsigned old = __hip_atomic_fetch_add(&gb.bar[XB_XSUB(gb.xcc)], 1u, __ATOMIC_RELAXED, __HIP_MEMORY_SCOPE_AGENT);
    if (old + 1 == s_nloc * gb.gen) {
      __builtin_amdgcn_fence(__ATOMIC_RELEASE, "agent");
      asm volatile("s_waitcnt vmcnt(0)" ::: "memory");
      __hip_atomic_fetch_add(&gb.bar[XB_TOP], 1u, __ATOMIC_RELAXED, __HIP_MEMORY_SCOPE_AGENT);
    }
    const unsigned target = s_nx * gb.gen;
    while (xb_ld(&gb.bar[XB_TOP]) < target) __builtin_amdgcn_s_sleep(1);
    __builtin_amdgcn_fence(__ATOMIC_ACQUIRE, "agent");
    asm volatile("s_waitcnt vmcnt(0)" ::: "memory");
  }
  __syncthreads();
}

__device__ __forceinline__ int lane_id_now() { int l; asm volatile("v_mbcnt_lo_u32_b32 %0, -1, 0\n\tv_mbcnt_hi_u32_b32 %0, -1, %0" : "=v"(l)); return l; }
__global__ void __launch_bounds__(256, 2) fwd_megakernel(Params p) {
  cg::grid_group grid = cg::this_grid();
  __shared__ __attribute__((aligned(16))) char lds[3 * 24576 + 1024];
  const int wave_s = __builtin_amdgcn_readfirstlane((int)threadIdx.x >> 6);
#define MYTID() (wave_s * 64 + lane_id_now())
    const bf16_t* hb = (const bf16_t*)(p.ws + OFF_HB);
  GridBar gb;
  grid.sync();
  grid_bar_setup(gb, (unsigned*)(p.ws + OFF_BAR), MYTID());
  phase_init(p, MYTID());
  grid_bar(gb, MYTID());
  for (int l = 0; l < 4; ++l) {
#pragma nounroll
    for (int step0 = 0; step0 < 12 + PROBE_EXTRA; ++step0) {
      const int step = step0 < 12 ? step0 : PROBE_STEP;
      if (PROBE_STEP < 0 && step0 >= 12) { grid_bar(gb, MYTID()); continue; }
      int tid = MYTID(); asm volatile("" : "+v"(tid));
      if (step == 0) {}
      else if (step == 1 || step == 10) phase_ffn_up(p, (const bf16_t*)(p.ws + OFF_W + (step == 1 ? W_GU1 : W_GU2)), 3 * l + (step == 1 ? 0 : 2), lds, tid);
      else if (step == 2 || step == 9 || step == 11) {
        const bf16_t* A = (const bf16_t*)(p.ws + (step == 9 ? OFF_Q : OFF_ACT));
        const int K = step == 9 ? D : DFF;
        const bf16_t* Wt = (const bf16_t*)(p.ws + OFF_W + (step == 2 ? W_D1 : (step == 9 ? W_O : W_D2)));
        const int sn = 3 * l + (step == 2 ? 1 : (step == 9 ? 2 : 3));
        phase_resid(p, A, K, Wt, sn, lds, tid);
      }
      else if (step == 3) phase_win(p, 3 * l + 1, lds, tid);
      else if (step == 4) phase_attn_xend(p, l, lds, tid);
      else if (step == 5) phase_scan(p, l, tid);
      else if (step == 6) phase_ssm_out(p, l, lds, tid);
      else if (step == 7) phase_glu(p, lds, tid);
      else phase_merge(p, lds, tid);
      {
        int pl = l, pb = 0, pe = 0, skip = 0;
        if (step == 0) { pb = l == 0 ? 0 : 3136; pe = l == 0 ? 10560 : 5952; }
        else if (step == 5 && l < 3) { pl = l + 1; pb = 0; pe = 3136; skip = 16; }
        else if (step == 7 && l < 3) { pl = l + 1; pb = 5952; pe = 10560; }
        if (pe > pb) phase_prep(p, pl, pb, pe, skip, lds, tid);
      }
      grid_bar(gb, MYTID());
#ifdef DBG_STEPS
      if (l * 12 + step + 1 == DBG_STEPS) {
        const int gt = blockIdx.x * 256 + MYTID();
#if DBG_MODE == 0
        const float* hsrc = (const float*)(p.ws + OFF_H);
        for (int i = gt; i < NX * D; i += gridDim.x * 256) p.out[i] = hsrc[i + 16 * D];
#else
        const bf16_t* bsrc = (const bf16_t*)(p.ws + DBG_BUF);
        for (int i = gt; i < NX * D; i += gridDim.x * 256) p.out[i] = bf2f(bsrc[i % DBG_N]);
#endif
        return;
      }
#endif
    }
  }
  (void)hb;
  phase_final(p, MYTID());
}

extern "C" void kernel_launch(void* const* d_in, const int* in_sizes, int n_in, void* d_out, int out_size, void* d_ws, size_t ws_size,
                              hipStream_t stream) {
  static int grid_blocks = 0;
  if (!grid_blocks) {
    int dev = 0, cus = 0, per_cu = 0;
    (void)hipGetDevice(&dev);
    (void)hipDeviceGetAttribute(&cus, hipDeviceAttributeMultiprocessorCount, dev);
    (void)hipOccupancyMaxActiveBlocksPerMultiprocessor(&per_cu, fwd_megakernel, 256, 0);
    if (per_cu > 2) per_cu = 2;
    if (per_cu < 1) per_cu = 1;
    grid_blocks = cus * per_cu;
  }
  if (ws_size < WS_TOTAL) { fprintf(stderr, "workspace too small: %zu < %zu\n", ws_size, (size_t)WS_TOTAL); return; }
  Params p{};
  const float* const* in = (const float* const*)d_in;
  p.x = in[0]; p.meta = in[1]; p.ffn1_norm = in[2]; p.ffn1_wg = in[3]; p.ffn1_wu = in[4]; p.ffn1_wd = in[5];
  p.mix_norm = in[6]; p.w_in = in[7]; p.lam_re = in[8]; p.lam_im = in[9]; p.log_dt = in[10];
  p.b_re = in[11]; p.b_im = in[12]; p.c_re = in[13]; p.c_im = in[14]; p.ssm_d = in[15]; p.w_glu = in[16];
  p.sink = in[17]; p.w_bs = in[18]; p.w_ba = in[19]; p.w_out = in[20]; p.ffn2_norm = in[21];
  p.ffn2_wg = in[22]; p.ffn2_wu = in[23]; p.ffn2_wd = in[24]; p.final_norm = in[25];
  p.out = (float*)d_out; p.ws = (char*)d_ws;
  void* args[] = {&p};
  (void)hipMemsetAsync((char*)d_ws + OFF_BAR, 0, 16384, stream);
  hipError_t e = hipLaunchCooperativeKernel((void*)fwd_megakernel, dim3(grid_blocks), dim3(256), args, 0, stream);
  if (e != hipSuccess) fprintf(stderr, "cooperative launch failed: %s (grid %d)\n", hipGetErrorString(e), grid_blocks);
}
```

```cpp
#ifndef PROBE_EXTRA
#define PROBE_EXTRA 0
#define PROBE_STEP 0
#endif
#include <hip/hip_runtime.h>
#include <hip/hip_cooperative_groups.h>
#include <cstdio>
#include <cstdint>
namespace cg = cooperative_groups;

typedef unsigned short bf16_t;
typedef short bf16x8 __attribute__((ext_vector_type(8)));
typedef float f32x16 __attribute__((ext_vector_type(16)));
typedef float f32x4 __attribute__((ext_vector_type(4)));

constexpr int L = 16400, NX = 16384, D = 1024, DFF = 2816;
constexpr int NG = 32, NP = 64;
constexpr int NCH = 257, LU = NCH * 64;
constexpr int LV = 16640;
constexpr int PADK = 64;
constexpr int LDH = D + PADK;
constexpr int LS = 16512;
constexpr int LZ = 16400;

constexpr size_t AL(size_t x) { return (x + 255) & ~(size_t)255; }
constexpr size_t OFF_H = 0;
constexpr size_t OFF_HB = OFF_H + AL((size_t)L * D * 4);
constexpr size_t OFF_SSQ = OFF_HB + AL((size_t)L * LDH * 2);
constexpr size_t OFF_SSK = OFF_SSQ + AL((size_t)13 * 16 * LS * 4);
constexpr size_t OFF_ACT = OFF_SSK + AL((size_t)13 * 64 * 16 * 4);
constexpr size_t OFF_Q = OFF_ACT;
constexpr size_t OFF_GS = OFF_Q + AL((size_t)129 * 128 * D * 2);
constexpr size_t OFF_K = OFF_GS + AL((size_t)L * D * 2);
constexpr size_t OFF_VT = OFF_K + AL((size_t)L * 256 * 2);
constexpr size_t OFF_VT_END = OFF_VT + AL((size_t)256 * LV * 2);
constexpr size_t OFF_GA = OFF_ACT + AL((size_t)129 * 128 * DFF * 2);
static_assert(OFF_VT_END <= OFF_GA, "alias overflow");
constexpr size_t OFF_YA = OFF_GA + AL((size_t)L * D * 2);
constexpr size_t OFF_UG = OFF_YA + AL((size_t)129 * 128 * D * 2) + 65536;
constexpr size_t OFF_Z = OFF_UG + AL((size_t)NG * LU * 16 * 2);
constexpr size_t OFF_YS = OFF_Z + AL((size_t)L * 512 * 2);
constexpr size_t OFF_XEND = OFF_YS + AL((size_t)129 * 128 * 512 * 2);
constexpr size_t OFF_XIN = OFF_XEND + AL((size_t)NG * NCH * 256 * 4);
constexpr size_t OFF_W = OFF_XIN + AL((size_t)NG * NCH * 256 * 2);
constexpr size_t W_GU1 = 0;
constexpr size_t W_D1 = W_GU1 + (size_t)2 * DFF * (D + PADK) * 2;
constexpr size_t W_IN = W_D1 + (size_t)D * (DFF + PADK) * 2;
constexpr size_t W_GLU = W_IN + (size_t)4096 * (D + PADK) * 2;
constexpr size_t W_BS = W_GLU + (size_t)512 * (512 + PADK) * 2;
constexpr size_t W_BA = W_BS + (size_t)D * (512 + PADK) * 2;
constexpr size_t W_O = W_BA + (size_t)D * (D + PADK) * 2;
constexpr size_t W_GU2 = W_O + (size_t)D * (D + PADK) * 2;
constexpr size_t W_D2 = W_GU2 + (size_t)2 * DFF * (D + PADK) * 2;
constexpr size_t W_TOTAL = W_D2 + (size_t)D * (DFF + PADK) * 2;
constexpr size_t OFF_KTAB = OFF_W + AL(W_TOTAL);
constexpr size_t OFF_WEND = OFF_KTAB + AL((size_t)NG * 127 * 256 * 2);
constexpr size_t OFF_MCAR = OFF_WEND + AL((size_t)NG * 256 * 1024 * 2);
constexpr size_t OFF_LP = OFF_MCAR + AL((size_t)NG * 1024 * 256 * 2);
constexpr size_t OFF_BB = OFF_LP + AL((size_t)4 * 2 * NG * NP * 65 * 8);
constexpr size_t OFF_BAR = OFF_BB + AL((size_t)4 * 2 * NG * NP * 16 * 8);
constexpr size_t WS_TOTAL = OFF_BAR + 16384;

struct Params {
  const float* x; const float* meta; const float* ffn1_norm; const float* ffn1_wg; const float* ffn1_wu; const float* ffn1_wd;
  const float* mix_norm; const float* w_in; const float* lam_re; const float* lam_im; const float* log_dt;
  const float* b_re; const float* b_im; const float* c_re; const float* c_im; const float* ssm_d; const float* w_glu;
  const float* sink; const float* w_bs; const float* w_ba; const float* w_out; const float* ffn2_norm;
  const float* ffn2_wg; const float* ffn2_wu; const float* ffn2_wd; const float* final_norm;
  float* out; char* ws;
};

#define LAUNDER_LANE() do { le = lane; asm volatile("" : "+v"(le)); } while (0)
__device__ __forceinline__ const bf16_t* wblk(const bf16_t* W, int nkt, int R, int kc) { return W + (((size_t)(R >> 8) * nkt + (kc >> 2)) * 256 + (R & 255)) * 32 + (kc & 3) * 8; }
__device__ __forceinline__ size_t hbidx(int row, int col) {
  const int rr = row - 16; const int tmx = row < 16 ? 128 : (rr >> 7), r = row < 16 ? row : (rr & 127);
  return (((size_t)tmx * 32 + (col >> 5)) * 128 + r) * 32 + (col & 31);
}
__device__ __forceinline__ size_t blkidx(int row, int col, int nkt) {
  const int rr = row - 16; const int tmx = row < 16 ? 128 : (rr >> 7), r = row < 16 ? row : (rr & 127);
  return (((size_t)tmx * nkt + (col >> 5)) * 128 + r) * 32 + (col & 31);
}
__device__ __forceinline__ size_t blkfast(int tm, int nkt, int cb, int rl) { return ((size_t)tm * nkt + cb) * 4096 + rl; }
__device__ __forceinline__ unsigned cvt_pk_bf16(float lo, float hi) { unsigned r; asm volatile("v_cvt_pk_bf16_f32 %0, %1, %2" : "=v"(r) : "v"(lo), "v"(hi)); return r; }
__device__ __forceinline__ float bf2f(bf16_t v) { return __uint_as_float(((unsigned)v) << 16); }
__device__ __forceinline__ float sigmoidf_(float v) { return __builtin_amdgcn_rcpf(1.0f + __expf(-v)); }
__device__ __forceinline__ float gelu_tanh(float x) { const float u = 1.5957691216f * (x + 0.044715f * x * x * x); return x * sigmoidf_(u); }
__device__ __forceinline__ int lds_off(int row, int ch) { return row * 128 + ((ch ^ ((row >> 1) & 7)) << 4); }
__device__ __forceinline__ uint2 pack4(f32x4 v) { uint2 r; r.x = cvt_pk_bf16(v[0], v[1]); r.y = cvt_pk_bf16(v[2], v[3]); return r; }

__device__ __forceinline__ float row_rstd(const Params& p, int si, int row) {
  float s = 0.f;
  if (row >= 16) {
    const float* q = (const float*)(p.ws + OFF_SSQ) + (size_t)si * 16 * LS + row + 16;
#pragma unroll
    for (int i = 0; i < 16; ++i) s += q[(size_t)i * LS];
  } else {
    const float* q = (const float*)(p.ws + OFF_SSK) + (size_t)si * 64 * 16 + row;
    for (int i = 0; i < 64; ++i) s += q[i * 16];
  }
  return rsqrtf(s * (1.f / 1024.f) + 1e-6f);
}
__device__ __forceinline__ float* ssq_slot(const Params& p, int si, int slot, int row) { return (float*)(p.ws + OFF_SSQ) + ((size_t)si * 16 + slot) * LS + row + 16; }
__device__ __forceinline__ float* ssk_slot(const Params& p, int si, int slot, int row) { return (float*)(p.ws + OFF_SSK) + ((size_t)si * 64 + slot) * 16 + row; }

#define GSTAGE 24576
typedef __attribute__((address_space(3))) void* lds_ptr_t;
typedef const __attribute__((address_space(1))) void* glb_ptr_t;
typedef int i32x4 __attribute__((ext_vector_type(4)));
#define GDMA(stagebase) do { char* _d = (stagebase) + tid * 16; \
    __builtin_amdgcn_global_load_lds((glb_ptr_t)(xp), (lds_ptr_t)(_d), 16, 0, 0); \
    __builtin_amdgcn_global_load_lds((glb_ptr_t)(xp + (size_t)64 * xld), (lds_ptr_t)(_d + 4096), 16, 0, 0); \
    __builtin_amdgcn_global_load_lds((glb_ptr_t)(wp), (lds_ptr_t)(_d + 8192), 16, 0, 0); \
    __builtin_amdgcn_global_load_lds((glb_ptr_t)(wp + (size_t)64 * wld), (lds_ptr_t)(_d + 12288), 16, 0, 0); \
    __builtin_amdgcn_global_load_lds((glb_ptr_t)(wp + (size_t)128 * wld), (lds_ptr_t)(_d + 16384), 16, 0, 0); \
    __builtin_amdgcn_global_load_lds((glb_ptr_t)(wp + (size_t)192 * wld), (lds_ptr_t)(_d + 20480), 16, 0, 0); } while (0)
__device__ __forceinline__ void gemm_acc(f32x16 (&acc)[2][4], const bf16_t* xp, int xld, int xks, const bf16_t* wp, int wld, int wks,
                                         int nkt, char* lds, int tid) {
  const int lane = tid & 63, wave = tid >> 6, wm = wave >> 1, wn = wave & 1;
  __syncthreads();
  GDMA(lds);
  if (nkt > 1) { xp += xks; wp += wks; GDMA(lds + GSTAGE); asm volatile("s_waitcnt vmcnt(6)" ::: "memory"); }
  else asm volatile("s_waitcnt vmcnt(0)" ::: "memory");
  __builtin_amdgcn_s_barrier();
  const int r31 = lane & 31, hh = lane >> 5, swz = (r31 >> 2) & 3;
  const unsigned lbase = (unsigned)(size_t)lds;
  const unsigned ax0 = lbase + wm * 4096 + r31 * 64 + (((0 + hh) ^ swz) << 4), ax1 = lbase + wm * 4096 + r31 * 64 + (((2 + hh) ^ swz) << 4);
  const unsigned aw0 = ax0 - wm * 4096 + 8192 + wn * 8192, aw1 = ax1 - wm * 4096 + 8192 + wn * 8192;
#define MMA8(x0, x1, w0, w1, w2, w3) do { \
    const bf16x8 xf0 = __builtin_bit_cast(bf16x8, x0), xf1 = __builtin_bit_cast(bf16x8, x1), wf0 = __builtin_bit_cast(bf16x8, w0), \
                 wf1 = __builtin_bit_cast(bf16x8, w1), wf2 = __builtin_bit_cast(bf16x8, w2), wf3 = __builtin_bit_cast(bf16x8, w3); \
    __builtin_amdgcn_s_setprio(1); \
    acc[0][0] = __builtin_amdgcn_mfma_f32_32x32x16_bf16(wf0, xf0, acc[0][0], 0, 0, 0); \
    acc[0][1] = __builtin_amdgcn_mfma_f32_32x32x16_bf16(wf1, xf0, acc[0][1], 0, 0, 0); \
    acc[0][2] = __builtin_amdgcn_mfma_f32_32x32x16_bf16(wf2, xf0, acc[0][2], 0, 0, 0); \
    acc[0][3] = __builtin_amdgcn_mfma_f32_32x32x16_bf16(wf3, xf0, acc[0][3], 0, 0, 0); \
    acc[1][0] = __builtin_amdgcn_mfma_f32_32x32x16_bf16(wf0, xf1, acc[1][0], 0, 0, 0); \
    acc[1][1] = __builtin_amdgcn_mfma_f32_32x32x16_bf16(wf1, xf1, acc[1][1], 0, 0, 0); \
    acc[1][2] = __builtin_amdgcn_mfma_f32_32x32x16_bf16(wf2, xf1, acc[1][2], 0, 0, 0); \
    acc[1][3] = __builtin_amdgcn_mfma_f32_32x32x16_bf16(wf3, xf1, acc[1][3], 0, 0, 0); \
    __builtin_amdgcn_s_setprio(0); } while (0)
#define KTILE() do { i32x4 x0, x1, w0, w1, w2, w3, y0, y1, v0, v1, v2, v3; \
    asm volatile("ds_read_b128 %0, %12\n\tds_read_b128 %1, %12 offset:2048\n\tds_read_b128 %2, %13\n\tds_read_b128 %3, %13 offset:2048\n\t" \
                 "ds_read_b128 %4, %13 offset:4096\n\tds_read_b128 %5, %13 offset:6144\n\t" \
                 "ds_read_b128 %6, %14\n\tds_read_b128 %7, %14 offset:2048\n\tds_read_b128 %8, %15\n\tds_read_b128 %9, %15 offset:2048\n\t" \
                 "ds_read_b128 %10, %15 offset:4096\n\tds_read_b128 %11, %15 offset:6144\n\ts_waitcnt lgkmcnt(6)" \
                 : "=&v"(x0), "=&v"(x1), "=&v"(w0), "=&v"(w1), "=&v"(w2), "=&v"(w3), "=&v"(y0), "=&v"(y1), "=&v"(v0), "=&v"(v1), "=&v"(v2), "=&v"(v3) \
                 : "v"(ax0 + soff), "v"(aw0 + soff), "v"(ax1 + soff), "v"(aw1 + soff) : "memory"); \
    MMA8(x0, x1, w0, w1, w2, w3); \
    asm volatile("s_waitcnt lgkmcnt(0)" : "+v"(y0), "+v"(y1), "+v"(v0), "+v"(v1), "+v"(v2), "+v"(v3) :: "memory"); \
    MMA8(y0, y1, v0, v1, v2, v3); } while (0)
  int st = 0;
#pragma unroll 1
  for (int kt = 0; kt < nkt; ++kt) {
    const unsigned soff = (unsigned)st * GSTAGE;
    const bool more2 = kt + 2 < nkt;
    if (more2) { xp += xks; wp += wks; const int s2 = st >= 1 ? st - 1 : 2; GDMA(lds + s2 * GSTAGE); }
    KTILE();
    if (more2) asm volatile("s_waitcnt vmcnt(6)" ::: "memory");
    else asm volatile("s_waitcnt vmcnt(0)" ::: "memory");
    __builtin_amdgcn_s_barrier();
    st = st == 2 ? 0 : st + 1;
  }
#undef KTILE
#undef MMA8
  __syncthreads();
}
__device__ __forceinline__ void zero_acc(f32x16 (&acc)[2][4]) {
#pragma unroll
  for (int a = 0; a < 2; ++a)
#pragma unroll
    for (int b = 0; b < 4; ++b)
#pragma unroll
      for (int r = 0; r < 16; ++r) acc[a][b][r] = 0.f;
}

template <class XA, class WA>
__device__ __forceinline__ f32x4 skinny_acc(XA xaddr, WA waddr, int nk32, char* lds, int tid) {
  int lane = tid & 63; const int wave = tid >> 6;
  asm volatile("" : "+v"(lane));
  const int per = nk32 >> 2;
  f32x4 acc = {0.f, 0.f, 0.f, 0.f};
  const int e = (wave + 1) * per;
  for (int s = wave * per; s < e; s += 8) {
    bf16x8 a0, a1, a2, a3, a4, a5, a6, a7, b0, b1, b2, b3, b4, b5, b6, b7;
#define SKL(j) { const int ss = (s + j < e) ? s + j : e - 1; const int kc = ss * 4 + (lane >> 4); a##j = *(const bf16x8*)waddr(lane & 15, kc); b##j = *(const bf16x8*)xaddr(lane & 15, kc); }
    SKL(0) SKL(1) SKL(2) SKL(3) SKL(4) SKL(5) SKL(6) SKL(7)
#undef SKL
#define SKM(j) if (s + j < e) acc = __builtin_amdgcn_mfma_f32_16x16x32_bf16(a##j, b##j, acc, 0, 0, 0);
    SKM(0) SKM(1) SKM(2) SKM(3) SKM(4) SKM(5) SKM(6) SKM(7)
#undef SKM
  }
  __syncthreads();
  f32x4* red = (f32x4*)lds;
  red[wave * 64 + lane] = acc;
  __syncthreads();
  if (wave == 0) acc = red[lane] + red[64 + lane] + red[128 + lane] + red[192 + lane];
  return acc;
}

__shared__ int s_unit;
__shared__ unsigned s_nx, s_nloc;
__shared__ int s_vb;
__device__ __forceinline__ bool tile_of(int it, int nN, int& tm, int& tn) {
  const int G = gridDim.x, b = s_vb;
  const int x = b & 7, j = b >> 3, tmPer = G >> 4;
  const int ptm = j % tmPer, ptn = j / tmPer;
  const int npn = nN >> 1, pi = it * 8 + x;
  tm = (pi / npn) * tmPer + ptm; tn = (pi % npn) * 2 + ptn;
  return tm < 128;
}
__device__ __forceinline__ int sk_first() { const int b = s_vb; return (7 - (b & 7)) * ((int)gridDim.x >> 3) + (b >> 3); }
__device__ __forceinline__ int tile_iters(int nN) { const int npatch = (128 / (gridDim.x >> 4)) * (nN >> 1); return (npatch + 7) >> 3; }

__device__ __forceinline__ void phase_init(const Params& p, int tid) {
  float* h = (float*)(p.ws + OFF_H); bf16_t* hb = (bf16_t*)(p.ws + OFF_HB);
  const int lane = tid & 63, wave = tid >> 6;
  const int gthreads = gridDim.x * 256, gtid = blockIdx.x * 256 + tid;
  for (int r0 = (int)blockIdx.x * 32 - 16; r0 < L; r0 += gridDim.x * 32)
  for (int r = r0 + wave; r < r0 + 32 && r < L; r += 4) {
    if (r < 0) continue;
    const float* src = r < 16 ? p.meta + (size_t)r * D : p.x + (size_t)(r - 16) * D;
    float ss = 0.f;
#pragma unroll
    for (int i = 0; i < 4; ++i) {
      const int c = i * 256 + lane * 4;
      const f32x4 v = *(const f32x4*)(src + c);
      *(f32x4*)(h + (size_t)r * D + c) = v;
      *(uint2*)(hb + hbidx(r, c)) = pack4(v);
      ss += v[0] * v[0] + v[1] * v[1] + v[2] * v[2] + v[3] * v[3];
    }
#pragma unroll
    for (int o = 32; o >= 1; o >>= 1) ss += __shfl_xor(ss, o);
    if (r >= 16) { if (lane < 16) *ssq_slot(p, 0, lane, r) = lane == 0 ? ss : 0.f; }
    else *ssk_slot(p, 0, lane, r) = lane == 0 ? ss : 0.f;
  }
  { bf16_t* ug = (bf16_t*)(p.ws + OFF_UG);
    for (int i = gtid; i < NG * 48 * 16 / 2; i += gthreads) { const int g = i / 384, w = i - g * 384; *(unsigned*)(ug + (size_t)g * LU * 16 + w * 2) = 0u; } }
  float2* LP = (float2*)(p.ws + OFF_LP); float2* BB = (float2*)(p.ws + OFF_BB);
  for (int i = gtid; i < 4 * 2 * NG * NP * 65; i += gthreads) {
    const int j = i % 65, q = i / 65;
    const float lre = p.lam_re[q], lim = p.lam_im[q];
    const float dt = expf(p.log_dt[q >> 6]);
    const float a = lre * dt;
    double ang = (double)j * ((double)lim * (double)dt);
    ang -= 6.283185307179586477 * rint(ang * 0.15915494309189533577);
    const float ra = (float)ang;
    const float mag = expf((float)j * a);
    LP[i] = make_float2(mag * cosf(ra), mag * sinf(ra));
  }
  for (int i = gtid; i < 4 * 2 * NG * NP * 16; i += gthreads) {
    const int q = i >> 4;
    const float lre = p.lam_re[q], lim = p.lam_im[q];
    const float dt = expf(p.log_dt[q >> 6]);
    const float a = lre * dt, b = lim * dt;
    const float sh = sinf(0.5f * b);
    const float nr = expm1f(a) * cosf(b) - 2.f * sh * sh, ni = expf(a) * sinf(b);
    const float den = 1.f / (lre * lre + lim * lim);
    const float cr = (nr * lre + ni * lim) * den, ci = (ni * lre - nr * lim) * den;
    const float br = p.b_re[i], bi = p.b_im[i];
    BB[i] = make_float2(cr * br - ci * bi, cr * bi + ci * br);
  }
}

__device__ __forceinline__ void phase_prep(const Params& p, int l, int ubeg, int uend, int bskip, char* lds, int tid) {
  char* W = p.ws + OFF_W;
  float* ldsf = (float*)lds;
  const float2* LP = (const float2*)(p.ws + OFF_LP) + (size_t)l * 2 * NG * NP * 65;
  const float2* BB = (const float2*)(p.ws + OFF_BB) + (size_t)l * 2 * NG * NP * 16;
  const float* Cre = p.c_re + (size_t)l * 2 * NG * 16 * NP; const float* Cim = p.c_im + (size_t)l * 2 * NG * 16 * NP;
  bf16_t* Ktab = (bf16_t*)(p.ws + OFF_KTAB); bf16_t* Wend = (bf16_t*)(p.ws + OFF_WEND); bf16_t* Mcar = (bf16_t*)(p.ws + OFF_MCAR);
  if ((int)blockIdx.x < bskip) return;
  for (int u = ubeg + (int)blockIdx.x - bskip; u < uend; u += (int)gridDim.x - bskip) {
    if (u < 5952) {
      const float* src; bf16_t* dst; int K, N; const float* rs = nullptr; float sc = 1.f; int perm = 0; int t;
      if (u < 704) { t = u; src = p.ffn1_wg + (size_t)l * D * DFF; dst = (bf16_t*)(W + W_GU1); K = D; N = DFF; rs = p.ffn1_norm + l * D; perm = 1; }
      else if (u < 1408) { t = u - 704; src = p.ffn1_wu + (size_t)l * D * DFF; dst = (bf16_t*)(W + W_GU1); K = D; N = DFF; rs = p.ffn1_norm + l * D; perm = 2; }
      else if (u < 2112) { t = u - 1408; src = p.ffn1_wd + (size_t)l * D * DFF; dst = (bf16_t*)(W + W_D1); K = DFF; N = D; sc = 0.5f; }
      else if (u < 3136) { t = u - 2112; src = p.w_in + (size_t)l * D * 4096; dst = (bf16_t*)(W + W_IN); K = D; N = 4096; rs = p.mix_norm + l * D; }
      else if (u < 3200) { t = u - 3136; src = p.w_glu + (size_t)l * 512 * 512; dst = (bf16_t*)(W + W_GLU); K = 512; N = 512; }
      else if (u < 3328) { t = u - 3200; src = p.w_bs + (size_t)l * 512 * D; dst = (bf16_t*)(W + W_BS); K = 512; N = D; }
      else if (u < 3584) { t = u - 3328; src = p.w_ba + (size_t)l * D * D; dst = (bf16_t*)(W + W_BA); K = D; N = D; }
      else if (u < 3840) { t = u - 3584; src = p.w_out + (size_t)l * D * D; dst = (bf16_t*)(W + W_O); K = D; N = D; }
      else if (u < 4544) { t = u - 3840; src = p.ffn2_wg + (size_t)l * D * DFF; dst = (bf16_t*)(W + W_GU2); K = D; N = DFF; rs = p.ffn2_norm + l * D; perm = 1; }
      else if (u < 5248) { t = u - 4544; src = p.ffn2_wu + (size_t)l * D * DFF; dst = (bf16_t*)(W + W_GU2); K = D; N = DFF; rs = p.ffn2_norm + l * D; perm = 2; }
      else { t = u - 5248; src = p.ffn2_wd + (size_t)l * D * DFF; dst = (bf16_t*)(W + W_D2); K = DFF; N = D; sc = 0.5f; }
      const int nkt = K >> 6; const int kt = t % nkt, nt = t / nkt;
      __syncthreads();
      f32x4 tv[4]; float tsc[4];
#pragma unroll
      for (int i = 0; i < 4; ++i) {
        const int idx = tid + 256 * i, kk = idx >> 4, n4 = idx & 15;
        tv[i] = *(const f32x4*)(src + (size_t)(kt * 64 + kk) * N + nt * 64 + n4 * 4);
        tsc[i] = rs ? rs[kt * 64 + kk] * sc : sc;
      }
#pragma unroll
      for (int i = 0; i < 4; ++i) {
        const int idx = tid + 256 * i, kk = idx >> 4, n4 = idx & 15;
        float* d4 = ldsf + kk * 65 + n4 * 4;
        d4[0] = tv[i][0] * tsc[i]; d4[1] = tv[i][1] * tsc[i]; d4[2] = tv[i][2] * tsc[i]; d4[3] = tv[i][3] * tsc[i];
      }
      __syncthreads();
      const int n = tid >> 2, kq = tid & 3;
      unsigned w[8];
#pragma unroll
      for (int j = 0; j < 8; ++j) w[j] = cvt_pk_bf16(ldsf[(kq * 16 + 2 * j) * 65 + n], ldsf[(kq * 16 + 2 * j + 1) * 65 + n]);
      int R = nt * 64 + n;
      if (perm) { const int tn = R >> 7, wn = (R >> 6) & 1, pr = (R >> 5) & 1, xx = R & 31; R = tn * 256 + wn * 128 + pr * 64 + xx + (perm == 2 ? 32 : 0); }
      const int k0 = kt * 64 + kq * 16;
      uint4* d = (uint4*)(dst + (((size_t)(R >> 8) * (K >> 5) + (k0 >> 5)) * 256 + (R & 255)) * 32 + (k0 & 31));
      d[0] = make_uint4(w[0], w[1], w[2], w[3]); d[1] = make_uint4(w[4], w[5], w[6], w[7]);
    } else if (u < 6464) {
      const int v = u - 5952, g = v >> 4, dd0 = (v & 15) * 8;
      float2* Cs = (float2*)lds;
      float2* Ws = (float2*)(lds + 16384);
      __syncthreads();
      for (int i = tid; i < 2048; i += 256) { const int dr = i >> 10, c = (i >> 6) & 15, pp = i & 63; const size_t ci = (size_t)((dr * NG + g) * 16 + c) * NP + pp; Cs[i] = make_float2(Cre[ci], Cim[ci]); }
      for (int j = 0; j < 8; ++j) {
        const int dd = dd0 + j; if (dd >= 127) break;
        const int d = dd - 63;
        __syncthreads();
#pragma unroll
        for (int ii = 0; ii < 8; ++ii) {
          const int i = tid + 256 * ii, dr = i >> 10, pp = (i >> 4) & 63, c2 = i & 15;
          const bool need = dr == 0 ? d >= 0 : d <= 0;
          float2 w = make_float2(0.f, 0.f);
          if (need) { const float2 a = LP[((size_t)(dr * NG + g) * NP + pp) * 65 + (d < 0 ? -d : d)], bb = BB[((size_t)(dr * NG + g) * NP + pp) * 16 + c2]; w = make_float2(a.x * bb.x - a.y * bb.y, a.x * bb.y + a.y * bb.x); }
          Ws[i] = w;
        }
        __syncthreads();
        const int c = tid >> 4, c2 = tid & 15;
        float sum = 0.f;
#pragma unroll 8
        for (int i = 0; i < 128; ++i) { const float2 cc = Cs[(i >> 6) * 1024 + c * 64 + (i & 63)], w = Ws[i * 16 + c2]; sum += cc.x * w.x - cc.y * w.y; }
        Ktab[((size_t)g * 127 + dd) * 256 + tid] = (bf16_t)(cvt_pk_bf16(sum, 0.f) & 0xffffu);
      }
    } else if (u < 8512) {
      const int v = u - 6464;
      const size_t e0 = ((size_t)v * 256 + tid) * 16;
      const int kk = (int)(e0 & 1023), pr = (int)((e0 >> 10) & 255), g = (int)(e0 >> 18);
      const int dr = pr >> 7, ri = (pr >> 6) & 1, pp = pr & 63, s = kk >> 4, c0 = kk & 15;
      const float2 a = LP[((size_t)(dr * NG + g) * NP + pp) * 65 + (dr ? s : 63 - s)];
      const float2* bb = BB + ((size_t)(dr * NG + g) * NP + pp) * 16 + c0;
      float o[16];
#pragma unroll
      for (int j = 0; j < 16; ++j) { const float2 b = bb[j]; o[j] = ri ? (a.x * b.y + a.y * b.x) : (a.x * b.x - a.y * b.y); }
      *(uint4*)(Wend + e0) = make_uint4(cvt_pk_bf16(o[0], o[1]), cvt_pk_bf16(o[2], o[3]), cvt_pk_bf16(o[4], o[5]), cvt_pk_bf16(o[6], o[7]));
      *(uint4*)(Wend + e0 + 8) = make_uint4(cvt_pk_bf16(o[8], o[9]), cvt_pk_bf16(o[10], o[11]), cvt_pk_bf16(o[12], o[13]), cvt_pk_bf16(o[14], o[15]));
    } else {
      const int v = u - 8512;
      const size_t e0 = ((size_t)v * 256 + tid) * 16;
      const int pr = (int)(e0 & 255), n = (int)((e0 >> 8) & 1023), g = (int)(e0 >> 18);
      const int dr = pr >> 7, ri = (pr >> 6) & 1, p0 = pr & 63, t = n >> 4, c = n & 15;
      const int e = dr ? 64 - t : t + 1;
      const float* cr = Cre + (size_t)((dr * NG + g) * 16 + c) * NP + p0; const float* ci = Cim + (size_t)((dr * NG + g) * 16 + c) * NP + p0;
      float o[16];
#pragma unroll
      for (int j = 0; j < 16; ++j) { const float2 a = LP[((size_t)(dr * NG + g) * NP + p0 + j) * 65 + e]; o[j] = ri ? -(cr[j] * a.y + ci[j] * a.x) : (cr[j] * a.x - ci[j] * a.y); }
      *(uint4*)(Mcar + e0) = make_uint4(cvt_pk_bf16(o[0], o[1]), cvt_pk_bf16(o[2], o[3]), cvt_pk_bf16(o[4], o[5]), cvt_pk_bf16(o[6], o[7]));
      *(uint4*)(Mcar + e0 + 8) = make_uint4(cvt_pk_bf16(o[8], o[9]), cvt_pk_bf16(o[10], o[11]), cvt_pk_bf16(o[12], o[13]), cvt_pk_bf16(o[14], o[15]));
    }
  }
}

__device__ __forceinline__ void phase_ffn_up(const Params& p, const bf16_t* Wgu, int si, char* lds, int tid) {
  const bf16_t* hb = (const bf16_t*)(p.ws + OFF_HB); bf16_t* act = (bf16_t*)(p.ws + OFF_ACT);
  const int lane = tid & 63, wave = tid >> 6, wm = wave >> 1, wn = wave & 1, lrow = tid >> 2, lch = tid & 3; int le = lane;
  constexpr int nN = 22;
  const int nit = tile_iters(nN);
  for (int it = 0; it < nit + 1; ++it) {
    if (it < nit) {
      int tm, tn; if (!tile_of(it, nN, tm, tn)) continue;
      const int m0 = 16 + tm * 128;
      f32x16 acc[2][4]; zero_acc(acc);
      int tl = tid; asm volatile("" : "+v"(tl));
      const int lrow = tl >> 2, lch = (tl & 3) ^ ((tl >> 4) & 3);
      float* rsl = (float*)(lds + 3 * GSTAGE) + (it & 1) * 128;
      if (tid < 128) rsl[tid] = row_rstd(p, si, m0 + tid);
      gemm_acc(acc, hb + ((size_t)tm * 32 * 128 + lrow) * 32 + lch * 8, 32, 4096, Wgu + ((size_t)tn * 32 * 256 + lrow) * 32 + lch * 8, 32, 8192, 32, lds, tid);
      LAUNDER_LANE();
#pragma unroll
      for (int mi = 0; mi < 2; ++mi) {
        const int row = m0 + wm * 64 + mi * 32 + (le & 31);
        const float rs = rsl[wm * 64 + mi * 32 + (le & 31)];
#pragma unroll
        for (int pr = 0; pr < 2; ++pr)
#pragma unroll
        for (int q = 0; q < 4; ++q) {
          f32x4 o;
#pragma unroll
          for (int j = 0; j < 4; ++j) { const float g = acc[mi][2 * pr][4 * q + j] * rs, uu = acc[mi][2 * pr + 1][4 * q + j] * rs; o[j] = g * sigmoidf_(g) * uu; }
          *(uint2*)(act + blkfast(tm, 88, tn * 4 + wn * 2 + pr, (wm * 64 + mi * 32 + (le & 31)) * 32 + 8 * q + 4 * (le >> 5))) = pack4(o);
        }
      }
    } else for (int v = sk_first(); v < 176; v += gridDim.x) {
      {
      const int c0 = v * 16, tn = c0 >> 7, wnn = (c0 >> 6) & 1, pr = (c0 >> 5) & 1, x0 = c0 & 31;
      const int Rg = tn * 256 + wnn * 128 + pr * 64 + x0;
      auto xa = [&](int m, int kc) { return hb + (((size_t)128 * 32 + (kc >> 2)) * 128 + m) * 32 + (kc & 3) * 8; };
      auto wg = [&](int n, int kc) { return wblk(Wgu, 32, Rg + n, kc); };
      auto wu = [&](int n, int kc) { return wblk(Wgu, 32, Rg + 32 + n, kc); };
      const f32x4 ag = skinny_acc(xa, wg, 32, lds, tid);
      const f32x4 au = skinny_acc(xa, wu, 32, lds, tid);
      if (wave == 0) {
        const int row = lane & 15;
        const float rs = row_rstd(p, si, row);
        f32x4 o;
#pragma unroll
        for (int j = 0; j < 4; ++j) { const float g = ag[j] * rs, uu = au[j] * rs; o[j] = g * sigmoidf_(g) * uu; }
        *(uint2*)(act + blkidx(row, c0 + 4 * (lane >> 4), 88)) = pack4(o);
      }
      }
    }
  }
}

__device__ __forceinline__ void resid_store(float* h, bf16_t* hb, int row, int col, f32x4 a, float& ss) {
  float* hp = h + (size_t)row * D + col;
  f32x4 hv = *(const f32x4*)hp;
  hv += a;
  *(f32x4*)hp = hv;
  *(uint2*)(hb + hbidx(row, col)) = pack4(hv);
  ss += hv[0] * hv[0] + hv[1] * hv[1] + hv[2] * hv[2] + hv[3] * hv[3];
}
__device__ __forceinline__ void phase_resid(const Params& p, const bf16_t* A, int K, const bf16_t* Wt, int si_next, char* lds, int tid) {
  float* h = (float*)(p.ws + OFF_H); bf16_t* hb = (bf16_t*)(p.ws + OFF_HB);
  const int lane = tid & 63, wave = tid >> 6, wm = wave >> 1, wn = wave & 1, lrow = tid >> 2, lch = tid & 3; int le = lane;
  constexpr int nN = 4;
  const int nit = tile_iters(nN);
  for (int it = 0; it < nit + 1; ++it) {
    if (it < nit) {
      int tm, tn; if (!tile_of(it, nN, tm, tn)) continue;
      const int m0 = 16 + tm * 128;
      f32x16 acc[2][4]; zero_acc(acc);
      int tl = tid; asm volatile("" : "+v"(tl));
      const int lrow = tl >> 2, lch = (tl & 3) ^ ((tl >> 4) & 3);
      gemm_acc(acc, A + ((size_t)tm * (K >> 5) * 128 + lrow) * 32 + lch * 8, 32, 4096, Wt + ((size_t)tn * (K >> 5) * 256 + lrow) * 32 + lch * 8, 32, 8192, K >> 5, lds, tid);
      LAUNDER_LANE();
#pragma unroll
      for (int mi = 0; mi < 2; ++mi) {
        const int row = m0 + wm * 64 + mi * 32 + (le & 31);
#pragma unroll
        for (int hf = 0; hf < 2; ++hf) {
        float ss = 0.f;
        f32x4 hv[2][4];
#pragma unroll
        for (int ni = 0; ni < 2; ++ni)
#pragma unroll
          for (int q = 0; q < 4; ++q) {
            hv[ni][q] = *(const f32x4*)(h + (size_t)row * D + tn * 256 + wn * 128 + (2 * hf + ni) * 32 + 8 * q + 4 * (le >> 5));
          }
#pragma unroll
        for (int ni = 0; ni < 2; ++ni)
#pragma unroll
          for (int q = 0; q < 4; ++q) {
            f32x4 a; a[0] = acc[mi][2 * hf + ni][4 * q]; a[1] = acc[mi][2 * hf + ni][4 * q + 1]; a[2] = acc[mi][2 * hf + ni][4 * q + 2]; a[3] = acc[mi][2 * hf + ni][4 * q + 3];
            const int col = tn * 256 + wn * 128 + (2 * hf + ni) * 32 + 8 * q + 4 * (le >> 5);
            const f32x4 hn = hv[ni][q] + a;
            *(f32x4*)(h + (size_t)row * D + col) = hn;
            *(uint2*)(hb + blkfast(tm, 32, tn * 8 + wn * 4 + 2 * hf + ni, (wm * 64 + mi * 32 + (le & 31)) * 32 + 8 * q + 4 * (le >> 5))) = pack4(hn);
            ss += hn[0] * hn[0] + hn[1] * hn[1] + hn[2] * hn[2] + hn[3] * hn[3];
          }
        ss += __shfl_xor(ss, 32);
        if (lane < 32) *ssq_slot(p, si_next, tn * 4 + wn * 2 + hf, row) = ss;
        asm volatile("" ::: "memory");
        }
      }
    } else for (int v = sk_first(); v < 64; v += gridDim.x) {
      {
      const int c0 = v * 16;
      auto xa = [&](int m, int kc) { return A + (((size_t)128 * (K >> 5) + (kc >> 2)) * 128 + m) * 32 + (kc & 3) * 8; };
      auto wa = [&](int n, int kc) { return wblk(Wt, K >> 5, c0 + n, kc); };
      const f32x4 a = skinny_acc(xa, wa, K >> 5, lds, tid);
      if (wave == 0) {
        const int row = lane & 15;
        float ss = 0.f;
        resid_store(h, hb, row, c0 + 4 * (lane >> 4), a, ss);
        ss += __shfl_xor(ss, 16); ss += __shfl_xor(ss, 32);
        if (lane < 16) *ssk_slot(p, si_next, c0 >> 4, row) = ss;
      }
      }
    }
  }
}

template <int SEL>
__device__ __forceinline__ void win_store(const Params& p, int row, int col, f32x4 a, float rs) {
  a *= rs;
  if (SEL == 0) { a *= 0.125f; *(uint2*)((bf16_t*)(p.ws + OFF_Q) + (size_t)row * D + col) = pack4(a); }
  else if (SEL == 1) { *(uint2*)((bf16_t*)(p.ws + OFF_K) + (size_t)row * 256 + (col - 1024)) = pack4(a); }
  else if (SEL == 2) {
    bf16_t* vt = (bf16_t*)(p.ws + OFF_VT) + (size_t)(col - 1280) * LV + row + 48;
    const uint2 w = pack4(a);
    vt[0] = (bf16_t)(w.x & 0xffffu); vt[LV] = (bf16_t)(w.x >> 16); vt[2 * LV] = (bf16_t)(w.y & 0xffffu); vt[3 * LV] = (bf16_t)(w.y >> 16);
  } else if (SEL == 3) {
    const int cc = col - 1536, g = cc >> 4, c = cc & 15;
    *(uint2*)((bf16_t*)(p.ws + OFF_UG) + ((size_t)g * LU + row + 48) * 16 + c) = pack4(a);
  } else {
    const f32x4 s = a;
    bf16_t* dst = (bf16_t*)(p.ws + (SEL == 4 ? OFF_GS : OFF_GA)) + (size_t)row * D + (col - (SEL == 4 ? 2048 : 3072));
    *(uint2*)dst = pack4(s);
  }
}
template <int SEL>
__device__ __forceinline__ void win_epi(const Params& p, const f32x16 (&acc)[2][4], const float* rsl, int m0, int tn, int tid) {
  const int lane = tid & 63, wave = tid >> 6, wm = wave >> 1, wn = wave & 1; int le = lane; LAUNDER_LANE();
#pragma unroll
  for (int mi = 0; mi < 2; ++mi) {
    const int row = m0 + wm * 64 + mi * 32 + (le & 31);
    const float rs = rsl[wm * 64 + mi * 32 + (le & 31)];
#pragma unroll
    for (int ni = 0; ni < 4; ++ni)
#pragma unroll
      for (int q = 0; q < 4; ++q) {
        f32x4 a; a[0] = acc[mi][ni][4 * q]; a[1] = acc[mi][ni][4 * q + 1]; a[2] = acc[mi][ni][4 * q + 2]; a[3] = acc[mi][ni][4 * q + 3];
        win_store<SEL>(p, row, tn * 256 + wn * 128 + ni * 32 + 8 * q + 4 * (le >> 5), a, rs);
      }
  }
}
__device__ __forceinline__ int win_sel(int col) { return col < 1024 ? 0 : col < 1280 ? 1 : col < 1536 ? 2 : col < 2048 ? 3 : col < 3072 ? 4 : 5; }
__device__ __forceinline__ void phase_win(const Params& p, int si, char* lds, int tid) {
  const bf16_t* hb = (const bf16_t*)(p.ws + OFF_HB); const bf16_t* Wt = (const bf16_t*)(p.ws + OFF_W + W_IN);
  const int lane = tid & 63, wave = tid >> 6, wm = wave >> 1, wn = wave & 1, lrow = tid >> 2, lch = tid & 3; int le = lane;
  constexpr int nN = 16;
  const int nit = tile_iters(nN);
  for (int it = 0; it < nit + 1; ++it) {
    if (it < nit) {
      int tm, tn; if (!tile_of(it, nN, tm, tn)) continue;
      const int m0 = 16 + tm * 128;
      f32x16 acc[2][4]; zero_acc(acc);
      int tl = tid; asm volatile("" : "+v"(tl));
      const int lrow = tl >> 2, lch = (tl & 3) ^ ((tl >> 4) & 3);
      float* rsl = (float*)(lds + 3 * GSTAGE) + (it & 1) * 128;
      if (tid < 128) rsl[tid] = row_rstd(p, si, m0 + tid);
      gemm_acc(acc, hb + ((size_t)tm * 32 * 128 + lrow) * 32 + lch * 8, 32, 4096, Wt + ((size_t)tn * 32 * 256 + lrow) * 32 + lch * 8, 32, 8192, 32, lds, tid);
      LAUNDER_LANE();
      switch (win_sel(tn * 256)) {
        case 0: win_epi<0>(p, acc, rsl, m0, tn, tid); break;
        case 1: win_epi<1>(p, acc, rsl, m0, tn, tid); break;
        case 2: win_epi<2>(p, acc, rsl, m0, tn, tid); break;
        case 3: win_epi<3>(p, acc, rsl, m0, tn, tid); break;
        case 4: win_epi<4>(p, acc, rsl, m0, tn, tid); break;
        default: win_epi<5>(p, acc, rsl, m0, tn, tid); break;
      }
    } else for (int v = sk_first(); v < 256; v += gridDim.x) {
      {
      const int c0 = v * 16;
      auto xa = [&](int m, int kc) { return hb + (((size_t)128 * 32 + (kc >> 2)) * 128 + m) * 32 + (kc & 3) * 8; };
      auto wa = [&](int n, int kc) { return wblk(Wt, 32, c0 + n, kc); };
      const f32x4 a = skinny_acc(xa, wa, 32, lds, tid);
      if (wave == 0) {
        const int row = lane & 15;
        const float rs = row_rstd(p, si, row);
        const int cc = c0 + 4 * (lane >> 4);
        switch (win_sel(c0)) {
          case 0: win_store<0>(p, row, cc, a, rs); break;
          case 1: win_store<1>(p, row, cc, a, rs); break;
          case 2: win_store<2>(p, row, cc, a, rs); break;
          case 3: win_store<3>(p, row, cc, a, rs); break;
          case 4: win_store<4>(p, row, cc, a, rs); break;
          default: win_store<5>(p, row, cc, a, rs); break;
        }
      }
      }
    }
  }
}

__device__ __forceinline__ void attn_unit(const Params& p, int l, int b, int h, char* lds, int tid) {
  const bf16_t* Q = (const bf16_t*)(p.ws + OFF_Q); const bf16_t* Kb = (const bf16_t*)(p.ws + OFF_K); const bf16_t* VT = (const bf16_t*)(p.ws + OFF_VT);
  bf16_t* YA = (bf16_t*)(p.ws + OFF_YA);
  const int lane = tid & 63, wave = tid >> 6, r31 = lane & 31, hh = lane >> 5;
  const int kv = h >> 2;
  const float slope = exp2f(-0.5f * (float)(h + 1));
  const float sinkv = p.sink[l * 16 + h];
  const int q0 = b * 128 + wave * 32;
  const int qx = q0 + r31;
  const bool wactive = (b >= 0) || (wave == 3);
  int qseq = qx + 16; const bool qvalid = qseq >= 0; if (qseq < 0) qseq = 0;
  bf16x8 qf[4];
#pragma unroll
  for (int kk = 0; kk < 4; ++kk) qf[kk] = *(const bf16x8*)(Q + (size_t)qseq * D + h * 64 + kk * 16 + 8 * hh);
  f32x16 o[2];
#pragma unroll
  for (int r = 0; r < 16; ++r) { o[0][r] = 0.f; o[1][r] = 0.f; }
  float m = sinkv, lsum = hh == 0 ? 1.f : 0.f;
  const int swz = (r31 >> 1) & 7;
  uint4 kr0, kr1, kr2, kr3, vr0, vr1, vr2, vr3;
#define ATT_ISSUE(ST) do { const int _st = (ST); const int _kseq0 = _st == 0 ? 0 : (b - 2 + _st) * 128 + 16; const int _nrow = _st == 0 ? 32 : 128, _nkc = _st == 0 ? 4 : 16; \
    const bf16_t* _kp = Kb + (size_t)(_kseq0 + (tid >> 3)) * 256 + kv * 64 + (tid & 7) * 8; \
    kr0 = *(const uint4*)(_kp); if (_nrow > 32) { kr1 = *(const uint4*)(_kp + 32 * 256); kr2 = *(const uint4*)(_kp + 64 * 256); kr3 = *(const uint4*)(_kp + 96 * 256); } \
    if ((tid & 15) < _nkc) { const bf16_t* _vp = VT + (size_t)(kv * 64 + (tid >> 4)) * LV + _kseq0 + 48 + (tid & 15) * 8; \
      vr0 = *(const uint4*)(_vp); vr1 = *(const uint4*)(_vp + (size_t)16 * LV); vr2 = *(const uint4*)(_vp + (size_t)32 * LV); vr3 = *(const uint4*)(_vp + (size_t)48 * LV); } } while (0)
  ATT_ISSUE(0);
  for (int st = 0; st < 4; ++st) {
    const int kb = b - 2 + st;
    if (st != 0 && (kb < 0 || kb >= 128)) continue;
    const int kseq0 = st == 0 ? 0 : kb * 128 + 16;
    __syncthreads();
    {
      const int nrow = st == 0 ? 32 : 128;
      char* kd = lds + lds_off(tid >> 3, tid & 7);
      *(uint4*)kd = kr0;
      if (nrow > 32) { *(uint4*)(kd + 4096) = kr1; *(uint4*)(kd + 8192) = kr2; *(uint4*)(kd + 12288) = kr3; }
      const int nkc = st == 0 ? 4 : 16;
      if ((tid & 15) < nkc) {
        char* dst = lds + 16384 + (tid >> 4) * 264 + (tid & 15) * 16;
        *(uint2*)dst = make_uint2(vr0.x, vr0.y); *(uint2*)(dst + 8) = make_uint2(vr0.z, vr0.w);
        *(uint2*)(dst + 16 * 264) = make_uint2(vr1.x, vr1.y); *(uint2*)(dst + 16 * 264 + 8) = make_uint2(vr1.z, vr1.w);
        *(uint2*)(dst + 32 * 264) = make_uint2(vr2.x, vr2.y); *(uint2*)(dst + 32 * 264 + 8) = make_uint2(vr2.z, vr2.w);
        *(uint2*)(dst + 48 * 264) = make_uint2(vr3.x, vr3.y); *(uint2*)(dst + 48 * 264 + 8) = make_uint2(vr3.z, vr3.w);
      }
      int nst = st + 1;
      while (nst < 4 && (b - 2 + nst < 0 || b - 2 + nst >= 128)) ++nst;
      if (nst < 4) ATT_ISSUE(nst);
    }
    __syncthreads();
    if (!wactive) continue;
    const int nj = st == 0 ? 1 : 4;
    for (int j = 0; j < nj; ++j) {
      const int kx0 = st == 0 ? 0 : kb * 128 + 32 * j;
      if (st != 0 && (kx0 + 31 < q0 - 128 || kx0 > q0 + 31 + 128)) continue;
      f32x16 s;
#pragma unroll
      for (int r = 0; r < 16; ++r) s[r] = 0.f;
#pragma unroll
      for (int kk = 0; kk < 4; ++kk) {
        const bf16x8 a = *(const bf16x8*)(lds + (32 * j + r31) * 128 + (((kk * 2 + hh) ^ swz) << 4));
        s = __builtin_amdgcn_mfma_f32_32x32x16_bf16(a, qf[kk], s, 0, 0, 0);
      }
      float tmax = -1e30f;
#pragma unroll
      for (int r = 0; r < 16; ++r) {
        const int key = 8 * (r >> 2) + 4 * hh + (r & 3);
        float sv; bool valid;
        if (st == 0) { valid = key < 16; sv = s[r]; }
        else { int dist = qx - (kx0 + key); dist = dist < 0 ? -dist : dist; valid = dist <= 128; sv = s[r] - slope * (float)dist; }
        sv = valid ? sv : -1e30f;
        s[r] = sv; tmax = fmaxf(tmax, sv);
      }
      tmax = fmaxf(tmax, __shfl_xor(tmax, 32));
      const float mnew = fmaxf(m, tmax);
      const float alpha = __expf(m - mnew);
      m = mnew;
      float psum = 0.f;
#pragma unroll
      for (int r = 0; r < 16; ++r) { s[r] = __expf(s[r] - mnew); psum += s[r]; }
      lsum = lsum * alpha + psum;
#pragma unroll
      for (int r = 0; r < 16; ++r) { o[0][r] *= alpha; o[1][r] *= alpha; }
      bf16x8 pf[2];
#pragma unroll
      for (int s2 = 0; s2 < 2; ++s2) {
        unsigned w0 = cvt_pk_bf16(s[8 * s2 + 0], s[8 * s2 + 1]), w1 = cvt_pk_bf16(s[8 * s2 + 2], s[8 * s2 + 3]);
        unsigned w2 = cvt_pk_bf16(s[8 * s2 + 4], s[8 * s2 + 5]), w3 = cvt_pk_bf16(s[8 * s2 + 6], s[8 * s2 + 7]);
        uint4 t = make_uint4(w0, w1, w2, w3);
        pf[s2] = *(bf16x8*)&t;
      }
#pragma unroll
      for (int s2 = 0; s2 < 2; ++s2)
#pragma unroll
        for (int di = 0; di < 2; ++di) {
          const char* vrow = lds + 16384 + (32 * di + r31) * 264 + (32 * j + 16 * s2 + 4 * hh) * 2;
          const uint2 lo = *(const uint2*)vrow, hi = *(const uint2*)(vrow + 16);
          uint4 t = make_uint4(lo.x, lo.y, hi.x, hi.y);
          o[di] = __builtin_amdgcn_mfma_f32_32x32x16_bf16(*(bf16x8*)&t, pf[s2], o[di], 0, 0, 0);
        }
    }
  }
  if (wactive) {
    const float lt = lsum + __shfl_xor(lsum, 32);
    const float inv = 1.0f / lt;
    if (qvalid) {
#pragma unroll
      for (int di = 0; di < 2; ++di)
#pragma unroll
        for (int q = 0; q < 4; ++q) {
          f32x4 a; a[0] = o[di][4 * q] * inv; a[1] = o[di][4 * q + 1] * inv; a[2] = o[di][4 * q + 2] * inv; a[3] = o[di][4 * q + 3] * inv;
          *(uint2*)(YA + blkidx(qseq, h * 64 + 32 * di + 8 * q + 4 * hh, 32)) = pack4(a);
        }
    }
  }
}

#undef ATT_ISSUE
__device__ __forceinline__ void phase_attn_xend(const Params& p, int l, char* lds, int tid) {
  const bf16_t* ug = (const bf16_t*)(p.ws + OFF_UG); const bf16_t* Wend = (const bf16_t*)(p.ws + OFF_WEND); float* Xend = (float*)(p.ws + OFF_XEND);
  const int lane = tid & 63, wave = tid >> 6, wm = wave >> 1, wn = wave & 1, lrow = tid >> 2, lch = tid & 3; int le = lane;
  constexpr int NATT = 2048 + 16, NXM = 64, NXS = 512;
  unsigned* ctr = (unsigned*)(p.ws + OFF_BAR) + 2304 + 64 * l;
  if (tid == 0) s_unit = (int)__hip_atomic_fetch_add(ctr, 1u, __ATOMIC_RELAXED, __HIP_MEMORY_SCOPE_AGENT);
  __syncthreads();
  int uq = s_unit;
  __syncthreads();
  while (uq < NATT + NXM + NXS) {
    if (tid == 0) s_unit = (int)__hip_atomic_fetch_add(ctr, 1u, __ATOMIC_RELAXED, __HIP_MEMORY_SCOPE_AGENT);
    const int u = uq < NXM ? NATT + uq : (uq < NXM + NATT ? uq - NXM : uq);
    if (u < NATT) {
      if (u < 2048) attn_unit(p, l, u >> 4, u & 15, lds, tid); else attn_unit(p, l, -1, u - 2048, lds, tid);
    } else if (u < NATT + NXM) {
      const int v = u - NATT, g = v >> 1, tm = v & 1;
      const int k0 = 1 + tm * 128;
      f32x16 acc[2][4]; zero_acc(acc);
      int tl = tid; asm volatile("" : "+v"(tl));
      const int lrow = tl >> 2, lch = (tl & 3) ^ ((tl >> 4) & 3);
      gemm_acc(acc, ug + ((size_t)g * LU + (size_t)(k0 + lrow) * 64) * 16 + lch * 8, 1024, 32,
               Wend + ((size_t)g * 256 + lrow) * 1024 + lch * 8, 1024, 32, 32, lds, tid);
      LAUNDER_LANE();
#pragma unroll
      for (int mi = 0; mi < 2; ++mi) {
        const int k = k0 + wm * 64 + mi * 32 + (le & 31);
#pragma unroll
        for (int ni = 0; ni < 4; ++ni)
#pragma unroll
          for (int q = 0; q < 4; ++q) {
            f32x4 a; a[0] = acc[mi][ni][4 * q]; a[1] = acc[mi][ni][4 * q + 1]; a[2] = acc[mi][ni][4 * q + 2]; a[3] = acc[mi][ni][4 * q + 3];
            *(f32x4*)(Xend + ((size_t)g * NCH + k) * 256 + wn * 128 + ni * 32 + 8 * q + 4 * (le >> 5)) = a;
          }
      }
    } else {
      {
      const int v = u - NATT - NXM, g = v >> 4, c0 = (v & 15) * 16;
      auto xa = [&](int m, int kc) { return ug + (size_t)g * LU * 16 + kc * 8; };
      auto wa = [&](int n, int kc) { return Wend + ((size_t)g * 256 + c0 + n) * 1024 + kc * 8; };
      const f32x4 a = skinny_acc(xa, wa, 32, lds, tid);
      if (wave == 0 && (lane & 15) == 0) *(f32x4*)(Xend + ((size_t)g * NCH + 0) * 256 + c0 + 4 * (lane >> 4)) = a;
      }
    }
    __syncthreads();
    uq = s_unit;
    __syncthreads();
  }
}

__device__ __forceinline__ void phase_scan(const Params& p, int l, int tid) {
  const float* Xend = (const float*)(p.ws + OFF_XEND); bf16_t* Xin = (bf16_t*)(p.ws + OFF_XIN);
  const float2* LP = (const float2*)(p.ws + OFF_LP) + (size_t)l * 2 * NG * NP * 65;
  const int gt = blockIdx.x * 256 + tid;
  if (gt >= 2 * NG * NP) return;
  const int pp = gt & 63, g = (gt >> 6) & 31, dr = gt >> 11;
  const float2 lam = LP[((size_t)(dr * NG + g) * NP + pp) * 65 + 64];
  const float* xe = Xend + (size_t)g * NCH * 256 + dr * 128 + pp;
  bf16_t* xi = Xin + (size_t)g * NCH * 256 + dr * 128 + pp;
  float xr = 0.f, xim = 0.f;
  for (int i0 = 0; i0 < NCH; i0 += 16) {
    float er[16], ei[16];
#pragma unroll
    for (int j = 0; j < 16; ++j) { const int i = i0 + j; const int ic = i < NCH ? i : NCH - 1; const int k = dr ? (NCH - 1 - ic) : ic; er[j] = xe[(size_t)k * 256]; ei[j] = xe[(size_t)k * 256 + 64]; }
#pragma unroll
    for (int j = 0; j < 16; ++j) {
      const int i = i0 + j; const int k = dr ? (NCH - 1 - i) : i;
      if (i < NCH) {
        xi[(size_t)k * 256] = (bf16_t)(cvt_pk_bf16(xr, 0.f) & 0xffffu); xi[(size_t)k * 256 + 64] = (bf16_t)(cvt_pk_bf16(xim, 0.f) & 0xffffu);
        const float nr = lam.x * xr - lam.y * xim + er[j], ni = lam.x * xim + lam.y * xr + ei[j];
        xr = nr; xim = ni;
      }
    }
  }
}

__device__ __forceinline__ uint2 ssm_load_u(const Params& p, int g, int k, int n) {
  const int t = n >> 4, c = n & 15;
  return *(const uint2*)((const bf16_t*)(p.ws + OFF_UG) + ((size_t)g * LU + 64 * k + t) * 16 + c);
}
__device__ __forceinline__ void ssm_store(const Params& p, int l, int g, int k, int n, f32x4 a, uint2 uw) {
  const int t = n >> 4, c = n & 15;
  const int pos = 64 * k + t, seq = pos - 48;
  if (seq < 0) return;
  const f32x4 dv = *(const f32x4*)(p.ssm_d + l * 512 + g * 16 + c);
  f32x4 y;
  y[0] = a[0] + dv[0] * __uint_as_float(uw.x << 16); y[1] = a[1] + dv[1] * __uint_as_float(uw.x & 0xffff0000u);
  y[2] = a[2] + dv[2] * __uint_as_float(uw.y << 16); y[3] = a[3] + dv[3] * __uint_as_float(uw.y & 0xffff0000u);
  y[0] = gelu_tanh(y[0]); y[1] = gelu_tanh(y[1]); y[2] = gelu_tanh(y[2]); y[3] = gelu_tanh(y[3]);
  *(uint2*)((bf16_t*)(p.ws + OFF_Z) + ((size_t)g * LZ + seq) * 16 + c) = pack4(y);
}
__device__ __forceinline__ void phase_ssm_out(const Params& p, int l, char* lds, int tid) {
  const bf16_t* ug = (const bf16_t*)(p.ws + OFF_UG); const bf16_t* Ktab = (const bf16_t*)(p.ws + OFF_KTAB);
  const bf16_t* Mcar = (const bf16_t*)(p.ws + OFF_MCAR); const bf16_t* Xin = (const bf16_t*)(p.ws + OFF_XIN);
  const int lane = tid & 63, wave = tid >> 6, wm = wave >> 1, wn = wave & 1, lrow = tid >> 2, lch = tid & 3; int le = lane;
  constexpr int NMAIN = 256, NSK = 512;
  for (int u = blockIdx.x; u < NMAIN + NSK; u += gridDim.x) {
    if (u < NMAIN) {
      const int g = u >> 3, tm = u & 1, tn = (u >> 1) & 3;
      const int k0 = 1 + tm * 128, n0 = tn * 256;
      f32x16 acc[2][4]; zero_acc(acc);
      int tl = tid; asm volatile("" : "+v"(tl));
      const int lrow = tl >> 2, lch = (tl & 3) ^ ((tl >> 4) & 3);
      gemm_acc(acc, ug + ((size_t)g * LU + (size_t)(k0 + lrow) * 64) * 16 + lch * 8, 1024, 32,
               Ktab + (size_t)g * 127 * 256 + (size_t)(n0 + lrow) * 16 + (63 - (lch >> 1)) * 256 + (lch & 1) * 8, 16, -512, 32, lds, tid);
      LAUNDER_LANE();
      gemm_acc(acc, Xin + ((size_t)g * NCH + k0 + lrow) * 256 + lch * 8, 256, 32,
               Mcar + ((size_t)g * 1024 + n0 + lrow) * 256 + lch * 8, 256, 32, 8, lds, tid);
      LAUNDER_LANE();
#pragma unroll
      for (int mi = 0; mi < 2; ++mi) {
        const int k = k0 + wm * 64 + mi * 32 + (le & 31);
#pragma unroll
        for (int hf = 0; hf < 2; ++hf) {
        uint2 uw[2][4];
#pragma unroll
        for (int ni = 0; ni < 2; ++ni)
#pragma unroll
          for (int q = 0; q < 4; ++q) uw[ni][q] = ssm_load_u(p, g, k, n0 + wn * 128 + (2 * hf + ni) * 32 + 8 * q + 4 * (le >> 5));
#pragma unroll
        for (int ni = 0; ni < 2; ++ni)
#pragma unroll
          for (int q = 0; q < 4; ++q) {
            f32x4 a; a[0] = acc[mi][2 * hf + ni][4 * q]; a[1] = acc[mi][2 * hf + ni][4 * q + 1]; a[2] = acc[mi][2 * hf + ni][4 * q + 2]; a[3] = acc[mi][2 * hf + ni][4 * q + 3];
            ssm_store(p, l, g, k, n0 + wn * 128 + (2 * hf + ni) * 32 + 8 * q + 4 * (le >> 5), a, uw[ni][q]);
          }
        asm volatile("" ::: "memory");
        }
      }
    } else {
      {
      const int v = u - NMAIN, g = v >> 4, c0 = 768 + (v & 15) * 16;
      auto xa = [&](int m, int kc) { return kc < 128 ? ug + (size_t)g * LU * 16 + kc * 8 : Xin + (size_t)g * NCH * 256 + (kc - 128) * 8; };
      auto wa = [&](int n, int kc) {
        const int nn = c0 + n;
        return kc < 128 ? Ktab + (size_t)g * 127 * 256 + ((nn >> 4) + 63 - (kc >> 1)) * 256 + (nn & 15) * 16 + (kc & 1) * 8
                        : Mcar + ((size_t)g * 1024 + nn) * 256 + (kc - 128) * 8; };
      const f32x4 a = skinny_acc(xa, wa, 40, lds, tid);
      if (wave == 0 && (lane & 15) == 0) ssm_store(p, l, g, 0, c0 + 4 * (lane >> 4), a, ssm_load_u(p, g, 0, c0 + 4 * (lane >> 4)));
      }
    }
  }
}

__device__ __forceinline__ void phase_glu(const Params& p, char* lds, int tid) {
  const bf16_t* Z = (const bf16_t*)(p.ws + OFF_Z); const bf16_t* Wt = (const bf16_t*)(p.ws + OFF_W + W_GLU); bf16_t* YS = (bf16_t*)(p.ws + OFF_YS);
  const int lane = tid & 63, wave = tid >> 6, wm = wave >> 1, wn = wave & 1, lrow = tid >> 2, lch = tid & 3; int le = lane;
  constexpr int nN = 2;
  auto loadz = [&](int row, int col) { return *(const uint2*)(Z + ((size_t)(col >> 4) * LZ + row) * 16 + (col & 15)); };
  auto store = [&](int row, int col, f32x4 a, uint2 zw) {
    f32x4 o;
    o[0] = __uint_as_float(zw.x << 16) * sigmoidf_(a[0]); o[1] = __uint_as_float(zw.x & 0xffff0000u) * sigmoidf_(a[1]);
    o[2] = __uint_as_float(zw.y << 16) * sigmoidf_(a[2]); o[3] = __uint_as_float(zw.y & 0xffff0000u) * sigmoidf_(a[3]);
    *(uint2*)(YS + blkidx(row, col, 16)) = pack4(o);
  };
  const int nit = tile_iters(nN);
  for (int it = 0; it < nit + 1; ++it) {
    if (it < nit) {
      int tm, tn; if (!tile_of(it, nN, tm, tn)) continue;
      const int m0 = 16 + tm * 128;
      f32x16 acc[2][4]; zero_acc(acc);
      int tl = tid; asm volatile("" : "+v"(tl));
      const int lrow = tl >> 2, lch = (tl & 3) ^ ((tl >> 4) & 3);
      gemm_acc(acc, Z + ((size_t)(lch >> 1) * LZ + m0 + lrow) * 16 + (lch & 1) * 8, 16, 2 * LZ * 16, Wt + ((size_t)tn * 16 * 256 + lrow) * 32 + lch * 8, 32, 8192, 16, lds, tid);
      LAUNDER_LANE();
#pragma unroll
      for (int mi = 0; mi < 2; ++mi) {
        const int row = m0 + wm * 64 + mi * 32 + (le & 31);
#pragma unroll
        for (int hf = 0; hf < 2; ++hf) {
        uint2 zw[2][4];
#pragma unroll
        for (int ni = 0; ni < 2; ++ni)
#pragma unroll
          for (int q = 0; q < 4; ++q) zw[ni][q] = loadz(row, tn * 256 + wn * 128 + (2 * hf + ni) * 32 + 8 * q + 4 * (le >> 5));
#pragma unroll
        for (int ni = 0; ni < 2; ++ni)
#pragma unroll
          for (int q = 0; q < 4; ++q) {
            f32x4 a; a[0] = acc[mi][2 * hf + ni][4 * q]; a[1] = acc[mi][2 * hf + ni][4 * q + 1]; a[2] = acc[mi][2 * hf + ni][4 * q + 2]; a[3] = acc[mi][2 * hf + ni][4 * q + 3];
            store(row, tn * 256 + wn * 128 + (2 * hf + ni) * 32 + 8 * q + 4 * (le >> 5), a, zw[ni][q]);
          }
        asm volatile("" ::: "memory");
        }
      }
    } else for (int v = sk_first(); v < 32; v += gridDim.x) {
      {
      const int c0 = v * 16;
      auto xa = [&](int m, int kc) { return Z + ((size_t)(kc >> 1) * LZ + m) * 16 + (kc & 1) * 8; };
      auto wa = [&](int n, int kc) { return wblk(Wt, 16, c0 + n, kc); };
      const f32x4 a = skinny_acc(xa, wa, 16, lds, tid);
      if (wave == 0) store(lane & 15, c0 + 4 * (lane >> 4), a, loadz(lane & 15, c0 + 4 * (lane >> 4)));
      }
    }
  }
}

__device__ __forceinline__ f32x4 un4bf(uint2 w) {
  f32x4 r; r[0] = __uint_as_float(w.x << 16); r[1] = __uint_as_float(w.x & 0xffff0000u); r[2] = __uint_as_float(w.y << 16); r[3] = __uint_as_float(w.y & 0xffff0000u); return r;
}
__device__ __forceinline__ f32x4 ld4bf(const bf16_t* ptr) {
  const uint2 w = *(const uint2*)ptr; f32x4 r;
  r[0] = __uint_as_float(w.x << 16); r[1] = __uint_as_float(w.x & 0xffff0000u); r[2] = __uint_as_float(w.y << 16); r[3] = __uint_as_float(w.y & 0xffff0000u); return r;
}
__device__ __forceinline__ void phase_merge(const Params& p, char* lds, int tid) {
  const bf16_t* YS = (const bf16_t*)(p.ws + OFF_YS); const bf16_t* YA = (const bf16_t*)(p.ws + OFF_YA);
  const bf16_t* GS = (const bf16_t*)(p.ws + OFF_GS); const bf16_t* GA = (const bf16_t*)(p.ws + OFF_GA);
  const bf16_t* Wbs = (const bf16_t*)(p.ws + OFF_W + W_BS); const bf16_t* Wba = (const bf16_t*)(p.ws + OFF_W + W_BA);
  bf16_t* MG = (bf16_t*)(p.ws + OFF_Q);
  const int lane = tid & 63, wave = tid >> 6, wm = wave >> 1, wn = wave & 1, lrow = tid >> 2, lch = tid & 3; int le = lane;
  constexpr int nN = 4;
  const int nit = tile_iters(nN);
  for (int it = 0; it < nit + 1; ++it) {
    if (it < nit) {
      int tm, tn; if (!tile_of(it, nN, tm, tn)) continue;
      const int m0 = 16 + tm * 128;
      f32x16 acc[2][4]; zero_acc(acc);
      int tl = tid; asm volatile("" : "+v"(tl));
      const int lrow = tl >> 2, lch = (tl & 3) ^ ((tl >> 4) & 3);
      gemm_acc(acc, YS + ((size_t)tm * 16 * 128 + lrow) * 32 + lch * 8, 32, 4096, Wbs + ((size_t)tn * 16 * 256 + lrow) * 32 + lch * 8, 32, 8192, 16, lds, tid);
      LAUNDER_LANE();
#pragma unroll
      for (int mi = 0; mi < 2; ++mi) {
        const int row = m0 + wm * 64 + mi * 32 + (le & 31);
#pragma unroll
        for (int hf = 0; hf < 2; ++hf) {
        uint2 gw[2][4];
#pragma unroll
        for (int ni = 0; ni < 2; ++ni)
#pragma unroll
          for (int q = 0; q < 4; ++q) gw[ni][q] = *(const uint2*)(GS + (size_t)row * D + tn * 256 + wn * 128 + (2 * hf + ni) * 32 + 8 * q + 4 * (le >> 5));
#pragma unroll
        for (int ni = 0; ni < 2; ++ni)
#pragma unroll
          for (int q = 0; q < 4; ++q) {
            f32x4 gsv = un4bf(gw[ni][q]);
            gsv[0] = sigmoidf_(gsv[0]); gsv[1] = sigmoidf_(gsv[1]); gsv[2] = sigmoidf_(gsv[2]); gsv[3] = sigmoidf_(gsv[3]);
            f32x4 t;
#pragma unroll
            for (int j = 0; j < 4; ++j) t[j] = acc[mi][2 * hf + ni][4 * q + j] * gsv[j];
            *(uint2*)(MG + blkfast(tm, 32, tn * 8 + wn * 4 + 2 * hf + ni, (wm * 64 + mi * 32 + (le & 31)) * 32 + 8 * q + 4 * (le >> 5))) = pack4(t);
          }
        asm volatile("" ::: "memory");
        }
      }
      zero_acc(acc);
      gemm_acc(acc, YA + ((size_t)tm * 32 * 128 + lrow) * 32 + lch * 8, 32, 4096, Wba + ((size_t)tn * 32 * 256 + lrow) * 32 + lch * 8, 32, 8192, 32, lds, tid);
      LAUNDER_LANE();
#pragma unroll
      for (int mi = 0; mi < 2; ++mi) {
        const int row = m0 + wm * 64 + mi * 32 + (le & 31);
#pragma unroll
        for (int hf = 0; hf < 2; ++hf) {
        uint2 gw[2][4], pw[2][4];
#pragma unroll
        for (int ni = 0; ni < 2; ++ni)
#pragma unroll
          for (int q = 0; q < 4; ++q) {
            gw[ni][q] = *(const uint2*)(GA + (size_t)row * D + tn * 256 + wn * 128 + (2 * hf + ni) * 32 + 8 * q + 4 * (le >> 5));
            pw[ni][q] = *(const uint2*)(MG + blkfast(tm, 32, tn * 8 + wn * 4 + 2 * hf + ni, (wm * 64 + mi * 32 + (le & 31)) * 32 + 8 * q + 4 * (le >> 5)));
          }
#pragma unroll
        for (int ni = 0; ni < 2; ++ni)
#pragma unroll
          for (int q = 0; q < 4; ++q) {
            const int col = tn * 256 + wn * 128 + (2 * hf + ni) * 32 + 8 * q + 4 * (le >> 5);
            f32x4 gav = un4bf(gw[ni][q]);
            gav[0] = sigmoidf_(gav[0]); gav[1] = sigmoidf_(gav[1]); gav[2] = sigmoidf_(gav[2]); gav[3] = sigmoidf_(gav[3]);
            const uint2 pk = pw[ni][q];
            f32x4 o;
            o[0] = __uint_as_float(pk.x << 16) + gav[0] * acc[mi][2 * hf + ni][4 * q + 0];
            o[1] = __uint_as_float(pk.x & 0xffff0000u) + gav[1] * acc[mi][2 * hf + ni][4 * q + 1];
            o[2] = __uint_as_float(pk.y << 16) + gav[2] * acc[mi][2 * hf + ni][4 * q + 2];
            o[3] = __uint_as_float(pk.y & 0xffff0000u) + gav[3] * acc[mi][2 * hf + ni][4 * q + 3];
            *(uint2*)(MG + blkfast(tm, 32, tn * 8 + wn * 4 + 2 * hf + ni, (wm * 64 + mi * 32 + (le & 31)) * 32 + 8 * q + 4 * (le >> 5))) = pack4(o);
          }
        asm volatile("" ::: "memory");
        }
      }
    } else for (int v = sk_first(); v < 64; v += gridDim.x) {
      {
      const int c0 = v * 16;
      auto xs = [&](int m, int kc) { return YS + (((size_t)128 * 16 + (kc >> 2)) * 128 + m) * 32 + (kc & 3) * 8; };
      auto ws_ = [&](int n, int kc) { return wblk(Wbs, 16, c0 + n, kc); };
      auto xa = [&](int m, int kc) { return YA + (((size_t)128 * 32 + (kc >> 2)) * 128 + m) * 32 + (kc & 3) * 8; };
      auto wa = [&](int n, int kc) { return wblk(Wba, 32, c0 + n, kc); };
      const f32x4 a1 = skinny_acc(xs, ws_, 16, lds, tid);
      const f32x4 a2 = skinny_acc(xa, wa, 32, lds, tid);
      if (wave == 0) {
        const int row = lane & 15, col = c0 + 4 * (lane >> 4);
        f32x4 gsv = ld4bf(GS + (size_t)row * D + col), gav = ld4bf(GA + (size_t)row * D + col);
#pragma unroll
        for (int j = 0; j < 4; ++j) { gsv[j] = sigmoidf_(gsv[j]); gav[j] = sigmoidf_(gav[j]); }
        f32x4 o;
#pragma unroll
        for (int j = 0; j < 4; ++j) o[j] = gsv[j] * a1[j] + gav[j] * a2[j];
        *(uint2*)(MG + blkidx(row, col, 32)) = pack4(o);
      }
      }
    }
  }
}

__device__ __forceinline__ void phase_final(const Params& p, int tid) {
  const float* h = (const float*)(p.ws + OFF_H);
  const int lane = tid & 63, wave = tid >> 6;
  for (int r = blockIdx.x * 4 + wave; r < NX; r += gridDim.x * 4) {
    const float rs = row_rstd(p, 12, r + 16);
#pragma unroll
    for (int i = 0; i < 4; ++i) {
      const int c = i * 256 + lane * 4;
      f32x4 v = *(const f32x4*)(h + (size_t)(r + 16) * D + c);
      const f32x4 g = *(const f32x4*)(p.final_norm + c);
      v = v * rs * g;
      *(f32x4*)(p.out + (size_t)r * D + c) = v;
    }
  }
}

#define XB_XCNT(j) (64 * (j))
#define XB_XSUB(j) (1024 + 64 * (j))
#define XB_TOP 2048
#define XB_PLAIN 2112
#define XB_WORDS 2176
struct GridBar { unsigned* bar; unsigned xcc, nloc, nx, gen; };
__device__ __forceinline__ unsigned xb_ld(unsigned* q) { return __hip_atomic_load(q, __ATOMIC_RELAXED, __HIP_MEMORY_SCOPE_AGENT); }
__device__ __forceinline__ void grid_bar_setup(GridBar& gb, unsigned* bar, int tid) {
  gb.bar = bar; gb.gen = 0; gb.nloc = 1; gb.nx = 1;
  gb.xcc = (unsigned)__builtin_amdgcn_s_getreg((3 << 11) | 20) & 0xFu;
  if (tid == 0) {
    const unsigned rank = __hip_atomic_fetch_add(&bar[XB_XCNT(gb.xcc)], 1u, __ATOMIC_RELAXED, __HIP_MEMORY_SCOPE_AGENT);
    __hip_atomic_fetch_add(&bar[XB_PLAIN], 1u, __ATOMIC_RELAXED, __HIP_MEMORY_SCOPE_AGENT);
    while (xb_ld(&bar[XB_PLAIN]) < gridDim.x) __builtin_amdgcn_s_sleep(2);
    unsigned nx = 0; bool even = (gridDim.x & 7u) == 0u;
    for (int j = 0; j < 16; ++j) { const unsigned c = xb_ld(&bar[XB_XCNT(j)]); nx += c != 0u; if (j < 8 ? c != (gridDim.x >> 3) : c != 0u) even = false; }
    s_nx = nx; s_nloc = xb_ld(&bar[XB_XCNT(gb.xcc)]);
    s_vb = even ? (int)(rank * 8u + gb.xcc) : (int)blockIdx.x;
  }
  __syncthreads();
}
__device__ __forceinline__ void grid_bar(GridBar& gb, int tid) {
  asm volatile("s_waitcnt vmcnt(0) lgkmcnt(0)" ::: "memory");
  __syncthreads();
  gb.gen += 1;
  if (tid == 0) {
    const unsigned old = __hip_atomic_fetch_add(&gb.bar[XB_XSUB(gb.xcc)], 1u, __ATOMIC_RELAXED, __HIP_MEMORY_SCOPE_AGENT);
    if (old + 1 == s_nloc * gb.gen) {
      __builtin_amdgcn_fence(__ATOMIC_RELEASE, "agent");
      asm volatile("s_waitcnt vmcnt(0)" ::: "memory");
      __hip_atomic_fetch_add(&gb.bar[XB_TOP], 1u, __ATOMIC_RELAXED, __HIP_MEMORY_SCOPE_AGENT);
    }
    const unsigned target = s_nx * gb.gen;
    while (xb_ld(&gb.bar[XB_TOP]) < target) __builtin_amdgcn_s_sleep(1);
    __builtin_amdgcn_fence(__ATOMIC_ACQUIRE, "agent");
    asm volatile("s_waitcnt vmcnt(0)" ::: "memory");
  }
  __syncthreads();
}

__device__ __forceinline__ int lane_id_now() { int l; asm volatile("v_mbcnt_lo_u32_b32 %0, -1, 0\n\tv_mbcnt_hi_u32_b32 %0, -1, %0" : "=v"(l)); return l; }
__global__ void __launch_bounds__(256, 2) fwd_megakernel(Params p) {
  cg::grid_group grid = cg::this_grid();
  __shared__ __attribute__((aligned(16))) char lds[3 * 24576 + 1024];
  const int wave_s = __builtin_amdgcn_readfirstlane((int)threadIdx.x >> 6);
#define MYTID() (wave_s * 64 + lane_id_now())
    const bf16_t* hb = (const bf16_t*)(p.ws + OFF_HB);
  GridBar gb;
  grid.sync();
  grid_bar_setup(gb, (unsigned*)(p.ws + OFF_BAR), MYTID());
  phase_init(p, MYTID());
  grid_bar(gb, MYTID());
  for (int l = 0; l < 4; ++l) {
#pragma nounroll
    for (int step0 = 0; step0 < 12 + PROBE_EXTRA; ++step0) {
      const int step = step0 < 12 ? step0 : PROBE_STEP;
      if (PROBE_STEP < 0 && step0 >= 12) { grid_bar(gb, MYTID()); continue; }
      int tid = MYTID(); asm volatile("" : "+v"(tid));
      if (step == 0) {}
      else if (step == 1 || step == 10) phase_ffn_up(p, (const bf16_t*)(p.ws + OFF_W + (step == 1 ? W_GU1 : W_GU2)), 3 * l + (step == 1 ? 0 : 2), lds, tid);
      else if (step == 2 || step == 9 || step == 11) {
        const bf16_t* A = (const bf16_t*)(p.ws + (step == 9 ? OFF_Q : OFF_ACT));
        const int K = step == 9 ? D : DFF;
        const bf16_t* Wt = (const bf16_t*)(p.ws + OFF_W + (step == 2 ? W_D1 : (step == 9 ? W_O : W_D2)));
        const int sn = 3 * l + (step == 2 ? 1 : (step == 9 ? 2 : 3));
        phase_resid(p, A, K, Wt, sn, lds, tid);
      }
      else if (step == 3) phase_win(p, 3 * l + 1, lds, tid);
      else if (step == 4) phase_attn_xend(p, l, lds, tid);
      else if (step == 5) phase_scan(p, l, tid);
      else if (step == 6) phase_ssm_out(p, l, lds, tid);
      else if (step == 7) phase_glu(p, lds, tid);
      else phase_merge(p, lds, tid);
      {
        int pl = l, pb = 0, pe = 0, skip = 0;
        if (step == 0) { pb = l == 0 ? 0 : 3136; pe = l == 0 ? 10560 : 5952; }
        else if (step == 5 && l < 3) { pl = l + 1; pb = 0; pe = 3136; skip = 16; }
        else if (step == 7 && l < 3) { pl = l + 1; pb = 5952; pe = 10560; }
        if (pe > pb) phase_prep(p, pl, pb, pe, skip, lds, tid);
      }
      grid_bar(gb, MYTID());
#ifdef DBG_STEPS
      if (l * 12 + step + 1 == DBG_STEPS) {
        const int gt = blockIdx.x * 256 + MYTID();
#if DBG_MODE == 0
        const float* hsrc = (const float*)(p.ws + OFF_H);
        for (int i = gt; i < NX * D; i += gridDim.x * 256) p.out[i] = hsrc[i + 16 * D];
#else
        const bf16_t* bsrc = (const bf16_t*)(p.ws + DBG_BUF);
        for (int i = gt; i < NX * D; i += gridDim.x * 256) p.out[i] = bf2f(bsrc[i % DBG_N]);
#endif
        return;
      }
#endif
    }
  }
  (void)hb;
  phase_final(p, MYTID());
}

extern "C" void kernel_launch(void* const* d_in, const int* in_sizes, int n_in, void* d_out, int out_size, void* d_ws, size_t ws_size,
                              hipStream_t stream) {
  static int grid_blocks = 0;
  if (!grid_blocks) {
    int dev = 0, cus = 0, per_cu = 0;
    (void)hipGetDevice(&dev);
    (void)hipDeviceGetAttribute(&cus, hipDeviceAttributeMultiprocessorCount, dev);
    (void)hipOccupancyMaxActiveBlocksPerMultiprocessor(&per_cu, fwd_megakernel, 256, 0);
    if (per_cu > 2) per_cu = 2;
    if (per_cu < 1) per_cu = 1;
    grid_blocks = cus * per_cu;
  }
  if (ws_size < WS_TOTAL) { fprintf(stderr, "workspace too small: %zu < %zu\n", ws_size, (size_t)WS_TOTAL); return; }
  Params p{};
  const float* const* in = (const float* const*)d_in;
  p.x = in[0]; p.meta = in[1]; p.ffn1_norm = in[2]; p.ffn1_wg = in[3]; p.ffn1_wu = in[4]; p.ffn1_wd = in[5];
  p.mix_norm = in[6]; p.w_in = in[7]; p.lam_re = in[8]; p.lam_im = in[9]; p.log_dt = in[10];
  p.b_re = in[11]; p.b_im = in[12]; p.c_re = in[13]; p.c_im = in[14]; p.ssm_d = in[15]; p.w_glu = in[16];
  p.sink = in[17]; p.w_bs = in[18]; p.w_ba = in[19]; p.w_out = in[20]; p.ffn2_norm = in[21];
  p.ffn2_wg = in[22]; p.ffn2_wu = in[23]; p.ffn2_wd = in[24]; p.final_norm = in[25];
  p.out = (float*)d_out; p.ws = (char*)d_ws;
  void* args[] = {&p};
  (void)hipMemsetAsync((char*)d_ws + OFF_BAR, 0, 16384, stream);
  hipError_t e = hipLaunchCooperativeKernel((void*)fwd_megakernel, dim3(grid_blocks), dim3(256), args, 0, stream);
  if (e != hipSuccess) fprintf(stderr, "cooperative launch failed: %s (grid %d)\n", hipGetErrorString(e), grid_blocks);
}
```

```cpp
#ifndef PROBE_EXTRA
#define PROBE_EXTRA 0
#define PROBE_STEP 0
#endif
#include <hip/hip_runtime.h>
#include <hip/hip_cooperative_groups.h>
#include <cstdio>
#include <cstdint>
namespace cg = cooperative_groups;

typedef unsigned short bf16_t;
typedef short bf16x8 __attribute__((ext_vector_type(8)));
typedef float f32x16 __attribute__((ext_vector_type(16)));
typedef float f32x4 __attribute__((ext_vector_type(4)));

constexpr int L = 16400, NX = 16384, D = 1024, DFF = 2816;
constexpr int NG = 32, NP = 64;
constexpr int NCH = 257, LU = NCH * 64;
constexpr int LV = 16640;
constexpr int PADK = 64;
constexpr int LDH = D + PADK;
constexpr int LS = 16512;
constexpr int LZ = 16400;

constexpr size_t AL(size_t x) { return (x + 255) & ~(size_t)255; }
constexpr size_t OFF_H = 0;
constexpr size_t OFF_HB = OFF_H + AL((size_t)L * D * 4);
constexpr size_t OFF_SSQ = OFF_HB + AL((size_t)L * LDH * 2);
constexpr size_t OFF_SSK = OFF_SSQ + AL((size_t)13 * 16 * LS * 4);
constexpr size_t OFF_ACT = OFF_SSK + AL((size_t)13 * 64 * 16 * 4);
constexpr size_t OFF_Q = OFF_ACT;
constexpr size_t OFF_GS = OFF_Q + AL((size_t)129 * 128 * D * 2);
constexpr size_t OFF_K = OFF_GS + AL((size_t)L * D * 2);
constexpr size_t OFF_VT = OFF_K + AL((size_t)L * 256 * 2);
constexpr size_t OFF_VT_END = OFF_VT + AL((size_t)256 * LV * 2);
constexpr size_t OFF_GA = OFF_ACT + AL((size_t)129 * 128 * DFF * 2);
static_assert(OFF_VT_END <= OFF_GA, "alias overflow");
constexpr size_t OFF_YA = OFF_GA + AL((size_t)L * D * 2);
constexpr size_t OFF_UG = OFF_YA + AL((size_t)129 * 128 * D * 2) + 65536;
constexpr size_t OFF_Z = OFF_UG + AL((size_t)NG * LU * 16 * 2);
constexpr size_t OFF_YS = OFF_Z + AL((size_t)L * 512 * 2);
constexpr size_t OFF_XEND = OFF_YS + AL((size_t)129 * 128 * 512 * 2);
constexpr size_t OFF_XIN = OFF_XEND + AL((size_t)NG * NCH * 256 * 4);
constexpr size_t OFF_W = OFF_XIN + AL((size_t)NG * NCH * 256 * 2);
constexpr size_t W_GU1 = 0;
constexpr size_t W_D1 = W_GU1 + (size_t)2 * DFF * (D + PADK) * 2;
constexpr size_t W_IN = W_D1 + (size_t)D * (DFF + PADK) * 2;
constexpr size_t W_GLU = W_IN + (size_t)4096 * (D + PADK) * 2;
constexpr size_t W_BS = W_GLU + (size_t)512 * (512 + PADK) * 2;
constexpr size_t W_BA = W_BS + (size_t)D * (512 + PADK) * 2;
constexpr size_t W_O = W_BA + (size_t)D * (D + PADK) * 2;
constexpr size_t W_GU2 = W_O + (size_t)D * (D + PADK) * 2;
constexpr size_t W_D2 = W_GU2 + (size_t)2 * DFF * (D + PADK) * 2;
constexpr size_t W_TOTAL = W_D2 + (size_t)D * (DFF + PADK) * 2;
constexpr size_t OFF_KTAB = OFF_W + AL(W_TOTAL);
constexpr size_t OFF_WEND = OFF_KTAB + AL((size_t)NG * 127 * 256 * 2);
constexpr size_t OFF_MCAR = OFF_WEND + AL((size_t)NG * 256 * 1024 * 2);
constexpr size_t OFF_LP = OFF_MCAR + AL((size_t)NG * 1024 * 256 * 2);
constexpr size_t OFF_BB = OFF_LP + AL((size_t)4 * 2 * NG * NP * 65 * 8);
constexpr size_t OFF_BAR = OFF_BB + AL((size_t)4 * 2 * NG * NP * 16 * 8);
constexpr size_t WS_TOTAL = OFF_BAR + 16384;

struct Params {
  const float* x; const float* meta; const float* ffn1_norm; const float* ffn1_wg; const float* ffn1_wu; const float* ffn1_wd;
  const float* mix_norm; const float* w_in; const float* lam_re; const float* lam_im; const float* log_dt;
  const float* b_re; const float* b_im; const float* c_re; const float* c_im; const float* ssm_d; const float* w_glu;
  const float* sink; const float* w_bs; const float* w_ba; const float* w_out; const float* ffn2_norm;
  const float* ffn2_wg; const float* ffn2_wu; const float* ffn2_wd; const float* final_norm;
  float* out; char* ws;
};

#define LAUNDER_LANE() do { le = lane; asm volatile("" : "+v"(le)); } while (0)
__device__ __forceinline__ const bf16_t* wblk(const bf16_t* W, int nkt, int R, int kc) { return W + (((size_t)(R >> 8) * nkt + (kc >> 2)) * 256 + (R & 255)) * 32 + (kc & 3) * 8; }
__device__ __forceinline__ size_t hbidx(int row, int col) {
  const int rr = row - 16; const int tmx = row < 16 ? 128 : (rr >> 7), r = row < 16 ? row : (rr & 127);
  return (((size_t)tmx * 32 + (col >> 5)) * 128 + r) * 32 + (col & 31);
}
__device__ __forceinline__ size_t blkidx(int row, int col, int nkt) {
  const int rr = row - 16; const int tmx = row < 16 ? 128 : (rr >> 7), r = row < 16 ? row : (rr & 127);
  return (((size_t)tmx * nkt + (col >> 5)) * 128 + r) * 32 + (col & 31);
}
__device__ __forceinline__ size_t blkfast(int tm, int nkt, int cb, int rl) { return ((size_t)tm * nkt + cb) * 4096 + rl; }
__device__ __forceinline__ unsigned cvt_pk_bf16(float lo, float hi) { unsigned r; asm volatile("v_cvt_pk_bf16_f32 %0, %1, %2" : "=v"(r) : "v"(lo), "v"(hi)); return r; }
__device__ __forceinline__ float bf2f(bf16_t v) { return __uint_as_float(((unsigned)v) << 16); }
__device__ __forceinline__ float sigmoidf_(float v) { return __builtin_amdgcn_rcpf(1.0f + __expf(-v)); }
__device__ __forceinline__ float gelu_tanh(float x) { const float u = 1.5957691216f * (x + 0.044715f * x * x * x); return x * sigmoidf_(u); }
__device__ __forceinline__ int lds_off(int row, int ch) { return row * 128 + ((ch ^ ((row >> 1) & 7)) << 4); }
__device__ __forceinline__ uint2 pack4(f32x4 v) { uint2 r; r.x = cvt_pk_bf16(v[0], v[1]); r.y = cvt_pk_bf16(v[2], v[3]); return r; }

__device__ __forceinline__ float row_rstd(const Params& p, int si, int row) {
  float s = 0.f;
  if (row >= 16) {
    const float* q = (const float*)(p.ws + OFF_SSQ) + (size_t)si * 16 * LS + row + 16;
#pragma unroll
    for (int i = 0; i < 16; ++i) s += q[(size_t)i * LS];
  } else {
    const float* q = (const float*)(p.ws + OFF_SSK) + (size_t)si * 64 * 16 + row;
    for (int i = 0; i < 64; ++i) s += q[i * 16];
  }
  return rsqrtf(s * (1.f / 1024.f) + 1e-6f);
}
__device__ __forceinline__ float* ssq_slot(const Params& p, int si, int slot, int row) { return (float*)(p.ws + OFF_SSQ) + ((size_t)si * 16 + slot) * LS + row + 16; }
__device__ __forceinline__ float* ssk_slot(const Params& p, int si, int slot, int row) { return (float*)(p.ws + OFF_SSK) + ((size_t)si * 64 + slot) * 16 + row; }

#define GSTAGE 24576
typedef __attribute__((address_space(3))) void* lds_ptr_t;
typedef const __attribute__((address_space(1))) void* glb_ptr_t;
typedef int i32x4 __attribute__((ext_vector_type(4)));
#define GDMA(stagebase) do { char* _d = (stagebase) + tid * 16; \
    __builtin_amdgcn_global_load_lds((glb_ptr_t)(xp), (lds_ptr_t)(_d), 16, 0, 0); \
    __builtin_amdgcn_global_load_lds((glb_ptr_t)(xp + (size_t)64 * xld), (lds_ptr_t)(_d + 4096), 16, 0, 0); \
    __builtin_amdgcn_global_load_lds((glb_ptr_t)(wp), (lds_ptr_t)(_d + 8192), 16, 0, 0); \
    __builtin_amdgcn_global_load_lds((glb_ptr_t)(wp + (size_t)64 * wld), (lds_ptr_t)(_d + 12288), 16, 0, 0); \
    __builtin_amdgcn_global_load_lds((glb_ptr_t)(wp + (size_t)128 * wld), (lds_ptr_t)(_d + 16384), 16, 0, 0); \
    __builtin_amdgcn_global_load_lds((glb_ptr_t)(wp + (size_t)192 * wld), (lds_ptr_t)(_d + 20480), 16, 0, 0); } while (0)
__device__ __forceinline__ void gemm_acc(f32x16 (&acc)[2][4], const bf16_t* xp, int xld, int xks, const bf16_t* wp, int wld, int wks,
                                         int nkt, char* lds, int tid) {
  const int lane = tid & 63, wave = tid >> 6, wm = wave >> 1, wn = wave & 1;
  __syncthreads();
  GDMA(lds);
  if (nkt > 1) { xp += xks; wp += wks; GDMA(lds + GSTAGE); asm volatile("s_waitcnt vmcnt(6)" ::: "memory"); }
  else asm volatile("s_waitcnt vmcnt(0)" ::: "memory");
  __builtin_amdgcn_s_barrier();
  const int r31 = lane & 31, hh = lane >> 5, swz = (r31 >> 2) & 3;
  const unsigned lbase = (unsigned)(size_t)lds;
  const unsigned ax0 = lbase + wm * 4096 + r31 * 64 + (((0 + hh) ^ swz) << 4), ax1 = lbase + wm * 4096 + r31 * 64 + (((2 + hh) ^ swz) << 4);
  const unsigned aw0 = ax0 - wm * 4096 + 8192 + wn * 8192, aw1 = ax1 - wm * 4096 + 8192 + wn * 8192;
#define MMA8(x0, x1, w0, w1, w2, w3) do { \
    const bf16x8 xf0 = __builtin_bit_cast(bf16x8, x0), xf1 = __builtin_bit_cast(bf16x8, x1), wf0 = __builtin_bit_cast(bf16x8, w0), \
                 wf1 = __builtin_bit_cast(bf16x8, w1), wf2 = __builtin_bit_cast(bf16x8, w2), wf3 = __builtin_bit_cast(bf16x8, w3); \
    __builtin_amdgcn_s_setprio(1); \
    acc[0][0] = __builtin_amdgcn_mfma_f32_32x32x16_bf16(wf0, xf0, acc[0][0], 0, 0, 0); \
    acc[0][1] = __builtin_amdgcn_mfma_f32_32x32x16_bf16(wf1, xf0, acc[0][1], 0, 0, 0); \
    acc[0][2] = __builtin_amdgcn_mfma_f32_32x32x16_bf16(wf2, xf0, acc[0][2], 0, 0, 0); \
    acc[0][3] = __builtin_amdgcn_mfma_f32_32x32x16_bf16(wf3, xf0, acc[0][3], 0, 0, 0); \
    acc[1][0] = __builtin_amdgcn_mfma_f32_32x32x16_bf16(wf0, xf1, acc[1][0], 0, 0, 0); \
    acc[1][1] = __builtin_amdgcn_mfma_f32_32x32x16_bf16(wf1, xf1, acc[1][1], 0, 0, 0); \
    acc[1][2] = __builtin_amdgcn_mfma_f32_32x32x16_bf16(wf2, xf1, acc[1][2], 0, 0, 0); \
    acc[1][3] = __builtin_amdgcn_mfma_f32_32x32x16_bf16(wf3, xf1, acc[1][3], 0, 0, 0); \
    __builtin_amdgcn_s_setprio(0); } while (0)
#define KTILE() do { i32x4 x0, x1, w0, w1, w2, w3, y0, y1, v0, v1, v2, v3; \
    asm volatile("ds_read_b128 %0, %12\n\tds_read_b128 %1, %12 offset:2048\n\tds_read_b128 %2, %13\n\tds_read_b128 %3, %13 offset:2048\n\t" \
                 "ds_read_b128 %4, %13 offset:4096\n\tds_read_b128 %5, %13 offset:6144\n\t" \
                 "ds_read_b128 %6, %14\n\tds_read_b128 %7, %14 offset:2048\n\tds_read_b128 %8, %15\n\tds_read_b128 %9, %15 offset:2048\n\t" \
                 "ds_read_b128 %10, %15 offset:4096\n\tds_read_b128 %11, %15 offset:6144\n\ts_waitcnt lgkmcnt(6)" \
                 : "=&v"(x0), "=&v"(x1), "=&v"(w0), "=&v"(w1), "=&v"(w2), "=&v"(w3), "=&v"(y0), "=&v"(y1), "=&v"(v0), "=&v"(v1), "=&v"(v2), "=&v"(v3) \
                 : "v"(ax0 + soff), "v"(aw0 + soff), "v"(ax1 + soff), "v"(aw1 + soff) : "memory"); \
    MMA8(x0, x1, w0, w1, w2, w3); \
    asm volatile("s_waitcnt lgkmcnt(0)" : "+v"(y0), "+v"(y1), "+v"(v0), "+v"(v1), "+v"(v2), "+v"(v3) :: "memory"); \
    MMA8(y0, y1, v0, v1, v2, v3); } while (0)
  int st = 0;
#pragma unroll 1
  for (int kt = 0; kt < nkt; ++kt) {
    const unsigned soff = (unsigned)st * GSTAGE;
    const bool more2 = kt + 2 < nkt;
    if (more2) { xp += xks; wp += wks; const int s2 = st >= 1 ? st - 1 : 2; GDMA(lds + s2 * GSTAGE); }
    KTILE();
    if (more2) asm volatile("s_waitcnt vmcnt(6)" ::: "memory");
    else asm volatile("s_waitcnt vmcnt(0)" ::: "memory");
    __builtin_amdgcn_s_barrier();
    st = st == 2 ? 0 : st + 1;
  }
#undef KTILE
#undef MMA8
  __syncthreads();
}
__device__ __forceinline__ void zero_acc(f32x16 (&acc)[2][4]) {
#pragma unroll
  for (int a = 0; a < 2; ++a)
#pragma unroll
    for (int b = 0; b < 4; ++b)
#pragma unroll
      for (int r = 0; r < 16; ++r) acc[a][b][r] = 0.f;
}

template <class XA, class WA>
__device__ __forceinline__ f32x4 skinny_acc(XA xaddr, WA waddr, int nk32, char* lds, int tid) {
  int lane = tid & 63; const int wave = tid >> 6;
  asm volatile("" : "+v"(lane));
  const int per = nk32 >> 2;
  f32x4 acc = {0.f, 0.f, 0.f, 0.f};
  const int e = (wave + 1) * per;
  for (int s = wave * per; s < e; s += 8) {
    bf16x8 a0, a1, a2, a3, a4, a5, a6, a7, b0, b1, b2, b3, b4, b5, b6, b7;
#define SKL(j) { const int ss = (s + j < e) ? s + j : e - 1; const int kc = ss * 4 + (lane >> 4); a##j = *(const bf16x8*)waddr(lane & 15, kc); b##j = *(const bf16x8*)xaddr(lane & 15, kc); }
    SKL(0) SKL(1) SKL(2) SKL(3) SKL(4) SKL(5) SKL(6) SKL(7)
#undef SKL
#define SKM(j) if (s + j < e) acc = __builtin_amdgcn_mfma_f32_16x16x32_bf16(a##j, b##j, acc, 0, 0, 0);
    SKM(0) SKM(1) SKM(2) SKM(3) SKM(4) SKM(5) SKM(6) SKM(7)
#undef SKM
  }
  __syncthreads();
  f32x4* red = (f32x4*)lds;
  red[wave * 64 + lane] = acc;
  __syncthreads();
  if (wave == 0) acc = red[lane] + red[64 + lane] + red[128 + lane] + red[192 + lane];
  return acc;
}

__shared__ int s_unit;
__shared__ unsigned s_nx, s_nloc;
__shared__ int s_vb;
__device__ __forceinline__ bool tile_of(int it, int nN, int& tm, int& tn) {
  const int G = gridDim.x, b = s_vb;
  const int x = b & 7, j = b >> 3, tmPer = G >> 4;
  const int ptm = j % tmPer, ptn = j / tmPer;
  const int npn = nN >> 1, pi = it * 8 + x;
  tm = (pi / npn) * tmPer + ptm; tn = (pi % npn) * 2 + ptn;
  return tm < 128;
}
__device__ __forceinline__ int sk_first() { const int b = s_vb; return (7 - (b & 7)) * ((int)gridDim.x >> 3) + (b >> 3); }
__device__ __forceinline__ int tile_iters(int nN) { const int npatch = (128 / (gridDim.x >> 4)) * (nN >> 1); return (npatch + 7) >> 3; }

__device__ __forceinline__ void phase_init(const Params& p, int tid) {
  float* h = (float*)(p.ws + OFF_H); bf16_t* hb = (bf16_t*)(p.ws + OFF_HB);
  const int lane = tid & 63, wave = tid >> 6;
  const int gthreads = gridDim.x * 256, gtid = blockIdx.x * 256 + tid;
  for (int r0 = (int)blockIdx.x * 32 - 16; r0 < L; r0 += gridDim.x * 32)
  for (int r = r0 + wave; r < r0 + 32 && r < L; r += 4) {
    if (r < 0) continue;
    const float* src = r < 16 ? p.meta + (size_t)r * D : p.x + (size_t)(r - 16) * D;
    float ss = 0.f;
#pragma unroll
    for (int i = 0; i < 4; ++i) {
      const int c = i * 256 + lane * 4;
      const f32x4 v = *(const f32x4*)(src + c);
      *(f32x4*)(h + (size_t)r * D + c) = v;
      *(uint2*)(hb + hbidx(r, c)) = pack4(v);
      ss += v[0] * v[0] + v[1] * v[1] + v[2] * v[2] + v[3] * v[3];
    }
#pragma unroll
    for (int o = 32; o >= 1; o >>= 1) ss += __shfl_xor(ss, o);
    if (r >= 16) { if (lane < 16) *ssq_slot(p, 0, lane, r) = lane == 0 ? ss : 0.f; }
    else *ssk_slot(p, 0, lane, r) = lane == 0 ? ss : 0.f;
  }
  { bf16_t* ug = (bf16_t*)(p.ws + OFF_UG);
    for (int i = gtid; i < NG * 48 * 16 / 2; i += gthreads) { const int g = i / 384, w = i - g * 384; *(unsigned*)(ug + (size_t)g * LU * 16 + w * 2) = 0u; } }
  float2* LP = (float2*)(p.ws + OFF_LP); float2* BB = (float2*)(p.ws + OFF_BB);
  for (int i = gtid; i < 4 * 2 * NG * NP * 65; i += gthreads) {
    const int j = i % 65, q = i / 65;
    const float lre = p.lam_re[q], lim = p.lam_im[q];
    const float dt = expf(p.log_dt[q >> 6]);
    const float a = lre * dt;
    double ang = (double)j * ((double)lim * (double)dt);
    ang -= 6.283185307179586477 * rint(ang * 0.15915494309189533577);
    const float ra = (float)ang;
    const float mag = expf((float)j * a);
    LP[i] = make_float2(mag * cosf(ra), mag * sinf(ra));
  }
  for (int i = gtid; i < 4 * 2 * NG * NP * 16; i += gthreads) {
    const int q = i >> 4;
    const float lre = p.lam_re[q], lim = p.lam_im[q];
    const float dt = expf(p.log_dt[q >> 6]);
    const float a = lre * dt, b = lim * dt;
    const float sh = sinf(0.5f * b);
    const float nr = expm1f(a) * cosf(b) - 2.f * sh * sh, ni = expf(a) * sinf(b);
    const float den = 1.f / (lre * lre + lim * lim);
    const float cr = (nr * lre + ni * lim) * den, ci = (ni * lre - nr * lim) * den;
    const float br = p.b_re[i], bi = p.b_im[i];
    BB[i] = make_float2(cr * br - ci * bi, cr * bi + ci * br);
  }
}

__device__ __forceinline__ void phase_prep(const Params& p, int l, int ubeg, int uend, int bskip, char* lds, int tid) {
  char* W = p.ws + OFF_W;
  float* ldsf = (float*)lds;
  const float2* LP = (const float2*)(p.ws + OFF_LP) + (size_t)l * 2 * NG * NP * 65;
  const float2* BB = (const float2*)(p.ws + OFF_BB) + (size_t)l * 2 * NG * NP * 16;
  const float* Cre = p.c_re + (size_t)l * 2 * NG * 16 * NP; const float* Cim = p.c_im + (size_t)l * 2 * NG * 16 * NP;
  bf16_t* Ktab = (bf16_t*)(p.ws + OFF_KTAB); bf16_t* Wend = (bf16_t*)(p.ws + OFF_WEND); bf16_t* Mcar = (bf16_t*)(p.ws + OFF_MCAR);
  if ((int)blockIdx.x < bskip) return;
  for (int u = ubeg + (int)blockIdx.x - bskip; u < uend; u += (int)gridDim.x - bskip) {
    if (u < 5952) {
      const float* src; bf16_t* dst; int K, N; const float* rs = nullptr; float sc = 1.f; int perm = 0; int t;
      if (u < 704) { t = u; src = p.ffn1_wg + (size_t)l * D * DFF; dst = (bf16_t*)(W + W_GU1); K = D; N = DFF; rs = p.ffn1_norm + l * D; perm = 1; }
      else if (u < 1408) { t = u - 704; src = p.ffn1_wu + (size_t)l * D * DFF; dst = (bf16_t*)(W + W_GU1); K = D; N = DFF; rs = p.ffn1_norm + l * D; perm = 2; }
      else if (u < 2112) { t = u - 1408; src = p.ffn1_wd + (size_t)l * D * DFF; dst = (bf16_t*)(W + W_D1); K = DFF; N = D; sc = 0.5f; }
      else if (u < 3136) { t = u - 2112; src = p.w_in + (size_t)l * D * 4096; dst = (bf16_t*)(W + W_IN); K = D; N = 4096; rs = p.mix_norm + l * D; }
      else if (u < 3200) { t = u - 3136; src = p.w_glu + (size_t)l * 512 * 512; dst = (bf16_t*)(W + W_GLU); K = 512; N = 512; }
      else if (u < 3328) { t = u - 3200; src = p.w_bs + (size_t)l * 512 * D; dst = (bf16_t*)(W + W_BS); K = 512; N = D; }
      else if (u < 3584) { t = u - 3328; src = p.w_ba + (size_t)l * D * D; dst = (bf16_t*)(W + W_BA); K = D; N = D; }
      else if (u < 3840) { t = u - 3584; src = p.w_out + (size_t)l * D * D; dst = (bf16_t*)(W + W_O); K = D; N = D; }
      else if (u < 4544) { t = u - 3840; src = p.ffn2_wg + (size_t)l * D * DFF; dst = (bf16_t*)(W + W_GU2); K = D; N = DFF; rs = p.ffn2_norm + l * D; perm = 1; }
      else if (u < 5248) { t = u - 4544; src = p.ffn2_wu + (size_t)l * D * DFF; dst = (bf16_t*)(W + W_GU2); K = D; N = DFF; rs = p.ffn2_norm + l * D; perm = 2; }
      else { t = u - 5248; src = p.ffn2_wd + (size_t)l * D * DFF; dst = (bf16_t*)(W + W_D2); K = DFF; N = D; sc = 0.5f; }
      const int nkt = K >> 6; const int kt = t % nkt, nt = t / nkt;
      __syncthreads();
      f32x4 tv[4]; float tsc[4];
#pragma unroll
      for (int i = 0; i < 4; ++i) {
        const int idx = tid + 256 * i, kk = idx >> 4, n4 = idx & 15;
        tv[i] = *(const f32x4*)(src + (size_t)(kt * 64 + kk) * N + nt * 64 + n4 * 4);
        tsc[i] = rs ? rs[kt * 64 + kk] * sc : sc;
      }
#pragma unroll
      for (int i = 0; i < 4; ++i) {
        const int idx = tid + 256 * i, kk = idx >> 4, n4 = idx & 15;
        float* d4 = ldsf + kk * 65 + n4 * 4;
        d4[0] = tv[i][0] * tsc[i]; d4[1] = tv[i][1] * tsc[i]; d4[2] = tv[i][2] * tsc[i]; d4[3] = tv[i][3] * tsc[i];
      }
      __syncthreads();
      const int n = tid >> 2, kq = tid & 3;
      unsigned w[8];
#pragma unroll
      for (int j = 0; j < 8; ++j) w[j] = cvt_pk_bf16(ldsf[(kq * 16 + 2 * j) * 65 + n], ldsf[(kq * 16 + 2 * j + 1) * 65 + n]);
      int R = nt * 64 + n;
      if (perm) { const int tn = R >> 7, wn = (R >> 6) & 1, pr = (R >> 5) & 1, xx = R & 31; R = tn * 256 + wn * 128 + pr * 64 + xx + (perm == 2 ? 32 : 0); }
      const int k0 = kt * 64 + kq * 16;
      uint4* d = (uint4*)(dst + (((size_t)(R >> 8) * (K >> 5) + (k0 >> 5)) * 256 + (R & 255)) * 32 + (k0 & 31));
      d[0] = make_uint4(w[0], w[1], w[2], w[3]); d[1] = make_uint4(w[4], w[5], w[6], w[7]);
    } else if (u < 6464) {
      const int v = u - 5952, g = v >> 4, dd0 = (v & 15) * 8;
      float2* Cs = (float2*)lds;
      float2* Ws = (float2*)(lds + 16384);
      __syncthreads();
      for (int i = tid; i < 2048; i += 256) { const int dr = i >> 10, c = (i >> 6) & 15, pp = i & 63; const size_t ci = (size_t)((dr * NG + g) * 16 + c) * NP + pp; Cs[i] = make_float2(Cre[ci], Cim[ci]); }
      for (int j = 0; j < 8; ++j) {
        const int dd = dd0 + j; if (dd >= 127) break;
        const int d = dd - 63;
        __syncthreads();
#pragma unroll
        for (int ii = 0; ii < 8; ++ii) {
          const int i = tid + 256 * ii, dr = i >> 10, pp = (i >> 4) & 63, c2 = i & 15;
          const bool need = dr == 0 ? d >= 0 : d <= 0;
          float2 w = make_float2(0.f, 0.f);
          if (need) { const float2 a = LP[((size_t)(dr * NG + g) * NP + pp) * 65 + (d < 0 ? -d : d)], bb = BB[((size_t)(dr * NG + g) * NP + pp) * 16 + c2]; w = make_float2(a.x * bb.x - a.y * bb.y, a.x * bb.y + a.y * bb.x); }
          Ws[i] = w;
        }
        __syncthreads();
        const int c = tid >> 4, c2 = tid & 15;
        float sum = 0.f;
#pragma unroll 8
        for (int i = 0; i < 128; ++i) { const float2 cc = Cs[(i >> 6) * 1024 + c * 64 + (i & 63)], w = Ws[i * 16 + c2]; sum += cc.x * w.x - cc.y * w.y; }
        Ktab[((size_t)g * 127 + dd) * 256 + tid] = (bf16_t)(cvt_pk_bf16(sum, 0.f) & 0xffffu);
      }
    } else if (u < 8512) {
      const int v = u - 6464;
      const size_t e0 = ((size_t)v * 256 + tid) * 16;
      const int kk = (int)(e0 & 1023), pr = (int)((e0 >> 10) & 255), g = (int)(e0 >> 18);
      const int dr = pr >> 7, ri = (pr >> 6) & 1, pp = pr & 63, s = kk >> 4, c0 = kk & 15;
      const float2 a = LP[((size_t)(dr * NG + g) * NP + pp) * 65 + (dr ? s : 63 - s)];
      const float2* bb = BB + ((size_t)(dr * NG + g) * NP + pp) * 16 + c0;
      float o[16];
#pragma unroll
      for (int j = 0; j < 16; ++j) { const float2 b = bb[j]; o[j] = ri ? (a.x * b.y + a.y * b.x) : (a.x * b.x - a.y * b.y); }
      *(uint4*)(Wend + e0) = make_uint4(cvt_pk_bf16(o[0], o[1]), cvt_pk_bf16(o[2], o[3]), cvt_pk_bf16(o[4], o[5]), cvt_pk_bf16(o[6], o[7]));
      *(uint4*)(Wend + e0 + 8) = make_uint4(cvt_pk_bf16(o[8], o[9]), cvt_pk_bf16(o[10], o[11]), cvt_pk_bf16(o[12], o[13]), cvt_pk_bf16(o[14], o[15]));
    } else {
      const int v = u - 8512;
      const size_t e0 = ((size_t)v * 256 + tid) * 16;
      const int pr = (int)(e0 & 255), n = (int)((e0 >> 8) & 1023), g = (int)(e0 >> 18);
      const int dr = pr >> 7, ri = (pr >> 6) & 1, p0 = pr & 63, t = n >> 4, c = n & 15;
      const int e = dr ? 64 - t : t + 1;
      const float* cr = Cre + (size_t)((dr * NG + g) * 16 + c) * NP + p0; const float* ci = Cim + (size_t)((dr * NG + g) * 16 + c) * NP + p0;
      float o[16];
#pragma unroll
      for (int j = 0; j < 16; ++j) { const float2 a = LP[((size_t)(dr * NG + g) * NP + p0 + j) * 65 + e]; o[j] = ri ? -(cr[j] * a.y + ci[j] * a.x) : (cr[j] * a.x - ci[j] * a.y); }
      *(uint4*)(Mcar + e0) = make_uint4(cvt_pk_bf16(o[0], o[1]), cvt_pk_bf16(o[2], o[3]), cvt_pk_bf16(o[4], o[5]), cvt_pk_bf16(o[6], o[7]));
      *(uint4*)(Mcar + e0 + 8) = make_uint4(cvt_pk_bf16(o[8], o[9]), cvt_pk_bf16(o[10], o[11]), cvt_pk_bf16(o[12], o[13]), cvt_pk_bf16(o[14], o[15]));
    }
  }
}

__device__ __forceinline__ void phase_ffn_up(const Params& p, const bf16_t* Wgu, int si, char* lds, int tid) {
  const bf16_t* hb = (const bf16_t*)(p.ws + OFF_HB); bf16_t* act = (bf16_t*)(p.ws + OFF_ACT);
  const int lane = tid & 63, wave = tid >> 6, wm = wave >> 1, wn = wave & 1, lrow = tid >> 2, lch = tid & 3; int le = lane;
  constexpr int nN = 22;
  const int nit = tile_iters(nN);
  for (int it = 0; it < nit + 1; ++it) {
    if (it < nit) {
      int tm, tn; if (!tile_of(it, nN, tm, tn)) continue;
      const int m0 = 16 + tm * 128;
      f32x16 acc[2][4]; zero_acc(acc);
      int tl = tid; asm volatile("" : "+v"(tl));
      const int lrow = tl >> 2, lch = (tl & 3) ^ ((tl >> 4) & 3);
      float* rsl = (float*)(lds + 3 * GSTAGE) + (it & 1) * 128;
      if (tid < 128) rsl[tid] = row_rstd(p, si, m0 + tid);
      gemm_acc(acc, hb + ((size_t)tm * 32 * 128 + lrow) * 32 + lch * 8, 32, 4096, Wgu + ((size_t)tn * 32 * 256 + lrow) * 32 + lch * 8, 32, 8192, 32, lds, tid);
      LAUNDER_LANE();
#pragma unroll
      for (int mi = 0; mi < 2; ++mi) {
        const int row = m0 + wm * 64 + mi * 32 + (le & 31);
        const float rs = rsl[wm * 64 + mi * 32 + (le & 31)];
#pragma unroll
        for (int pr = 0; pr < 2; ++pr)
#pragma unroll
        for (int q = 0; q < 4; ++q) {
          f32x4 o;
#pragma unroll
          for (int j = 0; j < 4; ++j) { const float g = acc[mi][2 * pr][4 * q + j] * rs, uu = acc[mi][2 * pr + 1][4 * q + j] * rs; o[j] = g * sigmoidf_(g) * uu; }
          *(uint2*)(act + blkfast(tm, 88, tn * 4 + wn * 2 + pr, (wm * 64 + mi * 32 + (le & 31)) * 32 + 8 * q + 4 * (le >> 5))) = pack4(o);
        }
      }
    } else for (int v = sk_first(); v < 176; v += gridDim.x) {
      {
      const int c0 = v * 16, tn = c0 >> 7, wnn = (c0 >> 6) & 1, pr = (c0 >> 5) & 1, x0 = c0 & 31;
      const int Rg = tn * 256 + wnn * 128 + pr * 64 + x0;
      auto xa = [&](int m, int kc) { return hb + (((size_t)128 * 32 + (kc >> 2)) * 128 + m) * 32 + (kc & 3) * 8; };
      auto wg = [&](int n, int kc) { return wblk(Wgu, 32, Rg + n, kc); };
      auto wu = [&](int n, int kc) { return wblk(Wgu, 32, Rg + 32 + n, kc); };
      const f32x4 ag = skinny_acc(xa, wg, 32, lds, tid);
      const f32x4 au = skinny_acc(xa, wu, 32, lds, tid);
      if (wave == 0) {
        const int row = lane & 15;
        const float rs = row_rstd(p, si, row);
        f32x4 o;
#pragma unroll
        for (int j = 0; j < 4; ++j) { const float g = ag[j] * rs, uu = au[j] * rs; o[j] = g * sigmoidf_(g) * uu; }
        *(uint2*)(act + blkidx(row, c0 + 4 * (lane >> 4), 88)) = pack4(o);
      }
      }
    }
  }
}

__device__ __forceinline__ void resid_store(float* h, bf16_t* hb, int row, int col, f32x4 a, float& ss) {
  float* hp = h + (size_t)row * D + col;
  f32x4 hv = *(const f32x4*)hp;
  hv += a;
  *(f32x4*)hp = hv;
  *(uint2*)(hb + hbidx(row, col)) = pack4(hv);
  ss += hv[0] * hv[0] + hv[1] * hv[1] + hv[2] * hv[2] + hv[3] * hv[3];
}
__device__ __forceinline__ void phase_resid(const Params& p, const bf16_t* A, int K, const bf16_t* Wt, int si_next, char* lds, int tid) {
  float* h = (float*)(p.ws + OFF_H); bf16_t* hb = (bf16_t*)(p.ws + OFF_HB);
  const int lane = tid & 63, wave = tid >> 6, wm = wave >> 1, wn = wave & 1, lrow = tid >> 2, lch = tid & 3; int le = lane;
  constexpr int nN = 4;
  const int nit = tile_iters(nN);
  for (int it = 0; it < nit + 1; ++it) {
    if (it < nit) {
      int tm, tn; if (!tile_of(it, nN, tm, tn)) continue;
      const int m0 = 16 + tm * 128;
      f32x16 acc[2][4]; zero_acc(acc);
      int tl = tid; asm volatile("" : "+v"(tl));
      const int lrow = tl >> 2, lch = (tl & 3) ^ ((tl >> 4) & 3);
      gemm_acc(acc, A + ((size_t)tm * (K >> 5) * 128 + lrow) * 32 + lch * 8, 32, 4096, Wt + ((size_t)tn * (K >> 5) * 256 + lrow) * 32 + lch * 8, 32, 8192, K >> 5, lds, tid);
      LAUNDER_LANE();
#pragma unroll
      for (int mi = 0; mi < 2; ++mi) {
        const int row = m0 + wm * 64 + mi * 32 + (le & 31);
#pragma unroll
        for (int hf = 0; hf < 2; ++hf) {
        float ss = 0.f;
        f32x4 hv[2][4];
#pragma unroll
        for (int ni = 0; ni < 2; ++ni)
#pragma unroll
          for (int q = 0; q < 4; ++q) {
            hv[ni][q] = *(const f32x4*)(h + (size_t)row * D + tn * 256 + wn * 128 + (2 * hf + ni) * 32 + 8 * q + 4 * (le >> 5));
          }
#pragma unroll
        for (int ni = 0; ni < 2; ++ni)
#pragma unroll
          for (int q = 0; q < 4; ++q) {
            f32x4 a; a[0] = acc[mi][2 * hf + ni][4 * q]; a[1] = acc[mi][2 * hf + ni][4 * q + 1]; a[2] = acc[mi][2 * hf + ni][4 * q + 2]; a[3] = acc[mi][2 * hf + ni][4 * q + 3];
            const int col = tn * 256 + wn * 128 + (2 * hf + ni) * 32 + 8 * q + 4 * (le >> 5);
            const f32x4 hn = hv[ni][q] + a;
            *(f32x4*)(h + (size_t)row * D + col) = hn;
            *(uint2*)(hb + blkfast(tm, 32, tn * 8 + wn * 4 + 2 * hf + ni, (wm * 64 + mi * 32 + (le & 31)) * 32 + 8 * q + 4 * (le >> 5))) = pack4(hn);
            ss += hn[0] * hn[0] + hn[1] * hn[1] + hn[2] * hn[2] + hn[3] * hn[3];
          }
        ss += __shfl_xor(ss, 32);
        if (lane < 32) *ssq_slot(p, si_next, tn * 4 + wn * 2 + hf, row) = ss;
        asm volatile("" ::: "memory");
        }
      }
    } else for (int v = sk_first(); v < 64; v += gridDim.x) {
      {
      const int c0 = v * 16;
      auto xa = [&](int m, int kc) { return A + (((size_t)128 * (K >> 5) + (kc >> 2)) * 128 + m) * 32 + (kc & 3) * 8; };
      auto wa = [&](int n, int kc) { return wblk(Wt, K >> 5, c0 + n, kc); };
      const f32x4 a = skinny_acc(xa, wa, K >> 5, lds, tid);
      if (wave == 0) {
        const int row = lane & 15;
        float ss = 0.f;
        resid_store(h, hb, row, c0 + 4 * (lane >> 4), a, ss);
        ss += __shfl_xor(ss, 16); ss += __shfl_xor(ss, 32);
        if (lane < 16) *ssk_slot(p, si_next, c0 >> 4, row) = ss;
      }
      }
    }
  }
}

template <int SEL>
__device__ __forceinline__ void win_store(const Params& p, int row, int col, f32x4 a, float rs) {
  a *= rs;
  if (SEL == 0) { a *= 0.125f * 1.44269504088896f;     *(uint2*)((bf16_t*)(p.ws + OFF_Q) + (size_t)row * D + col) = pack4(a); }
  else if (SEL == 1) { *(uint2*)((bf16_t*)(p.ws + OFF_K) + (size_t)row * 256 + (col - 1024)) = pack4(a); }
  else if (SEL == 2) {
    bf16_t* vt = (bf16_t*)(p.ws + OFF_VT) + (size_t)(col - 1280) * LV + row + 48;
    const uint2 w = pack4(a);
    vt[0] = (bf16_t)(w.x & 0xffffu); vt[LV] = (bf16_t)(w.x >> 16); vt[2 * LV] = (bf16_t)(w.y & 0xffffu); vt[3 * LV] = (bf16_t)(w.y >> 16);
  } else if (SEL == 3) {
    const int cc = col - 1536, g = cc >> 4, c = cc & 15;
    *(uint2*)((bf16_t*)(p.ws + OFF_UG) + ((size_t)g * LU + row + 48) * 16 + c) = pack4(a);
  } else {
    const f32x4 s = a;
    bf16_t* dst = (bf16_t*)(p.ws + (SEL == 4 ? OFF_GS : OFF_GA)) + (size_t)row * D + (col - (SEL == 4 ? 2048 : 3072));
    *(uint2*)dst = pack4(s);
  }
}
template <int SEL>
__device__ __forceinline__ void win_epi(const Params& p, const f32x16 (&acc)[2][4], const float* rsl, int m0, int tn, int tid) {
  const int lane = tid & 63, wave = tid >> 6, wm = wave >> 1, wn = wave & 1; int le = lane; LAUNDER_LANE();
#pragma unroll
  for (int mi = 0; mi < 2; ++mi) {
    const int row = m0 + wm * 64 + mi * 32 + (le & 31);
    const float rs = rsl[wm * 64 + mi * 32 + (le & 31)];
#pragma unroll
    for (int ni = 0; ni < 4; ++ni)
#pragma unroll
      for (int q = 0; q < 4; ++q) {
        f32x4 a; a[0] = acc[mi][ni][4 * q]; a[1] = acc[mi][ni][4 * q + 1]; a[2] = acc[mi][ni][4 * q + 2]; a[3] = acc[mi][ni][4 * q + 3];
        win_store<SEL>(p, row, tn * 256 + wn * 128 + ni * 32 + 8 * q + 4 * (le >> 5), a, rs);
      }
  }
}
__device__ __forceinline__ int win_sel(int col) { return col < 1024 ? 0 : col < 1280 ? 1 : col < 1536 ? 2 : col < 2048 ? 3 : col < 3072 ? 4 : 5; }
__device__ __forceinline__ void phase_win(const Params& p, int si, char* lds, int tid) {
  const bf16_t* hb = (const bf16_t*)(p.ws + OFF_HB); const bf16_t* Wt = (const bf16_t*)(p.ws + OFF_W + W_IN);
  const int lane = tid & 63, wave = tid >> 6, wm = wave >> 1, wn = wave & 1, lrow = tid >> 2, lch = tid & 3; int le = lane;
  constexpr int nN = 16;
  const int nit = tile_iters(nN);
  for (int it = 0; it < nit + 1; ++it) {
    if (it < nit) {
      int tm, tn; if (!tile_of(it, nN, tm, tn)) continue;
      const int m0 = 16 + tm * 128;
      f32x16 acc[2][4]; zero_acc(acc);
      int tl = tid; asm volatile("" : "+v"(tl));
      const int lrow = tl >> 2, lch = (tl & 3) ^ ((tl >> 4) & 3);
      float* rsl = (float*)(lds + 3 * GSTAGE) + (it & 1) * 128;
      if (tid < 128) rsl[tid] = row_rstd(p, si, m0 + tid);
      gemm_acc(acc, hb + ((size_t)tm * 32 * 128 + lrow) * 32 + lch * 8, 32, 4096, Wt + ((size_t)tn * 32 * 256 + lrow) * 32 + lch * 8, 32, 8192, 32, lds, tid);
      LAUNDER_LANE();
      switch (win_sel(tn * 256)) {
        case 0: win_epi<0>(p, acc, rsl, m0, tn, tid); break;
        case 1: win_epi<1>(p, acc, rsl, m0, tn, tid); break;
        case 2: win_epi<2>(p, acc, rsl, m0, tn, tid); break;
        case 3: win_epi<3>(p, acc, rsl, m0, tn, tid); break;
        case 4: win_epi<4>(p, acc, rsl, m0, tn, tid); break;
        default: win_epi<5>(p, acc, rsl, m0, tn, tid); break;
      }
    } else for (int v = sk_first(); v < 256; v += gridDim.x) {
      {
      const int c0 = v * 16;
      auto xa = [&](int m, int kc) { return hb + (((size_t)128 * 32 + (kc >> 2)) * 128 + m) * 32 + (kc & 3) * 8; };
      auto wa = [&](int n, int kc) { return wblk(Wt, 32, c0 + n, kc); };
      const f32x4 a = skinny_acc(xa, wa, 32, lds, tid);
      if (wave == 0) {
        const int row = lane & 15;
        const float rs = row_rstd(p, si, row);
        const int cc = c0 + 4 * (lane >> 4);
        switch (win_sel(c0)) {
          case 0: win_store<0>(p, row, cc, a, rs); break;
          case 1: win_store<1>(p, row, cc, a, rs); break;
          case 2: win_store<2>(p, row, cc, a, rs); break;
          case 3: win_store<3>(p, row, cc, a, rs); break;
          case 4: win_store<4>(p, row, cc, a, rs); break;
          default: win_store<5>(p, row, cc, a, rs); break;
        }
      }
      }
    }
  }
}

__device__ __forceinline__ void attn_unit(const Params& p, int l, int b, int h, char* lds, int tid) {
  const bf16_t* Q = (const bf16_t*)(p.ws + OFF_Q); const bf16_t* Kb = (const bf16_t*)(p.ws + OFF_K); const bf16_t* VT = (const bf16_t*)(p.ws + OFF_VT);
  bf16_t* YA = (bf16_t*)(p.ws + OFF_YA);
  const int lane = tid & 63, wave = tid >> 6, r31 = lane & 31, hh = lane >> 5;
  const int kv = h >> 2;
  const float slope = exp2f(-0.5f * (float)(h + 1)) * 1.44269504088896f;
  const float sinkv = p.sink[l * 16 + h] * 1.44269504088896f;
  const int q0 = b * 128 + wave * 32;
  const int qx = q0 + r31;
  const bool wactive = (b >= 0) || (wave == 3);
  int qseq = qx + 16; const bool qvalid = qseq >= 0; if (qseq < 0) qseq = 0;
  bf16x8 qf[4];
#pragma unroll
  for (int kk = 0; kk < 4; ++kk) qf[kk] = *(const bf16x8*)(Q + (size_t)qseq * D + h * 64 + kk * 16 + 8 * hh);
  f32x16 o[2];
#pragma unroll
  for (int r = 0; r < 16; ++r) { o[0][r] = 0.f; o[1][r] = 0.f; }
  float m = sinkv, lsum = hh == 0 ? 1.f : 0.f;
  const int swz = (r31 >> 1) & 7;
  uint4 kr0, kr1, kr2, kr3, vr0, vr1, vr2, vr3;
#define ATT_ISSUE(ST) do { const int _st = (ST); const int _kseq0 = _st == 0 ? 0 : (b - 2 + _st) * 128 + 16; const int _nrow = _st == 0 ? 32 : 128, _nkc = _st == 0 ? 4 : 16; \
    const bf16_t* _kp = Kb + (size_t)(_kseq0 + (tid >> 3)) * 256 + kv * 64 + (tid & 7) * 8; \
    kr0 = *(const uint4*)(_kp); if (_nrow > 32) { kr1 = *(const uint4*)(_kp + 32 * 256); kr2 = *(const uint4*)(_kp + 64 * 256); kr3 = *(const uint4*)(_kp + 96 * 256); } \
    if ((tid & 15) < _nkc) { const bf16_t* _vp = VT + (size_t)(kv * 64 + (tid >> 4)) * LV + _kseq0 + 48 + (tid & 15) * 8; \
      vr0 = *(const uint4*)(_vp); vr1 = *(const uint4*)(_vp + (size_t)16 * LV); vr2 = *(const uint4*)(_vp + (size_t)32 * LV); vr3 = *(const uint4*)(_vp + (size_t)48 * LV); } } while (0)
  ATT_ISSUE(0);
  for (int st = 0; st < 4; ++st) {
    const int kb = b - 2 + st;
    if (st != 0 && (kb < 0 || kb >= 128)) continue;
    const int kseq0 = st == 0 ? 0 : kb * 128 + 16;
    __syncthreads();
    {
      const int nrow = st == 0 ? 32 : 128;
      char* kd = lds + lds_off(tid >> 3, tid & 7);
      *(uint4*)kd = kr0;
      if (nrow > 32) { *(uint4*)(kd + 4096) = kr1; *(uint4*)(kd + 8192) = kr2; *(uint4*)(kd + 12288) = kr3; }
      const int nkc = st == 0 ? 4 : 16;
      if ((tid & 15) < nkc) {
        char* dst = lds + 16384 + (tid >> 4) * 264 + (tid & 15) * 16;
        *(uint2*)dst = make_uint2(vr0.x, vr0.y); *(uint2*)(dst + 8) = make_uint2(vr0.z, vr0.w);
        *(uint2*)(dst + 16 * 264) = make_uint2(vr1.x, vr1.y); *(uint2*)(dst + 16 * 264 + 8) = make_uint2(vr1.z, vr1.w);
        *(uint2*)(dst + 32 * 264) = make_uint2(vr2.x, vr2.y); *(uint2*)(dst + 32 * 264 + 8) = make_uint2(vr2.z, vr2.w);
        *(uint2*)(dst + 48 * 264) = make_uint2(vr3.x, vr3.y); *(uint2*)(dst + 48 * 264 + 8) = make_uint2(vr3.z, vr3.w);
      }
      int nst = st + 1;
      while (nst < 4 && (b - 2 + nst < 0 || b - 2 + nst >= 128)) ++nst;
      if (nst < 4) ATT_ISSUE(nst);
    }
    __syncthreads();
    if (!wactive) continue;
    const int nj = st == 0 ? 1 : 4;
    for (int j = 0; j < nj; ++j) {
      const int kx0 = st == 0 ? 0 : kb * 128 + 32 * j;
      if (st != 0 && (kx0 + 31 < q0 - 128 || kx0 > q0 + 31 + 128)) continue;
      f32x16 s;
#pragma unroll
      for (int r = 0; r < 16; ++r) s[r] = 0.f;
#pragma unroll
      for (int kk = 0; kk < 4; ++kk) {
        const bf16x8 a = *(const bf16x8*)(lds + (32 * j + r31) * 128 + (((kk * 2 + hh) ^ swz) << 4));
        s = __builtin_amdgcn_mfma_f32_32x32x16_bf16(a, qf[kk], s, 0, 0, 0);
      }
      float tmax = -1e30f;
      const float fbase = (float)(qx - kx0 - 4 * hh);
#pragma unroll
      for (int r = 0; r < 16; ++r) {
        float sv; bool valid;
        if (st == 0) { valid = 8 * (r >> 2) + 4 * hh + (r & 3) < 16; sv = s[r]; }
        else { const float dist = fabsf(fbase - (float)(8 * (r >> 2) + (r & 3))); valid = dist <= 128.f; sv = fmaf(-slope, dist, s[r]); }
        sv = valid ? sv : -1e30f;
        s[r] = sv; tmax = fmaxf(tmax, sv);
      }
      tmax = fmaxf(tmax, __shfl_xor(tmax, 32));
      const float mnew = fmaxf(m, tmax);
      const float alpha = __builtin_amdgcn_exp2f(m - mnew);
      m = mnew;
      float psum = 0.f;
#pragma unroll
      for (int r = 0; r < 16; ++r) { s[r] = __builtin_amdgcn_exp2f(s[r] - mnew); psum += s[r]; }
      lsum = lsum * alpha + psum;
#pragma unroll
      for (int r = 0; r < 16; ++r) { o[0][r] *= alpha; o[1][r] *= alpha; }
      bf16x8 pf[2];
#pragma unroll
      for (int s2 = 0; s2 < 2; ++s2) {
        unsigned w0 = cvt_pk_bf16(s[8 * s2 + 0], s[8 * s2 + 1]), w1 = cvt_pk_bf16(s[8 * s2 + 2], s[8 * s2 + 3]);
        unsigned w2 = cvt_pk_bf16(s[8 * s2 + 4], s[8 * s2 + 5]), w3 = cvt_pk_bf16(s[8 * s2 + 6], s[8 * s2 + 7]);
        uint4 t = make_uint4(w0, w1, w2, w3);
        pf[s2] = *(bf16x8*)&t;
      }
#pragma unroll
      for (int s2 = 0; s2 < 2; ++s2)
#pragma unroll
        for (int di = 0; di < 2; ++di) {
          const char* vrow = lds + 16384 + (32 * di + r31) * 264 + (32 * j + 16 * s2 + 4 * hh) * 2;
          const uint2 lo = *(const uint2*)vrow, hi = *(const uint2*)(vrow + 16);
          uint4 t = make_uint4(lo.x, lo.y, hi.x, hi.y);
          o[di] = __builtin_amdgcn_mfma_f32_32x32x16_bf16(*(bf16x8*)&t, pf[s2], o[di], 0, 0, 0);
        }
    }
  }
  if (wactive) {
    const float lt = lsum + __shfl_xor(lsum, 32);
    const float inv = 1.0f / lt;
    if (qvalid) {
#pragma unroll
      for (int di = 0; di < 2; ++di)
#pragma unroll
        for (int q = 0; q < 4; ++q) {
          f32x4 a; a[0] = o[di][4 * q] * inv; a[1] = o[di][4 * q + 1] * inv; a[2] = o[di][4 * q + 2] * inv; a[3] = o[di][4 * q + 3] * inv;
          *(uint2*)(YA + blkidx(qseq, h * 64 + 32 * di + 8 * q + 4 * hh, 32)) = pack4(a);
        }
    }
  }
}

#undef ATT_ISSUE
__device__ __forceinline__ void phase_attn_xend(const Params& p, int l, char* lds, int tid) {
  const bf16_t* ug = (const bf16_t*)(p.ws + OFF_UG); const bf16_t* Wend = (const bf16_t*)(p.ws + OFF_WEND); float* Xend = (float*)(p.ws + OFF_XEND);
  const int lane = tid & 63, wave = tid >> 6, wm = wave >> 1, wn = wave & 1, lrow = tid >> 2, lch = tid & 3; int le = lane;
  constexpr int NATT = 2048 + 16, NXM = 64, NXS = 512;
  unsigned* ctr = (unsigned*)(p.ws + OFF_BAR) + 2304 + 64 * l;
  if (tid == 0) s_unit = (int)__hip_atomic_fetch_add(ctr, 1u, __ATOMIC_RELAXED, __HIP_MEMORY_SCOPE_AGENT);
  __syncthreads();
  int uq = s_unit;
  __syncthreads();
  while (uq < NATT + NXM + NXS) {
    if (tid == 0) s_unit = (int)__hip_atomic_fetch_add(ctr, 1u, __ATOMIC_RELAXED, __HIP_MEMORY_SCOPE_AGENT);
    const int u = uq < NXM ? NATT + uq : (uq < NXM + NATT ? uq - NXM : uq);
    if (u < NATT) {
      if (u < 2048) attn_unit(p, l, u >> 4, u & 15, lds, tid); else attn_unit(p, l, -1, u - 2048, lds, tid);
    } else if (u < NATT + NXM) {
      const int v = u - NATT, g = v >> 1, tm = v & 1;
      const int k0 = 1 + tm * 128;
      f32x16 acc[2][4]; zero_acc(acc);
      int tl = tid; asm volatile("" : "+v"(tl));
      const int lrow = tl >> 2, lch = (tl & 3) ^ ((tl >> 4) & 3);
      gemm_acc(acc, ug + ((size_t)g * LU + (size_t)(k0 + lrow) * 64) * 16 + lch * 8, 1024, 32,
               Wend + ((size_t)g * 256 + lrow) * 1024 + lch * 8, 1024, 32, 32, lds, tid);
      LAUNDER_LANE();
#pragma unroll
      for (int mi = 0; mi < 2; ++mi) {
        const int k = k0 + wm * 64 + mi * 32 + (le & 31);
#pragma unroll
        for (int ni = 0; ni < 4; ++ni)
#pragma unroll
          for (int q = 0; q < 4; ++q) {
            f32x4 a; a[0] = acc[mi][ni][4 * q]; a[1] = acc[mi][ni][4 * q + 1]; a[2] = acc[mi][ni][4 * q + 2]; a[3] = acc[mi][ni][4 * q + 3];
            *(f32x4*)(Xend + ((size_t)g * NCH + k) * 256 + wn * 128 + ni * 32 + 8 * q + 4 * (le >> 5)) = a;
          }
      }
    } else {
      {
      const int v = u - NATT - NXM, g = v >> 4, c0 = (v & 15) * 16;
      auto xa = [&](int m, int kc) { return ug + (size_t)g * LU * 16 + kc * 8; };
      auto wa = [&](int n, int kc) { return Wend + ((size_t)g * 256 + c0 + n) * 1024 + kc * 8; };
      const f32x4 a = skinny_acc(xa, wa, 32, lds, tid);
      if (wave == 0 && (lane & 15) == 0) *(f32x4*)(Xend + ((size_t)g * NCH + 0) * 256 + c0 + 4 * (lane >> 4)) = a;
      }
    }
    __syncthreads();
    uq = s_unit;
    __syncthreads();
  }
}

__device__ __forceinline__ void phase_scan(const Params& p, int l, int tid) {
  const float* Xend = (const float*)(p.ws + OFF_XEND); bf16_t* Xin = (bf16_t*)(p.ws + OFF_XIN);
  const float2* LP = (const float2*)(p.ws + OFF_LP) + (size_t)l * 2 * NG * NP * 65;
  const int gt = blockIdx.x * 256 + tid;
  if (gt >= 2 * NG * NP) return;
  const int pp = gt & 63, g = (gt >> 6) & 31, dr = gt >> 11;
  const float2 lam = LP[((size_t)(dr * NG + g) * NP + pp) * 65 + 64];
  const float* xe = Xend + (size_t)g * NCH * 256 + dr * 128 + pp;
  bf16_t* xi = Xin + (size_t)g * NCH * 256 + dr * 128 + pp;
  float xr = 0.f, xim = 0.f;
  for (int i0 = 0; i0 < NCH; i0 += 16) {
    float er[16], ei[16];
#pragma unroll
    for (int j = 0; j < 16; ++j) { const int i = i0 + j; const int ic = i < NCH ? i : NCH - 1; const int k = dr ? (NCH - 1 - ic) : ic; er[j] = xe[(size_t)k * 256]; ei[j] = xe[(size_t)k * 256 + 64]; }
#pragma unroll
    for (int j = 0; j < 16; ++j) {
      const int i = i0 + j; const int k = dr ? (NCH - 1 - i) : i;
      if (i < NCH) {
        xi[(size_t)k * 256] = (bf16_t)(cvt_pk_bf16(xr, 0.f) & 0xffffu); xi[(size_t)k * 256 + 64] = (bf16_t)(cvt_pk_bf16(xim, 0.f) & 0xffffu);
        const float nr = lam.x * xr - lam.y * xim + er[j], ni = lam.x * xim + lam.y * xr + ei[j];
        xr = nr; xim = ni;
      }
    }
  }
}

__device__ __forceinline__ uint2 ssm_load_u(const Params& p, int g, int k, int n) {
  const int t = n >> 4, c = n & 15;
  return *(const uint2*)((const bf16_t*)(p.ws + OFF_UG) + ((size_t)g * LU + 64 * k + t) * 16 + c);
}
__device__ __forceinline__ void ssm_store(const Params& p, int l, int g, int k, int n, f32x4 a, uint2 uw) {
  const int t = n >> 4, c = n & 15;
  const int pos = 64 * k + t, seq = pos - 48;
  if (seq < 0) return;
  const f32x4 dv = *(const f32x4*)(p.ssm_d + l * 512 + g * 16 + c);
  f32x4 y;
  y[0] = a[0] + dv[0] * __uint_as_float(uw.x << 16); y[1] = a[1] + dv[1] * __uint_as_float(uw.x & 0xffff0000u);
  y[2] = a[2] + dv[2] * __uint_as_float(uw.y << 16); y[3] = a[3] + dv[3] * __uint_as_float(uw.y & 0xffff0000u);
  y[0] = gelu_tanh(y[0]); y[1] = gelu_tanh(y[1]); y[2] = gelu_tanh(y[2]); y[3] = gelu_tanh(y[3]);
  *(uint2*)((bf16_t*)(p.ws + OFF_Z) + ((size_t)g * LZ + seq) * 16 + c) = pack4(y);
}
__device__ __forceinline__ void phase_ssm_out(const Params& p, int l, char* lds, int tid) {
  const bf16_t* ug = (const bf16_t*)(p.ws + OFF_UG); const bf16_t* Ktab = (const bf16_t*)(p.ws + OFF_KTAB);
  const bf16_t* Mcar = (const bf16_t*)(p.ws + OFF_MCAR); const bf16_t* Xin = (const bf16_t*)(p.ws + OFF_XIN);
  const int lane = tid & 63, wave = tid >> 6, wm = wave >> 1, wn = wave & 1, lrow = tid >> 2, lch = tid & 3; int le = lane;
  constexpr int NMAIN = 256, NSK = 512;
  for (int u = blockIdx.x; u < NMAIN + NSK; u += gridDim.x) {
    if (u < NMAIN) {
      const int g = u >> 3, tm = u & 1, tn = (u >> 1) & 3;
      const int k0 = 1 + tm * 128, n0 = tn * 256;
      f32x16 acc[2][4]; zero_acc(acc);
      int tl = tid; asm volatile("" : "+v"(tl));
      const int lrow = tl >> 2, lch = (tl & 3) ^ ((tl >> 4) & 3);
      gemm_acc(acc, ug + ((size_t)g * LU + (size_t)(k0 + lrow) * 64) * 16 + lch * 8, 1024, 32,
               Ktab + (size_t)g * 127 * 256 + (size_t)(n0 + lrow) * 16 + (63 - (lch >> 1)) * 256 + (lch & 1) * 8, 16, -512, 32, lds, tid);
      LAUNDER_LANE();
      gemm_acc(acc, Xin + ((size_t)g * NCH + k0 + lrow) * 256 + lch * 8, 256, 32,
               Mcar + ((size_t)g * 1024 + n0 + lrow) * 256 + lch * 8, 256, 32, 8, lds, tid);
      LAUNDER_LANE();
#pragma unroll
      for (int mi = 0; mi < 2; ++mi) {
        const int k = k0 + wm * 64 + mi * 32 + (le & 31);
#pragma unroll
        for (int hf = 0; hf < 2; ++hf) {
        uint2 uw[2][4];
#pragma unroll
        for (int ni = 0; ni < 2; ++ni)
#pragma unroll
          for (int q = 0; q < 4; ++q) uw[ni][q] = ssm_load_u(p, g, k, n0 + wn * 128 + (2 * hf + ni) * 32 + 8 * q + 4 * (le >> 5));
#pragma unroll
        for (int ni = 0; ni < 2; ++ni)
#pragma unroll
          for (int q = 0; q < 4; ++q) {
            f32x4 a; a[0] = acc[mi][2 * hf + ni][4 * q]; a[1] = acc[mi][2 * hf + ni][4 * q + 1]; a[2] = acc[mi][2 * hf + ni][4 * q + 2]; a[3] = acc[mi][2 * hf + ni][4 * q + 3];
            ssm_store(p, l, g, k, n0 + wn * 128 + (2 * hf + ni) * 32 + 8 * q + 4 * (le >> 5), a, uw[ni][q]);
          }
        asm volatile("" ::: "memory");
        }
      }
    } else {
      {
      const int v = u - NMAIN, g = v >> 4, c0 = 768 + (v & 15) * 16;
      auto xa = [&](int m, int kc) { return kc < 128 ? ug + (size_t)g * LU * 16 + kc * 8 : Xin + (size_t)g * NCH * 256 + (kc - 128) * 8; };
      auto wa = [&](int n, int kc) {
        const int nn = c0 + n;
        return kc < 128 ? Ktab + (size_t)g * 127 * 256 + ((nn >> 4) + 63 - (kc >> 1)) * 256 + (nn & 15) * 16 + (kc & 1) * 8
                        : Mcar + ((size_t)g * 1024 + nn) * 256 + (kc - 128) * 8; };
      const f32x4 a = skinny_acc(xa, wa, 40, lds, tid);
      if (wave == 0 && (lane & 15) == 0) ssm_store(p, l, g, 0, c0 + 4 * (lane >> 4), a, ssm_load_u(p, g, 0, c0 + 4 * (lane >> 4)));
      }
    }
  }
}

__device__ __forceinline__ void phase_glu(const Params& p, char* lds, int tid) {
  const bf16_t* Z = (const bf16_t*)(p.ws + OFF_Z); const bf16_t* Wt = (const bf16_t*)(p.ws + OFF_W + W_GLU); bf16_t* YS = (bf16_t*)(p.ws + OFF_YS);
  const int lane = tid & 63, wave = tid >> 6, wm = wave >> 1, wn = wave & 1, lrow = tid >> 2, lch = tid & 3; int le = lane;
  constexpr int nN = 2;
  auto loadz = [&](int row, int col) { return *(const uint2*)(Z + ((size_t)(col >> 4) * LZ + row) * 16 + (col & 15)); };
  auto store = [&](int row, int col, f32x4 a, uint2 zw) {
    f32x4 o;
    o[0] = __uint_as_float(zw.x << 16) * sigmoidf_(a[0]); o[1] = __uint_as_float(zw.x & 0xffff0000u) * sigmoidf_(a[1]);
    o[2] = __uint_as_float(zw.y << 16) * sigmoidf_(a[2]); o[3] = __uint_as_float(zw.y & 0xffff0000u) * sigmoidf_(a[3]);
    *(uint2*)(YS + blkidx(row, col, 16)) = pack4(o);
  };
  const int nit = tile_iters(nN);
  for (int it = 0; it < nit + 1; ++it) {
    if (it < nit) {
      int tm, tn; if (!tile_of(it, nN, tm, tn)) continue;
      const int m0 = 16 + tm * 128;
      f32x16 acc[2][4]; zero_acc(acc);
      int tl = tid; asm volatile("" : "+v"(tl));
      const int lrow = tl >> 2, lch = (tl & 3) ^ ((tl >> 4) & 3);
      gemm_acc(acc, Z + ((size_t)(lch >> 1) * LZ + m0 + lrow) * 16 + (lch & 1) * 8, 16, 2 * LZ * 16, Wt + ((size_t)tn * 16 * 256 + lrow) * 32 + lch * 8, 32, 8192, 16, lds, tid);
      LAUNDER_LANE();
#pragma unroll
      for (int mi = 0; mi < 2; ++mi) {
        const int row = m0 + wm * 64 + mi * 32 + (le & 31);
#pragma unroll
        for (int hf = 0; hf < 2; ++hf) {
        uint2 zw[2][4];
#pragma unroll
        for (int ni = 0; ni < 2; ++ni)
#pragma unroll
          for (int q = 0; q < 4; ++q) zw[ni][q] = loadz(row, tn * 256 + wn * 128 + (2 * hf + ni) * 32 + 8 * q + 4 * (le >> 5));
#pragma unroll
        for (int ni = 0; ni < 2; ++ni)
#pragma unroll
          for (int q = 0; q < 4; ++q) {
            f32x4 a; a[0] = acc[mi][2 * hf + ni][4 * q]; a[1] = acc[mi][2 * hf + ni][4 * q + 1]; a[2] = acc[mi][2 * hf + ni][4 * q + 2]; a[3] = acc[mi][2 * hf + ni][4 * q + 3];
            store(row, tn * 256 + wn * 128 + (2 * hf + ni) * 32 + 8 * q + 4 * (le >> 5), a, zw[ni][q]);
          }
        asm volatile("" ::: "memory");
        }
      }
    } else for (int v = sk_first(); v < 32; v += gridDim.x) {
      {
      const int c0 = v * 16;
      auto xa = [&](int m, int kc) { return Z + ((size_t)(kc >> 1) * LZ + m) * 16 + (kc & 1) * 8; };
      auto wa = [&](int n, int kc) { return wblk(Wt, 16, c0 + n, kc); };
      const f32x4 a = skinny_acc(xa, wa, 16, lds, tid);
      if (wave == 0) store(lane & 15, c0 + 4 * (lane >> 4), a, loadz(lane & 15, c0 + 4 * (lane >> 4)));
      }
    }
  }
}

__device__ __forceinline__ f32x4 un4bf(uint2 w) {
  f32x4 r; r[0] = __uint_as_float(w.x << 16); r[1] = __uint_as_float(w.x & 0xffff0000u); r[2] = __uint_as_float(w.y << 16); r[3] = __uint_as_float(w.y & 0xffff0000u); return r;
}
__device__ __forceinline__ f32x4 ld4bf(const bf16_t* ptr) {
  const uint2 w = *(const uint2*)ptr; f32x4 r;
  r[0] = __uint_as_float(w.x << 16); r[1] = __uint_as_float(w.x & 0xffff0000u); r[2] = __uint_as_float(w.y << 16); r[3] = __uint_as_float(w.y & 0xffff0000u); return r;
}
__device__ __forceinline__ void phase_merge(const Params& p, char* lds, int tid) {
  const bf16_t* YS = (const bf16_t*)(p.ws + OFF_YS); const bf16_t* YA = (const bf16_t*)(p.ws + OFF_YA);
  const bf16_t* GS = (const bf16_t*)(p.ws + OFF_GS); const bf16_t* GA = (const bf16_t*)(p.ws + OFF_GA);
  const bf16_t* Wbs = (const bf16_t*)(p.ws + OFF_W + W_BS); const bf16_t* Wba = (const bf16_t*)(p.ws + OFF_W + W_BA);
  bf16_t* MG = (bf16_t*)(p.ws + OFF_Q);
  const int lane = tid & 63, wave = tid >> 6, wm = wave >> 1, wn = wave & 1, lrow = tid >> 2, lch = tid & 3; int le = lane;
  constexpr int nN = 4;
  const int nit = tile_iters(nN);
  for (int it = 0; it < nit + 1; ++it) {
    if (it < nit) {
      int tm, tn; if (!tile_of(it, nN, tm, tn)) continue;
      const int m0 = 16 + tm * 128;
      f32x16 acc[2][4]; zero_acc(acc);
      int tl = tid; asm volatile("" : "+v"(tl));
      const int lrow = tl >> 2, lch = (tl & 3) ^ ((tl >> 4) & 3);
      gemm_acc(acc, YS + ((size_t)tm * 16 * 128 + lrow) * 32 + lch * 8, 32, 4096, Wbs + ((size_t)tn * 16 * 256 + lrow) * 32 + lch * 8, 32, 8192, 16, lds, tid);
      LAUNDER_LANE();
#pragma unroll
      for (int mi = 0; mi < 2; ++mi) {
        const int row = m0 + wm * 64 + mi * 32 + (le & 31);
#pragma unroll
        for (int hf = 0; hf < 2; ++hf) {
        uint2 gw[2][4];
#pragma unroll
        for (int ni = 0; ni < 2; ++ni)
#pragma unroll
          for (int q = 0; q < 4; ++q) gw[ni][q] = *(const uint2*)(GS + (size_t)row * D + tn * 256 + wn * 128 + (2 * hf + ni) * 32 + 8 * q + 4 * (le >> 5));
#pragma unroll
        for (int ni = 0; ni < 2; ++ni)
#pragma unroll
          for (int q = 0; q < 4; ++q) {
            f32x4 gsv = un4bf(gw[ni][q]);
            gsv[0] = sigmoidf_(gsv[0]); gsv[1] = sigmoidf_(gsv[1]); gsv[2] = sigmoidf_(gsv[2]); gsv[3] = sigmoidf_(gsv[3]);
            f32x4 t;
#pragma unroll
            for (int j = 0; j < 4; ++j) t[j] = acc[mi][2 * hf + ni][4 * q + j] * gsv[j];
            *(uint2*)(MG + blkfast(tm, 32, tn * 8 + wn * 4 + 2 * hf + ni, (wm * 64 + mi * 32 + (le & 31)) * 32 + 8 * q + 4 * (le >> 5))) = pack4(t);
          }
        asm volatile("" ::: "memory");
        }
      }
      zero_acc(acc);
      gemm_acc(acc, YA + ((size_t)tm * 32 * 128 + lrow) * 32 + lch * 8, 32, 4096, Wba + ((size_t)tn * 32 * 256 + lrow) * 32 + lch * 8, 32, 8192, 32, lds, tid);
      LAUNDER_LANE();
#pragma unroll
      for (int mi = 0; mi < 2; ++mi) {
        const int row = m0 + wm * 64 + mi * 32 + (le & 31);
#pragma unroll
        for (int hf = 0; hf < 2; ++hf) {
        uint2 gw[2][4], pw[2][4];
#pragma unroll
        for (int ni = 0; ni < 2; ++ni)
#pragma unroll
          for (int q = 0; q < 4; ++q) {
            gw[ni][q] = *(const uint2*)(GA + (size_t)row * D + tn * 256 + wn * 128 + (2 * hf + ni) * 32 + 8 * q + 4 * (le >> 5));
            pw[ni][q] = *(const uint2*)(MG + blkfast(tm, 32, tn * 8 + wn * 4 + 2 * hf + ni, (wm * 64 + mi * 32 + (le & 31)) * 32 + 8 * q + 4 * (le >> 5)));
          }
#pragma unroll
        for (int ni = 0; ni < 2; ++ni)
#pragma unroll
          for (int q = 0; q < 4; ++q) {
            const int col = tn * 256 + wn * 128 + (2 * hf + ni) * 32 + 8 * q + 4 * (le >> 5);
            f32x4 gav = un4bf(gw[ni][q]);
            gav[0] = sigmoidf_(gav[0]); gav[1] = sigmoidf_(gav[1]); gav[2] = sigmoidf_(gav[2]); gav[3] = sigmoidf_(gav[3]);
            const uint2 pk = pw[ni][q];
            f32x4 o;
            o[0] = __uint_as_float(pk.x << 16) + gav[0] * acc[mi][2 * hf + ni][4 * q + 0];
            o[1] = __uint_as_float(pk.x & 0xffff0000u) + gav[1] * acc[mi][2 * hf + ni][4 * q + 1];
            o[2] = __uint_as_float(pk.y << 16) + gav[2] * acc[mi][2 * hf + ni][4 * q + 2];
            o[3] = __uint_as_float(pk.y & 0xffff0000u) + gav[3] * acc[mi][2 * hf + ni][4 * q + 3];
            *(uint2*)(MG + blkfast(tm, 32, tn * 8 + wn * 4 + 2 * hf + ni, (wm * 64 + mi * 32 + (le & 31)) * 32 + 8 * q + 4 * (le >> 5))) = pack4(o);
          }
        asm volatile("" ::: "memory");
        }
      }
    } else for (int v = sk_first(); v < 64; v += gridDim.x) {
      {
      const int c0 = v * 16;
      auto xs = [&](int m, int kc) { return YS + (((size_t)128 * 16 + (kc >> 2)) * 128 + m) * 32 + (kc & 3) * 8; };
      auto ws_ = [&](int n, int kc) { return wblk(Wbs, 16, c0 + n, kc); };
      auto xa = [&](int m, int kc) { return YA + (((size_t)128 * 32 + (kc >> 2)) * 128 + m) * 32 + (kc & 3) * 8; };
      auto wa = [&](int n, int kc) { return wblk(Wba, 32, c0 + n, kc); };
      const f32x4 a1 = skinny_acc(xs, ws_, 16, lds, tid);
      const f32x4 a2 = skinny_acc(xa, wa, 32, lds, tid);
      if (wave == 0) {
        const int row = lane & 15, col = c0 + 4 * (lane >> 4);
        f32x4 gsv = ld4bf(GS + (size_t)row * D + col), gav = ld4bf(GA + (size_t)row * D + col);
#pragma unroll
        for (int j = 0; j < 4; ++j) { gsv[j] = sigmoidf_(gsv[j]); gav[j] = sigmoidf_(gav[j]); }
        f32x4 o;
#pragma unroll
        for (int j = 0; j < 4; ++j) o[j] = gsv[j] * a1[j] + gav[j] * a2[j];
        *(uint2*)(MG + blkidx(row, col, 32)) = pack4(o);
      }
      }
    }
  }
}

__device__ __forceinline__ void phase_final(const Params& p, int tid) {
  const float* h = (const float*)(p.ws + OFF_H);
  const int lane = tid & 63, wave = tid >> 6;
  for (int r = blockIdx.x * 4 + wave; r < NX; r += gridDim.x * 4) {
    const float rs = row_rstd(p, 12, r + 16);
#pragma unroll
    for (int i = 0; i < 4; ++i) {
      const int c = i * 256 + lane * 4;
      f32x4 v = *(const f32x4*)(h + (size_t)(r + 16) * D + c);
      const f32x4 g = *(const f32x4*)(p.final_norm + c);
      v = v * rs * g;
      *(f32x4*)(p.out + (size_t)r * D + c) = v;
    }
  }
}

#define XB_XCNT(j) (64 * (j))
#define XB_XSUB(j) (1024 + 64 * (j))
#define XB_TOP 2048
#define XB_PLAIN 2112
#define XB_WORDS 2176
struct GridBar { unsigned* bar; unsigned xcc, nloc, nx, gen; };
__device__ __forceinline__ unsigned xb_ld(unsigned* q) { return __hip_atomic_load(q, __ATOMIC_RELAXED, __HIP_MEMORY_SCOPE_AGENT); }
__device__ __forceinline__ void grid_bar_setup(GridBar& gb, unsigned* bar, int tid) {
  gb.bar = bar; gb.gen = 0; gb.nloc = 1; gb.nx = 1;
  gb.xcc = (unsigned)__builtin_amdgcn_s_getreg((3 << 11) | 20) & 0xFu;
  if (tid == 0) {
    const unsigned rank = __hip_atomic_fetch_add(&bar[XB_XCNT(gb.xcc)], 1u, __ATOMIC_RELAXED, __HIP_MEMORY_SCOPE_AGENT);
    __hip_atomic_fetch_add(&bar[XB_PLAIN], 1u, __ATOMIC_RELAXED, __HIP_MEMORY_SCOPE_AGENT);
    while (xb_ld(&bar[XB_PLAIN]) < gridDim.x) __builtin_amdgcn_s_sleep(2);
    unsigned nx = 0; bool even = (gridDim.x & 7u) == 0u;
    for (int j = 0; j < 16; ++j) { const unsigned c = xb_ld(&bar[XB_XCNT(j)]); nx += c != 0u; if (j < 8 ? c != (gridDim.x >> 3) : c != 0u) even = false; }
    s_nx = nx; s_nloc = xb_ld(&bar[XB_XCNT(gb.xcc)]);
    s_vb = even ? (int)(rank * 8u + gb.xcc) : (int)blockIdx.x;
  }
  __syncthreads();
}
__device__ __forceinline__ void grid_bar(GridBar& gb, int tid) {
  asm volatile("s_waitcnt vmcnt(0) lgkmcnt(0)" ::: "memory");
  __syncthreads();
  gb.gen += 1;
  if (tid == 0) {
    const unsigned old = __hip_atomic_fetch_add(&gb.bar[XB_XSUB(gb.xcc)], 1u, __ATOMIC_RELAXED, __HIP_MEMORY_SCOPE_AGENT);
    if (old + 1 == s_nloc * gb.gen) {
      __builtin_amdgcn_fence(__ATOMIC_RELEASE, "agent");
      asm volatile("s_waitcnt vmcnt(0)" ::: "memory");
      __hip_atomic_fetch_add(&gb.bar[XB_TOP], 1u, __ATOMIC_RELAXED, __HIP_MEMORY_SCOPE_AGENT);
    }
    const unsigned target = s_nx * gb.gen;
    while (xb_ld(&gb.bar[XB_TOP]) < target) __builtin_amdgcn_s_sleep(1);
    __builtin_amdgcn_fence(__ATOMIC_ACQUIRE, "agent");
    asm volatile("s_waitcnt vmcnt(0)" ::: "memory");
  }
  __syncthreads();
}

__device__ __forceinline__ int lane_id_now() { int l; asm volatile("v_mbcnt_lo_u32_b32 %0, -1, 0\n\tv_mbcnt_hi_u32_b32 %0, -1, %0" : "=v"(l)); return l; }
__global__ void __launch_bounds__(256, 2) fwd_megakernel(Params p) {
  cg::grid_group grid = cg::this_grid();
  __shared__ __attribute__((aligned(16))) char lds[3 * 24576 + 1024];
  const int wave_s = __builtin_amdgcn_readfirstlane((int)threadIdx.x >> 6);
#define MYTID() (wave_s * 64 + lane_id_now())
    const bf16_t* hb = (const bf16_t*)(p.ws + OFF_HB);
  GridBar gb;
  grid.sync();
  grid_bar_setup(gb, (unsigned*)(p.ws + OFF_BAR), MYTID());
  phase_init(p, MYTID());
  grid_bar(gb, MYTID());
  for (int l = 0; l < 4; ++l) {
#pragma nounroll
    for (int step0 = 0; step0 < 12 + PROBE_EXTRA; ++step0) {
      const int step = step0 < 12 ? step0 : PROBE_STEP;
      if (PROBE_STEP < 0 && step0 >= 12) { grid_bar(gb, MYTID()); continue; }
      int tid = MYTID(); asm volatile("" : "+v"(tid));
      if (step == 0) {}
      else if (step == 1 || step == 10) phase_ffn_up(p, (const bf16_t*)(p.ws + OFF_W + (step == 1 ? W_GU1 : W_GU2)), 3 * l + (step == 1 ? 0 : 2), lds, tid);
      else if (step == 2 || step == 9 || step == 11) {
        const bf16_t* A = (const bf16_t*)(p.ws + (step == 9 ? OFF_Q : OFF_ACT));
        const int K = step == 9 ? D : DFF;
        const bf16_t* Wt = (const bf16_t*)(p.ws + OFF_W + (step == 2 ? W_D1 : (step == 9 ? W_O : W_D2)));
        const int sn = 3 * l + (step == 2 ? 1 : (step == 9 ? 2 : 3));
        phase_resid(p, A, K, Wt, sn, lds, tid);
      }
      else if (step == 3) phase_win(p, 3 * l + 1, lds, tid);
      else if (step == 4) phase_attn_xend(p, l, lds, tid);
      else if (step == 5) phase_scan(p, l, tid);
      else if (step == 6) phase_ssm_out(p, l, lds, tid);
      else if (step == 7) phase_glu(p, lds, tid);
      else phase_merge(p, lds, tid);
      {
        int pl = l, pb = 0, pe = 0, skip = 0;
        if (step == 0) { pb = l == 0 ? 0 : 3136; pe = l == 0 ? 10560 : 5952; }
        else if (step == 5 && l < 3) { pl = l + 1; pb = 0; pe = 3136; skip = 16; }
        else if (step == 7 && l < 3) { pl = l + 1; pb = 5952; pe = 10560; }
        if (pe > pb) phase_prep(p, pl, pb, pe, skip, lds, tid);
      }
      grid_bar(gb, MYTID());
#ifdef DBG_STEPS
      if (l * 12 + step + 1 == DBG_STEPS) {
        const int gt = blockIdx.x * 256 + MYTID();
#if DBG_MODE == 0
        const float* hsrc = (const float*)(p.ws + OFF_H);
        for (int i = gt; i < NX * D; i += gridDim.x * 256) p.out[i] = hsrc[i + 16 * D];
#else
        const bf16_t* bsrc = (const bf16_t*)(p.ws + DBG_BUF);
        for (int i = gt; i < NX * D; i += gridDim.x * 256) p.out[i] = bf2f(bsrc[i % DBG_N]);
#endif
        return;
      }
#endif
    }
  }
  (void)hb;
  phase_final(p, MYTID());
}

extern "C" void kernel_launch(void* const* d_in, const int* in_sizes, int n_in, void* d_out, int out_size, void* d_ws, size_t ws_size,
                              hipStream_t stream) {
  static int grid_blocks = 0;
  if (!grid_blocks) {
    int dev = 0, cus = 0, per_cu = 0;
    (void)hipGetDevice(&dev);
    (void)hipDeviceGetAttribute(&cus, hipDeviceAttributeMultiprocessorCount, dev);
    (void)hipOccupancyMaxActiveBlocksPerMultiprocessor(&per_cu, fwd_megakernel, 256, 0);
    if (per_cu > 2) per_cu = 2;
    if (per_cu < 1) per_cu = 1;
    grid_blocks = cus * per_cu;
  }
  if (ws_size < WS_TOTAL) { fprintf(stderr, "workspace too small: %zu < %zu\n", ws_size, (size_t)WS_TOTAL); return; }
  Params p{};
  const float* const* in = (const float* const*)d_in;
  p.x = in[0]; p.meta = in[1]; p.ffn1_norm = in[2]; p.ffn1_wg = in[3]; p.ffn1_wu = in[4]; p.ffn1_wd = in[5];
  p.mix_norm = in[6]; p.w_in = in[7]; p.lam_re = in[8]; p.lam_im = in[9]; p.log_dt = in[10];
  p.b_re = in[11]; p.b_im = in[12]; p.c_re = in[13]; p.c_im = in[14]; p.ssm_d = in[15]; p.w_glu = in[16];
  p.sink = in[17]; p.w_bs = in[18]; p.w_ba = in[19]; p.w_out = in[20]; p.ffn2_norm = in[21];
  p.ffn2_wg = in[22]; p.ffn2_wu = in[23]; p.ffn2_wd = in[24]; p.final_norm = in[25];
  p.out = (float*)d_out; p.ws = (char*)d_ws;
  void* args[] = {&p};
  (void)hipMemsetAsync((char*)d_ws + OFF_BAR, 0, 16384, stream);
  hipError_t e = hipLaunchCooperativeKernel((void*)fwd_megakernel, dim3(grid_blocks), dim3(256), args, 0, stream);
  if (e != hipSuccess) fprintf(stderr, "cooperative launch failed: %s (grid %d)\n", hipGetErrorString(e), grid_blocks);
}
```
